# Optimizing an MI355X kernel written in HIP

```python
import numpy as np
import jax
import jax.numpy as jnp
from jax import lax

D_MODEL = 2048
BATCH = 8
SEQ = 4096
DEPTH = 4
DEC_BATCH = 32
DEC_SEQ = 64
PAST_LEN = 1024

CHUNK = 64
MIX_W = D_MODEL
ATT_W = MIX_W // 2
SSM_W = MIX_W // 4
POOL_W = MIX_W - ATT_W - SSM_W
N_HEADS = 16
HEAD_DIM = ATT_W // N_HEADS
N_PREV_CHUNKS = 8
PREV_ROWS = N_PREV_CHUNKS * CHUNK
BAND_ROWS = PREV_ROWS + CHUNK
REL_CLIP = 256
SSM_GC = 16
SSM_GROUPS = SSM_W // SSM_GC
SSM_STATE = 64
DT_MIN = 1e-3
DT_MAX = 1e-1
POOL_WINDOWS = (2, 4, 8, 16)
POOL_GROUP_W = POOL_W // len(POOL_WINDOWS)
POOL_HIST = max(POOL_WINDOWS) - 1
IN_COLS = 4 * ATT_W + 2 * SSM_W + 2 * POOL_W
IN_SPLITS = (ATT_W, 2 * ATT_W, 3 * ATT_W, 4 * ATT_W, 4 * ATT_W + SSM_W,
             4 * ATT_W + 2 * SSM_W, 4 * ATT_W + 2 * SSM_W + POOL_W)
EPS = 1e-6
NEG_INF = -1e30

kernel_name = 'hymba_streaming_encoder_step'


def rmsnorm(x, g):
    xf = x.astype(jnp.float32)
    y = xf * lax.rsqrt(jnp.mean(xf * xf, axis=-1, keepdims=True) + EPS)
    return y.astype(x.dtype) * g


def chunk_band_attention(q, k, v, hist_k, hist_v, start_pos, rel_bias):
    B, L, H, Dh = q.shape
    W = hist_k.shape[1]
    n_chunks = -(-L // CHUNK)
    tail = n_chunks * CHUNK - L
    lead = PREV_ROWS - W
    end_pos = start_pos + L

    def extend(hist, new):
        return jnp.concatenate([jnp.zeros((B, lead, H, Dh), new.dtype), hist.astype(new.dtype), new,
                                jnp.zeros((B, tail, H, Dh), new.dtype)], axis=1)

    k_ext = extend(hist_k, k)
    v_ext = extend(hist_v, v)
    q_pad = jnp.pad(q, ((0, 0), (0, tail), (0, 0), (0, 0)))
    scale = HEAD_DIM ** -0.5

    def one_chunk(n):
        q0 = n * CHUNK
        qc = lax.dynamic_slice_in_dim(q_pad, q0, CHUNK, axis=1)
        kc = lax.dynamic_slice_in_dim(k_ext, q0, BAND_ROWS, axis=1)
        vc = lax.dynamic_slice_in_dim(v_ext, q0, BAND_ROWS, axis=1)
        q_pos = start_pos + q0 + jnp.arange(CHUNK)
        k_pos = start_pos - PREV_ROWS + q0 + jnp.arange(BAND_ROWS)
        q_ch = q_pos // CHUNK
        k_ch = k_pos // CHUNK
        mask = ((k_pos >= 0)[None, :] & (k_pos < end_pos)[None, :]
                & (k_ch[None, :] <= q_ch[:, None]) & (k_ch[None, :] >= q_ch[:, None] - N_PREV_CHUNKS))
        rel = jnp.clip(q_pos[:, None] - k_pos[None, :], -REL_CLIP, REL_CLIP) + REL_CLIP
        bias = rel_bias[:, rel].astype(jnp.float32)
        s = jnp.einsum('bqhd,bkhd->bhqk', qc, kc, preferred_element_type=jnp.float32) * scale + bias
        s = jnp.where(mask[None, None], s, NEG_INF)
        p = jax.nn.softmax(s, axis=-1).astype(vc.dtype)
        return jnp.einsum('bhqk,bkhd->bqhd', p, vc)

    out = lax.map(one_chunk, jnp.arange(n_chunks))
    out = jnp.moveaxis(out, 0, 1).reshape(B, n_chunks * CHUNK, H, Dh)
    return out[:, :L]


def _complex_affine_combine(e1, e2):
    a1r, a1i, b1r, b1i = e1
    a2r, a2i, b2r, b2i = e2
    ar = a2r * a1r - a2i * a1i
    ai = a2r * a1i + a2i * a1r
    br = a2r * b1r - a2i * b1i + b2r
    bi = a2r * b1i + a2i * b1r + b2i
    return ar, ai, br, bi


def s5_branch(u, h0_re, h0_im, a_re, a_im, log_dt, b_re, b_im, c_re, c_im, d_skip, w_glu, b_glu):
    f32 = jnp.float32
    Bsz, L, _ = u.shape
    uf = u.astype(f32).reshape(Bsz, L, SSM_GROUPS, SSM_GC)
    dt = jnp.exp(log_dt.astype(f32))[:, None]
    ar, ai = a_re.astype(f32), a_im.astype(f32)
    mag = jnp.exp(ar * dt)
    ang = ai * dt
    abar_r, abar_i = mag * jnp.cos(ang), mag * jnp.sin(ang)
    den = ar * ar + ai * ai
    nr, ni = abar_r - 1.0, abar_i
    coef_r = (nr * ar + ni * ai) / den
    coef_i = (ni * ar - nr * ai) / den
    br, bi = b_re.astype(f32), b_im.astype(f32)
    bbar_r = coef_r[..., None] * br - coef_i[..., None] * bi
    bbar_i = coef_r[..., None] * bi + coef_i[..., None] * br
    bu_r = jnp.einsum('blgc,gpc->blgp', uf, bbar_r)
    bu_i = jnp.einsum('blgc,gpc->blgp', uf, bbar_i)
    h0r, h0i = h0_re.astype(f32), h0_im.astype(f32)
    bu_r = bu_r.at[:, 0].add(abar_r * h0r - abar_i * h0i)
    bu_i = bu_i.at[:, 0].add(abar_r * h0i + abar_i * h0r)
    a_seq_r = jnp.broadcast_to(abar_r, (1, L, SSM_GROUPS, SSM_STATE))
    a_seq_i = jnp.broadcast_to(abar_i, (1, L, SSM_GROUPS, SSM_STATE))
    _, _, hr, hi = lax.associative_scan(_complex_affine_combine, (a_seq_r, a_seq_i, bu_r, bu_i), axis=1)
    y = (jnp.einsum('blgp,gcp->blgc', hr, c_re.astype(f32))
         - jnp.einsum('blgp,gcp->blgc', hi, c_im.astype(f32))
         + d_skip.astype(f32) * uf).reshape(Bsz, L, SSM_W)
    g = jax.nn.gelu(y)
    gl = g @ w_glu.astype(f32) + b_glu.astype(f32)
    out = gl[..., :SSM_W] * jax.nn.sigmoid(gl[..., SSM_W:])
    return out.astype(u.dtype), hr[:, -1], hi[:, -1]


def pool_mix(ext, first_pos, w_pool, pool_scale):
    f32 = jnp.float32
    B, E, _ = ext.shape
    L = E - POOL_HIST
    ef = ext.astype(f32)
    cs = jnp.concatenate([jnp.zeros((B, 1, POOL_W), f32), jnp.cumsum(ef, axis=1)], axis=1)
    pos = first_pos + POOL_HIST + jnp.arange(L)
    tok = ef[:, POOL_HIST:]
    outs = []
    for g, w in enumerate(POOL_WINDOWS):
        lo, hi = g * POOL_GROUP_W, (g + 1) * POOL_GROUP_W
        wsum = cs[:, POOL_HIST + 1:POOL_HIST + 1 + L, lo:hi] - cs[:, POOL_HIST + 1 - w:POOL_HIST + 1 - w + L, lo:hi]
        cnt = jnp.minimum(w, pos + 1).astype(f32)
        diff = wsum / cnt[None, :, None] - tok[..., lo:hi]
        outs.append(jnp.einsum('blc,cd->bld', diff, w_pool[g].astype(f32)))
    return (jnp.concatenate(outs, axis=-1) * pool_scale.astype(f32)).astype(ext.dtype)


def trunk_layer(x, c, hist_k, hist_v, h0_re, h0_im, pool_hist, start_pos,
                norm_g, w_ada, b_ada, w_in, rel_bias, a_re, a_im, log_dt, b_re, b_im, c_re, c_im,
                d_skip, w_glu, b_glu, w_pool, pool_scale, branch_g, w_out):
    B, L, _ = x.shape
    mod = jax.nn.silu(c) @ w_ada + b_ada
    shift, scale, gate = jnp.split(mod, 3, axis=-1)
    h = rmsnorm(x, norm_g) * (1.0 + scale[:, None]) + shift[:, None]
    proj = h @ w_in
    q, k, v, z_att, u_ssm, z_ssm, u_pool, z_pool = jnp.split(proj, IN_SPLITS, axis=-1)
    hd = (B, L, N_HEADS, HEAD_DIM)
    q, k, v = q.reshape(hd), k.reshape(hd), v.reshape(hd)
    y_att = chunk_band_attention(q, k, v, hist_k, hist_v, start_pos, rel_bias).reshape(B, L, ATT_W)
    y_ssm, hT_re, hT_im = s5_branch(u_ssm, h0_re, h0_im, a_re, a_im, log_dt, b_re, b_im,
                                    c_re, c_im, d_skip, w_glu, b_glu)
    pool_ext = jnp.concatenate([pool_hist.astype(u_pool.dtype), u_pool], axis=1)
    y_pool = pool_mix(pool_ext, start_pos - POOL_HIST, w_pool, pool_scale)
    g_att, g_ssm, g_pool = jnp.split(branch_g, (ATT_W, ATT_W + SSM_W))
    y = jnp.concatenate([rmsnorm(y_att, g_att) * jax.nn.silu(z_att),
                         rmsnorm(y_ssm, g_ssm) * jax.nn.silu(z_ssm),
                         rmsnorm(y_pool, g_pool) * jax.nn.silu(z_pool)], axis=-1)
    x = x + gate[:, None] * (y @ w_out)
    return x, k, v, hT_re, hT_im, pool_ext[:, -POOL_HIST:]


def setup_inputs(seed: int = 0) -> dict:
    key = jax.random.key(seed)
    ks = iter(jax.random.split(key, 40))
    f32 = jnp.float32

    def nrm(shape, s):
        return s * jax.random.normal(next(ks), shape, f32)

    att_hist = min(PREV_ROWS, PAST_LEN)
    n_idx = jnp.arange(SSM_STATE, dtype=f32)
    return {
        'x_prompt': nrm((BATCH, SEQ, D_MODEL), 1.0),
        'x_sample': nrm((DEC_BATCH, DEC_SEQ, D_MODEL), 1.0),
        'c_prompt': nrm((BATCH, D_MODEL), 1.0),
        'c_sample': nrm((DEC_BATCH, D_MODEL), 1.0),
        'cache_k': nrm((DEPTH, DEC_BATCH, att_hist, N_HEADS, HEAD_DIM), 1.0),
        'cache_v': nrm((DEPTH, DEC_BATCH, att_hist, N_HEADS, HEAD_DIM), 1.0),
        'state_ssm_re': nrm((DEPTH, DEC_BATCH, SSM_GROUPS, SSM_STATE), 0.1),
        'state_ssm_im': nrm((DEPTH, DEC_BATCH, SSM_GROUPS, SSM_STATE), 0.1),
        'state_pool': nrm((DEPTH, DEC_BATCH, POOL_HIST, POOL_W), 1.0),
        'norm_g': 1.0 + nrm((DEPTH, D_MODEL), 0.05),
        'w_ada': nrm((DEPTH, D_MODEL, 3 * D_MODEL), 0.5 * D_MODEL ** -0.5),
        'b_ada': nrm((DEPTH, 3 * D_MODEL), 0.02),
        'w_in': nrm((DEPTH, D_MODEL, IN_COLS), D_MODEL ** -0.5),
        'rel_bias': nrm((DEPTH, N_HEADS, 2 * REL_CLIP + 1), 0.5),
        'ssm_a_re': -0.5 + nrm((DEPTH, SSM_GROUPS, SSM_STATE), 0.01),
        'ssm_a_im': jnp.pi * n_idx + nrm((DEPTH, SSM_GROUPS, SSM_STATE), 0.01),
        'ssm_log_dt': jax.random.uniform(next(ks), (DEPTH, SSM_GROUPS), f32,
                                         minval=float(np.log(DT_MIN)), maxval=float(np.log(DT_MAX))),
        'ssm_b_re': nrm((DEPTH, SSM_GROUPS, SSM_STATE, SSM_GC), SSM_GC ** -0.5),
        'ssm_b_im': nrm((DEPTH, SSM_GROUPS, SSM_STATE, SSM_GC), SSM_GC ** -0.5),
        'ssm_c_re': nrm((DEPTH, SSM_GROUPS, SSM_GC, SSM_STATE), SSM_STATE ** -0.5),
        'ssm_c_im': nrm((DEPTH, SSM_GROUPS, SSM_GC, SSM_STATE), SSM_STATE ** -0.5),
        'ssm_d': nrm((DEPTH, SSM_GROUPS, SSM_GC), 0.5),
        'w_glu': nrm((DEPTH, SSM_W, 2 * SSM_W), SSM_W ** -0.5),
        'b_glu': nrm((DEPTH, 2 * SSM_W), 0.02),
        'w_pool': nrm((DEPTH, len(POOL_WINDOWS), POOL_GROUP_W, POOL_GROUP_W), POOL_GROUP_W ** -0.5),
        'pool_scale': 1.0 + nrm((DEPTH, POOL_W), 0.1),
        'branch_norm_g': 1.0 + nrm((DEPTH, MIX_W), 0.05),
        'w_out': nrm((DEPTH, MIX_W, D_MODEL), MIX_W ** -0.5),
        'final_norm_g': 1.0 + nrm((D_MODEL,), 0.05),
    }


def reference(x_prompt, x_sample, c_prompt, c_sample, cache_k, cache_v, state_ssm_re, state_ssm_im,
              state_pool, norm_g, w_ada, b_ada, w_in, rel_bias, ssm_a_re, ssm_a_im, ssm_log_dt,
              ssm_b_re, ssm_b_im, ssm_c_re, ssm_c_im, ssm_d, w_glu, b_glu, w_pool, pool_scale,
              branch_norm_g, w_out, final_norm_g):
    Bp, Lp, _ = x_prompt.shape
    keep = min(PREV_ROWS, Lp)
    hk0 = jnp.zeros((Bp, 0, N_HEADS, HEAD_DIM), x_prompt.dtype)
    h00 = jnp.zeros((Bp, SSM_GROUPS, SSM_STATE), jnp.float32)
    ph0 = jnp.zeros((Bp, POOL_HIST, POOL_W), x_prompt.dtype)
    xp, xs = x_prompt, x_sample
    kp_l, vp_l, srp_l, sip_l, pp_l = [], [], [], [], []
    ks_l, vs_l, srs_l, sis_l, ps_l = [], [], [], [], []
    for l in range(DEPTH):
        lw = (norm_g[l], w_ada[l], b_ada[l], w_in[l], rel_bias[l], ssm_a_re[l], ssm_a_im[l],
              ssm_log_dt[l], ssm_b_re[l], ssm_b_im[l], ssm_c_re[l], ssm_c_im[l], ssm_d[l],
              w_glu[l], b_glu[l], w_pool[l], pool_scale[l], branch_norm_g[l], w_out[l])
        xp, k_p, v_p, sr_p, si_p, pool_p = trunk_layer(xp, c_prompt, hk0, hk0, h00, h00, ph0, 0, *lw)
        kp_l.append(k_p[:, Lp - keep:])
        vp_l.append(v_p[:, Lp - keep:])
        srp_l.append(sr_p)
        sip_l.append(si_p)
        pp_l.append(pool_p)
        xs, k_s, v_s, sr_s, si_s, pool_s = trunk_layer(xs, c_sample, cache_k[l], cache_v[l], state_ssm_re[l],
                                                       state_ssm_im[l], state_pool[l], PAST_LEN, *lw)
        ks_l.append(k_s)
        vs_l.append(v_s)
        srs_l.append(sr_s)
        sis_l.append(si_s)
        ps_l.append(pool_s)
    y_prompt = rmsnorm(xp, final_norm_g)
    y_sample = rmsnorm(xs, final_norm_g)
    return (y_prompt, y_sample,
            jnp.stack(kp_l), jnp.stack(vp_l), jnp.stack(srp_l), jnp.stack(sip_l), jnp.stack(pp_l),
            jnp.stack(ks_l), jnp.stack(vs_l), jnp.stack(srs_l), jnp.stack(sis_l), jnp.stack(ps_l))
```

```cpp
#include <hip/hip_runtime.h>
#include <cstdio>
#include <cstdint>
namespace pg8 {
#define PG8_LAS __attribute__((address_space(3)))
typedef unsigned short bf16_t;
typedef short bf16x8 __attribute__((ext_vector_type(8)));
typedef float f32x4 __attribute__((ext_vector_type(4)));
typedef unsigned u32x4 __attribute__((ext_vector_type(4)));
constexpr int BM = 256, BK = 64, HALF = 128, HTB = HALF * BK * 2  , STAGE_BYTES = 8 * HTB, NXCD = 8, WGM = 8;

__host__ __device__ __forceinline__ int lds_byte(int r, int c) { const int st = (r >> 4) * 2 + (c >> 5), rr = r & 15, cc = c & 31, ob = rr * 64 + cc * 2; return st * 1024 + (ob ^ (((ob >> 9) & 1) << 5)); }
__host__ __device__ __forceinline__ void stage_rc(int b, int& R, int& C) { const int st = b / 1024, sb = b % 1024, swz = sb ^ (((sb >> 9) & 1) << 5); R = (st >> 1) * 16 + swz / 64; C = (st & 1) * 32 + (swz % 64) / 2; }
__host__ __device__ __forceinline__ int perm32(int rho) { const int n = rho >> 4, i = rho & 15; return 8 * (i >> 2) + 4 * n + (i & 3); }

struct Unit { int pm, pn; };
struct Gemm { const bf16_t* A; const bf16_t* Bt; int M, N, K; };

struct StaticOrder {
    int nM, nN, nwg, G, c;
    __host__ __device__ void init(int M, int N, int G_, int c_) { nM = M / BM; nN = N / BM; nwg = nM * nN; G = G_; c = c_; }
    __host__ __device__ bool next(int i, Unit& u) const {
        const long L = (long)i * G + c; if (L >= nwg) return false;
        int wgid = (int)L; { const int q = nwg / NXCD, r = nwg % NXCD, xcd = wgid % NXCD, off = wgid / NXCD; wgid = (xcd < r ? xcd * (q + 1) : r * (q + 1) + (xcd - r) * q) + off; }
        const int nig = WGM * nN, gid = wgid / nig, fm = gid * WGM, gsz = (nM - fm) < WGM ? (nM - fm) : WGM;
        u.pm = fm + ((wgid % nig) % gsz); u.pn = (wgid % nig) / gsz; return true;
    }
    __device__ __forceinline__ void a_ready(const Unit&) const {}
    __device__ __forceinline__ void done(const Unit&) const {}
};

__device__ __forceinline__ unsigned cvt_pk_bf16(float lo, float hi) { unsigned r; asm volatile("v_cvt_pk_bf16_f32 %0, %1, %2" : "=v"(r) : "v"(lo), "v"(hi)); return r; }
typedef float f32x2 __attribute__((ext_vector_type(2)));
struct EpiProj {
    static constexpr bool PERM = true, AFTER_DRAIN = false;
    bf16_t* O; float* kp; float* vp; float* ks; float* vs;
    __device__ __forceinline__ void operator()(const f32x4 (&acc)[2][2][4][2], const Unit& u, int wr, int wc, int fr, int fq) const {
        const int lrow0 = wr * 64 + fr, col0 = u.pn * BM + wc * 32 + 8 * fq;
        float* fo = nullptr;
        const bool isk = (u.pn >= 4 && u.pn < 8), isv = (u.pn >= 8 && u.pn < 12);
        if (isk || isv) {
            if (u.pm >= 128) fo = (isk ? ks : vs) + (size_t)(u.pm - 128) * 256 * 1024;
            else if ((u.pm & 15) >= 14) fo = (isk ? kp : vp) + ((size_t)(u.pm >> 4) * 512 + (size_t)((u.pm & 15) - 14) * 256) * 1024;
        }
        const int fcol0 = (u.pn & 3) * 256 + wc * 32 + 8 * fq;
#pragma unroll
        for (int ai = 0; ai < 2; ++ai)
#pragma unroll
            for (int m = 0; m < 4; ++m) { const int lr = lrow0 + ai * HALF + m * 16; bf16_t* rowp = O + (size_t)(u.pm * BM + lr) * 6144 + col0;
#pragma unroll
                for (int bj = 0; bj < 2; ++bj) { const f32x4 v0 = acc[ai][bj][m][0], v1 = acc[ai][bj][m][1];
                    u32x4 w; w.x = cvt_pk_bf16(v0[0], v0[1]); w.y = cvt_pk_bf16(v0[2], v0[3]); w.z = cvt_pk_bf16(v1[0], v1[1]); w.w = cvt_pk_bf16(v1[2], v1[3]);
                    *(u32x4*)(rowp + bj * HALF) = w; } }
        if (fo) {
            float* fb = fo + (size_t)lrow0 * 1024 + fcol0;
#pragma unroll
            for (int ai = 0; ai < 2; ++ai)
#pragma unroll
                for (int m = 0; m < 4; ++m)
#pragma unroll
                    for (int bj = 0; bj < 2; ++bj) { float* fp = fb + (ai * HALF + m * 16) * 1024 + bj * HALF; *(f32x4*)fp = acc[ai][bj][m][0]; *(f32x4*)(fp + 4) = acc[ai][bj][m][1]; }
        }
    }
};
struct EpiRes {
    static constexpr bool PERM = false, AFTER_DRAIN = false;
    const float* xin_p; const float* xin_s; float* xout; const float* gate;
    __device__ __forceinline__ void operator()(const f32x4 (&acc)[2][2][4][2], const Unit& u, int wr, int wc, int fr, int fq) const {
        const int col0 = u.pn * BM + wc * 32 + 4 * fq;
#pragma unroll
        for (int ai = 0; ai < 2; ++ai) {
            const int brow = (u.pm < 128) ? (u.pm >> 4) : (8 + (u.pm - 128) * 4 + 2 * ai + wr);
            f32x4 gv[2][2];
#pragma unroll
            for (int bj = 0; bj < 2; ++bj)
#pragma unroll
                for (int n = 0; n < 2; ++n) gv[bj][n] = *(const f32x4*)(gate + (size_t)brow * 6144 + col0 + bj * HALF + n * 16);
#pragma unroll
            for (int m = 0; m < 4; ++m) { const int r = u.pm * BM + ai * HALF + wr * 64 + m * 16 + fr;
                const float* xi = (u.pm < 128) ? (xin_p + (size_t)r * 2048) : (xin_s + (size_t)(r - 32768) * 2048); float* xo = xout + (size_t)r * 2048;
#pragma unroll
                for (int bj = 0; bj < 2; ++bj)
#pragma unroll
                    for (int n = 0; n < 2; ++n) { const f32x4 xv = *(const f32x4*)(xi + col0 + bj * HALF + n * 16); *(f32x4*)(xo + col0 + bj * HALF + n * 16) = xv + gv[bj][n] * acc[ai][bj][m][n]; }
                asm volatile("" ::: "memory"); }
        }
    }
};

template <class Epi, class Sched, bool ALIGN_EPI = false, bool SP2 = false>
__device__ __forceinline__ void gemm_phase(PG8_LAS unsigned char* lds, const Gemm g, const Sched& S, const Epi& E) {
    int tid_ = threadIdx.x; asm volatile("" : "+v"(tid_));
    const int tid = tid_, wid = __builtin_amdgcn_readfirstlane(tid >> 6), lane = tid & 63, wr = wid >> 2, wc = wid & 3, fr = lane & 15, fq = lane >> 4;
    const int K = g.K, nt = K / BK;
    unsigned voffA[2], voffB[2];
#pragma unroll
    for (int i = 0; i < 2; ++i) { int R, C; stage_rc(tid * 16 + i * 8192, R, C); const int Rb = Epi::PERM ? ((R & ~31) + perm32(R & 31)) : R;
        voffA[i] = (unsigned)(R * K + C) * 2u; voffB[i] = (unsigned)(Rb * K + C) * 2u; }
    const size_t kstep = (size_t)(BK * 2);
    const size_t hstep = (size_t)HALF * K * 2;
    const size_t tstep = 2 * hstep;
    const unsigned ldsw = (unsigned)wid * 1024u;
    const int aoff = lds_byte(wr * 64 + fr, fq * 8), boff = lds_byte(wc * 32 + fr, fq * 8);
#define PG8_SA(b, h) (((b) * 2 + (h)) * HTB)
#define PG8_SB(b, h) ((4 + (b) * 2 + (h)) * HTB)
#define PG8_STAGE(bufoff, gbase, voff) do { _Pragma("unroll") for (int _i = 0; _i < 2; ++_i) \
        __builtin_amdgcn_global_load_lds((const unsigned*)((const char*)(gbase) + (voff)[_i]), (PG8_LAS unsigned*)(lds + (bufoff) + ldsw + _i * 8192), 16, 0, 0); } while (0)
#define PG8_LDA(dst, b, h) do { _Pragma("unroll") for (int m = 0; m < 4; ++m) _Pragma("unroll") for (int k = 0; k < 2; ++k) dst[m][k] = *(const PG8_LAS bf16x8*)(lds + PG8_SA(b, h) + aoff + m * 2048 + k * 1024); } while (0)
#define PG8_LDB(dst, b, h) do { _Pragma("unroll") for (int n = 0; n < 2; ++n) _Pragma("unroll") for (int k = 0; k < 2; ++k) dst[n][k] = *(const PG8_LAS bf16x8*)(lds + PG8_SB(b, h) + boff + n * 2048 + k * 1024); } while (0)
#define PG8_MMA(ai, bj, At, Bt) do { __builtin_amdgcn_s_setprio(1); _Pragma("unroll") for (int m = 0; m < 4; ++m) _Pragma("unroll") for (int n = 0; n < 2; ++n) _Pragma("unroll") for (int k = 0; k < 2; ++k) \
        acc[ai][bj][m][n] = __builtin_amdgcn_mfma_f32_16x16x32_bf16(Bt[n][k], At[m][k], acc[ai][bj][m][n], 0, 0, 0); __builtin_amdgcn_s_setprio(0); } while (0)
#define PG8_WAIT_V(n) asm volatile("s_waitcnt vmcnt(" #n ")" ::: "memory")
#define PG8_WAIT_L(n) asm volatile("s_waitcnt lgkmcnt(" #n ")" ::: "memory")
#define PG8_BAR __builtin_amdgcn_s_barrier()
#define PG8_SCHED __builtin_amdgcn_sched_barrier(0)
    Unit cur, nxt; int ui = 0;
    if (!S.next(0, cur)) return;
    f32x4 acc[2][2][4][2];
#pragma unroll
    for (int a = 0; a < 2; ++a)
#pragma unroll
        for (int b = 0; b < 2; ++b)
#pragma unroll
            for (int m = 0; m < 4; ++m)
#pragma unroll
                for (int n = 0; n < 2; ++n) acc[a][b][m][n] = (f32x4){0.f, 0.f, 0.f, 0.f};
    bf16x8 At[4][2], B0[2][2], B1[2][2];
    const char* cA = (const char*)g.A + (size_t)cur.pm * tstep; const char* cB = (const char*)g.Bt + (size_t)cur.pn * tstep;
    S.a_ready(cur);
    if constexpr (SP2) {
        PG8_STAGE(PG8_SB(0, 0), cB, voffB); PG8_STAGE(PG8_SB(0, 1), cB + hstep, voffB); PG8_STAGE(PG8_SA(0, 0), cA, voffA); PG8_STAGE(PG8_SA(0, 1), cA + hstep, voffA);
        if (wr == 1) PG8_BAR;
        PG8_WAIT_V(2); PG8_BAR;
        PG8_STAGE(PG8_SB(1, 0), cB + kstep, voffB); PG8_STAGE(PG8_SA(1, 0), cA + kstep, voffA); PG8_STAGE(PG8_SB(1, 1), cB + hstep + kstep, voffB);
        PG8_WAIT_V(6); PG8_BAR;
    } else {
        PG8_STAGE(PG8_SB(0, 0), cB, voffB); PG8_STAGE(PG8_SA(0, 0), cA, voffA); PG8_STAGE(PG8_SB(0, 1), cB + hstep, voffB); PG8_STAGE(PG8_SA(0, 1), cA + hstep, voffA);
        if (wr == 1) PG8_BAR;
        PG8_WAIT_V(4); PG8_BAR;
        PG8_STAGE(PG8_SB(1, 0), cB + kstep, voffB); PG8_STAGE(PG8_SA(1, 0), cA + kstep, voffA); PG8_STAGE(PG8_SB(1, 1), cB + hstep + kstep, voffB);
        PG8_WAIT_V(6); PG8_BAR;
    }
    for (;;) {
        const bool has_next = S.next(ui + 1, nxt);
        const char* nA = has_next ? (const char*)g.A + (size_t)nxt.pm * tstep : cA; const char* nB = has_next ? (const char*)g.Bt + (size_t)nxt.pn * tstep : cB;
        for (int t = 0; t < nt; t += 2) {
            const bool last = (t == nt - 2);
            const char* a1 = cA + (size_t)(t + 1) * kstep;
            const char* a2 = last ? nA : cA + (size_t)(t + 2) * kstep; const char* b2 = last ? nB : cB + (size_t)(t + 2) * kstep;
            const char* a3 = a2 + kstep; const char* b3 = b2 + kstep;
            if (last && has_next) S.a_ready(nxt);
            if constexpr (SP2) {
            PG8_LDB(B0, 0, 0); PG8_LDB(B1, 0, 1); PG8_SCHED; PG8_LDA(At, 0, 0); PG8_STAGE(PG8_SA(1, 1), a1 + hstep, voffA);
            PG8_WAIT_V(8); PG8_WAIT_L(0); PG8_BAR; PG8_MMA(0, 0, At, B0); PG8_MMA(0, 1, At, B1); PG8_BAR; PG8_SCHED;
            PG8_LDA(At, 0, 1); PG8_STAGE(PG8_SB(0, 0), b2, voffB); PG8_STAGE(PG8_SB(0, 1), b2 + hstep, voffB); PG8_STAGE(PG8_SA(0, 0), a2, voffA);
            PG8_WAIT_V(8); PG8_WAIT_L(0); PG8_BAR; PG8_MMA(1, 0, At, B0); PG8_MMA(1, 1, At, B1); PG8_BAR; PG8_SCHED;
            PG8_LDB(B0, 1, 0); PG8_LDB(B1, 1, 1); PG8_SCHED; PG8_LDA(At, 1, 0); PG8_STAGE(PG8_SA(0, 1), a2 + hstep, voffA);
            PG8_WAIT_V(8); PG8_WAIT_L(0); PG8_BAR; PG8_MMA(0, 0, At, B0); PG8_MMA(0, 1, At, B1); PG8_BAR; PG8_SCHED;
            PG8_LDA(At, 1, 1); PG8_STAGE(PG8_SB(1, 0), b3, voffB); PG8_STAGE(PG8_SB(1, 1), b3 + hstep, voffB); PG8_STAGE(PG8_SA(1, 0), a3, voffA);
            PG8_WAIT_V(8); PG8_WAIT_L(0); PG8_BAR; PG8_MMA(1, 0, At, B0); PG8_MMA(1, 1, At, B1); PG8_BAR; PG8_SCHED;
            } else {
            PG8_LDB(B0, 0, 0); PG8_SCHED; PG8_LDA(At, 0, 0); PG8_STAGE(PG8_SA(1, 1), a1 + hstep, voffA);
            PG8_WAIT_L(8); PG8_BAR; PG8_WAIT_L(0); PG8_MMA(0, 0, At, B0); PG8_BAR; PG8_SCHED;
            PG8_LDB(B1, 0, 1); PG8_STAGE(PG8_SB(0, 0), b2, voffB);
            PG8_BAR; PG8_WAIT_L(0); PG8_MMA(0, 1, At, B1); PG8_BAR;
            PG8_LDA(At, 0, 1); PG8_STAGE(PG8_SA(0, 0), a2, voffA);
            PG8_BAR; PG8_WAIT_L(0); PG8_MMA(1, 0, At, B0); PG8_BAR; PG8_SCHED;
            PG8_STAGE(PG8_SB(0, 1), b2 + hstep, voffB);
            PG8_WAIT_V(6); PG8_BAR; PG8_MMA(1, 1, At, B1); PG8_BAR;
            PG8_LDB(B0, 1, 0); PG8_SCHED; PG8_LDA(At, 1, 0); PG8_STAGE(PG8_SA(0, 1), a2 + hstep, voffA);
            PG8_WAIT_L(8); PG8_BAR; PG8_WAIT_L(0); PG8_MMA(0, 0, At, B0); PG8_BAR; PG8_SCHED;
            PG8_LDB(B1, 1, 1); PG8_STAGE(PG8_SB(1, 0), b3, voffB);
            PG8_BAR; PG8_WAIT_L(0); PG8_MMA(0, 1, At, B1); PG8_BAR;
            PG8_LDA(At, 1, 1); PG8_STAGE(PG8_SA(1, 0), a3, voffA);
            PG8_BAR; PG8_WAIT_L(0); PG8_MMA(1, 0, At, B0); PG8_BAR; PG8_SCHED;
            PG8_STAGE(PG8_SB(1, 1), b3 + hstep, voffB);
            PG8_WAIT_V(6); PG8_BAR; PG8_MMA(1, 1, At, B1); PG8_BAR;
            }
        }
        if constexpr (ALIGN_EPI) { if (wr == 0) PG8_BAR; }
        if constexpr (!Epi::AFTER_DRAIN) { E(acc, cur, wr, wc, fr, fq); S.done(cur); }
        if (!has_next) break;
#pragma unroll
        for (int a = 0; a < 2; ++a)
#pragma unroll
            for (int b = 0; b < 2; ++b)
#pragma unroll
                for (int m = 0; m < 4; ++m)
#pragma unroll
                    for (int n = 0; n < 2; ++n) acc[a][b][m][n] = (f32x4){0.f, 0.f, 0.f, 0.f};
        cur = nxt; cA = nA; cB = nB; ++ui;
        if constexpr (ALIGN_EPI) { if (wr == 1) PG8_BAR; }
    }
    PG8_WAIT_V(0);
    if constexpr (!ALIGN_EPI) { if (wr == 0) PG8_BAR; }
    PG8_BAR;
    if constexpr (Epi::AFTER_DRAIN) { E.fused(acc, cur, wr, wc, fr, fq, lds, wid, lane); S.done(cur); }
#undef PG8_SA
#undef PG8_SB
#undef PG8_STAGE
#undef PG8_LDA
#undef PG8_LDB
#undef PG8_MMA
#undef PG8_WAIT_V
#undef PG8_WAIT_L
#undef PG8_BAR
#undef PG8_SCHED
}
}
#define LAS __attribute__((address_space(3)))
#define XB_TMO      128
#define XB_XCNT(j)  (256  + 64 * (j))
#define XB_XSUB(j)  (1280 + 64 * (j))
#define XB_XGEN(j)  (2304 + 64 * (j))
#define XB_TOP      3328
#define XB_TOPGEN   3392
#define XCD_BAR_WORDS 3456
#define XB_SPIN_CAP (1u << 18)
#define LAS __attribute__((address_space(3)))

__device__ __forceinline__ unsigned xb_ld(unsigned* p)              { return __hip_atomic_load(p, __ATOMIC_RELAXED, __HIP_MEMORY_SCOPE_AGENT); }
__device__ __forceinline__ unsigned xb_add(unsigned* p, unsigned v) { return __hip_atomic_fetch_add(p, v, __ATOMIC_RELAXED, __HIP_MEMORY_SCOPE_AGENT); }
__device__ __forceinline__ unsigned xb_xcc_id() { return (unsigned)__builtin_amdgcn_s_getreg((3 << 11) | 20) & 0xFu; }
#define XB_SPIN(cond, bar) do { unsigned _sp = 0; while (cond) { __builtin_amdgcn_s_sleep(1); \
    if ((++_sp & 255u) == 0u) { if (xb_ld(&(bar)[XB_TMO])) break; if (_sp > XB_SPIN_CAP) { atomicAdd(&(bar)[XB_TMO], 1u); break; } } } } while (0)

struct XcdBarrier {
    unsigned* bar; unsigned x;
    volatile LAS unsigned* st;
};

__device__ __forceinline__ XcdBarrier xcd_barrier_post(unsigned* bar, volatile LAS unsigned* st) {
    XcdBarrier b; b.bar = bar; b.x = xb_xcc_id(); b.st = st;
    if (threadIdx.x == 0) (void)xb_add(&bar[XB_XCNT(b.x)], 1u);
    return b;
}
__device__ __forceinline__ void xcd_barrier_complete(unsigned* bar, unsigned x, unsigned& nloc, unsigned& nx) {
    const unsigned G = gridDim.x * gridDim.y * gridDim.z;
    unsigned sum, cnt, mine, sp = 0u;
    for (;;) {
        sum = 0u; cnt = 0u; mine = 0u;
#pragma unroll
        for (unsigned j = 0; j < 16; ++j) { const unsigned c = xb_ld(&bar[XB_XCNT(j)]); sum += c; cnt += (c > 0u) ? 1u : 0u; mine = (j == x) ? c : mine; }
        if (sum == G) break;
        __builtin_amdgcn_s_sleep(1);
        if ((++sp & 255u) == 0u) { if (xb_ld(&bar[XB_TMO])) break; if (sp > XB_SPIN_CAP) { atomicAdd(&bar[XB_TMO], 1u); break; } }
    }
    nloc = mine > 0u ? mine : 1u; nx = cnt > 0u ? cnt : 1u;
}

__device__ __forceinline__ void xcd_barrier(const XcdBarrier& b) {
    asm volatile("s_waitcnt vmcnt(0)" ::: "memory");
    __syncthreads();
    if (threadIdx.x == 0) {
        unsigned* bar = b.bar;
        __builtin_amdgcn_s_waitcnt(0);
        unsigned nloc = b.st[0], nx = b.st[1];
        if (nloc == 0u) { xcd_barrier_complete(bar, b.x, nloc, nx); b.st[0] = nloc; b.st[1] = nx; }
        const unsigned old = xb_add(&bar[XB_XSUB(b.x)], 1u);
        const unsigned gen = old / nloc;
        if (old + 1u == (gen + 1u) * nloc) {
            __builtin_amdgcn_fence(__ATOMIC_RELEASE, "agent");
            asm volatile("s_waitcnt vmcnt(0)" ::: "memory");
            const unsigned og = xb_add(&bar[XB_TOP], 1u);
            const unsigned tg = og / nx;
            if (og + 1u == (tg + 1u) * nx) xb_add(&bar[XB_TOPGEN], 1u);
            else XB_SPIN(xb_ld(&bar[XB_TOPGEN]) == tg, bar);
            __builtin_amdgcn_fence(__ATOMIC_ACQUIRE, "agent");
            xb_add(&bar[XB_XGEN(b.x)], 1u);
            asm volatile("s_waitcnt vmcnt(0)" ::: "memory");
        } else {
            XB_SPIN(xb_ld(&bar[XB_XGEN(b.x)]) == gen, bar);
            __builtin_amdgcn_fence(__ATOMIC_ACQUIRE, "agent");
            asm volatile("s_waitcnt vmcnt(0)" ::: "memory");
        }
    }
    __syncthreads();
}

constexpr int DM = 2048, NIN = 6144, MP = 32768, MS = 2048, MT = MP + MS, DEPTH = 4;
constexpr int NBP = 8, LP = 4096, NBS = 32, LSQ = 64;
constexpr int COL_Q = 0, COL_K = 1024, COL_V = 2048, COL_ZA = 3072, COL_US = 4096, COL_ZS = 4608, COL_UP = 5120, COL_ZP = 5632;
constexpr float EPSN = 1e-6f, LOG2E = 1.4426950408889634f;
constexpr size_t O_YP = 0, O_YS = O_YP + (size_t)MP * DM, O_KP = O_YS + (size_t)MS * DM, O_VP = O_KP + (size_t)DEPTH * NBP * 512 * 1024,
    O_SRP = O_VP + (size_t)DEPTH * NBP * 512 * 1024, O_SIP = O_SRP + (size_t)DEPTH * NBP * 2048, O_PP = O_SIP + (size_t)DEPTH * NBP * 2048,
    O_KS = O_PP + (size_t)DEPTH * NBP * 15 * 512, O_VS = O_KS + (size_t)DEPTH * NBS * 64 * 1024, O_SRS = O_VS + (size_t)DEPTH * NBS * 64 * 1024,
    O_SIS = O_SRS + (size_t)DEPTH * NBS * 2048, O_PS = O_SIS + (size_t)DEPTH * NBS * 2048, O_END = O_PS + (size_t)DEPTH * NBS * 15 * 512;
enum { I_XP = 0, I_XS, I_CP, I_CS, I_CK, I_CV, I_SRE, I_SIM, I_SPOOL, I_NORMG, I_WADA, I_BADA, I_WIN, I_RELB, I_AR, I_AI, I_LDT, I_BR, I_BI, I_CR, I_CI, I_SD, I_WGLU, I_BGLU,
       I_WPOOL, I_PSCALE, I_BNG, I_WOUT, I_FNG, N_IN };
constexpr size_t MiB = 1u << 20;
constexpr size_t WS_CTL = 0, WS_MOD = 1 * MiB, ZERO_BYTES = 5 * MiB, WS_SSMP = 5 * MiB, SSMP_LAYER = 512 * 1024, WS_WGLU = 7 * MiB, WS_WPOOL = 11 * MiB, WS_SLOC = 12 * MiB,
    WS_WOUT = 20 * MiB, WS_WIN = 52 * MiB, WS_HY = 148 * MiB, WS_PROJ = 284 * MiB, WS_KC = 692 * MiB, WS_VC = 820 * MiB, WS_END = 948 * MiB;
constexpr size_t SSMP_ABAR = 0, SSMP_ABAR64 = 16384, SSMP_BF = 32768, SSMP_CF = 32768 + 131072;
constexpr int CW_BAR = 4096, CW_Q = 16384;
constexpr int LDS_BYTES = 147456, MISC_OFF = LDS_BYTES - 64;
constexpr int NPH = 2 + 5 * DEPTH;

#define GAS __attribute__((address_space(1)))
typedef unsigned short bf16;
typedef unsigned v4u __attribute__((ext_vector_type(4)));
typedef unsigned v2u __attribute__((ext_vector_type(2)));
typedef float f32x4 __attribute__((ext_vector_type(4)));
typedef float f32x16 __attribute__((ext_vector_type(16)));
typedef short bf16x8 __attribute__((ext_vector_type(8)));
typedef short s16x4 __attribute__((ext_vector_type(4)));
typedef float f32x2_t __attribute__((ext_vector_type(2)));
typedef __bf16 bf16x2_t __attribute__((ext_vector_type(2)));
#define DI __device__ __forceinline__
DI unsigned pk2(float lo, float hi) { f32x2_t v = {lo, hi}; bf16x2_t b = __builtin_convertvector(v, bf16x2_t); return __builtin_bit_cast(unsigned, b); }
DI float bflo(unsigned u) { return __uint_as_float(u << 16); }
DI float bfhi(unsigned u) { return __uint_as_float(u & 0xffff0000u); }
DI float ex2(float x) { return __builtin_amdgcn_exp2f(x); }
DI float rcpf_(float x) { return __builtin_amdgcn_rcpf(x); }
DI float silu_f(float z) { return z * rcpf_(1.f + ex2(-LOG2E * z)); }
DI float sigm_f(float z) { return rcpf_(1.f + ex2(-LOG2E * z)); }
DI float gelu_tanh_f(float x) { const float t = x + 0.044715f * x * x * x; return x * rcpf_(1.f + ex2(-(1.5957691216057308f * LOG2E) * t)); }
DI float xh_max(float v) { auto rr = __builtin_amdgcn_permlane32_swap(__float_as_uint(v), __float_as_uint(v), false, false); return fmaxf(__uint_as_float(rr[0]), __uint_as_float(rr[1])); }
DI float xh_sum(float v) { auto rr = __builtin_amdgcn_permlane32_swap(__float_as_uint(v), __float_as_uint(v), false, false); return __uint_as_float(rr[0]) + __uint_as_float(rr[1]); }
DI float wave_sum(float v) {
#pragma unroll
    for (int o = 1; o < 64; o <<= 1) v += __shfl_xor(v, o);
    return v; }
DI f32x16 mfma32(bf16x8 a, bf16x8 b, f32x16 c) { return __builtin_amdgcn_mfma_f32_32x32x16_bf16(a, b, c, 0, 0, 0); }
DI f32x4 mfma16(bf16x8 a, bf16x8 b, f32x4 c) { return __builtin_amdgcn_mfma_f32_16x16x32_bf16(a, b, c, 0, 0, 0); }
typedef short v4i16_t __attribute__((ext_vector_type(4)));
DI s16x4 lds_tr(LAS const unsigned char* p) { return __builtin_bit_cast(s16x4, __builtin_amdgcn_ds_read_tr16_b64_v4i16((LAS v4i16_t*)p)); }
DI bf16x8 zero8() { return (bf16x8){0, 0, 0, 0, 0, 0, 0, 0}; }
DI bf16x8 ld8(const bf16* p) { return *(const bf16x8*)p; }
DI void unpack8(v4u w, float (&f)[8]) { f[0] = bflo(w.x); f[1] = bfhi(w.x); f[2] = bflo(w.y); f[3] = bfhi(w.y); f[4] = bflo(w.z); f[5] = bfhi(w.z); f[6] = bflo(w.w); f[7] = bfhi(w.w); }

struct Args { const float* in[N_IN]; float* out; unsigned char* ws; int ph_lo, ph_hi; };
static_assert(sizeof(Args) == (N_IN + 2) * 8 + 8, "Args has no padding");

DI int otid() { int t = threadIdx.x; asm volatile("" : "+v"(t)); return t; }
struct Ctx {
    const float* const* in; float* out; unsigned char* ws; LAS unsigned char* lds;
    int tid, lane, wave, G, bid;
    bf16* HY; bf16* PROJ; bf16* KC; bf16* VC; bf16* WIN; bf16* WOUT; float* MOD; unsigned* ctl;
};

DI void fresh(Ctx& C) { C.tid = otid(); C.lane = C.tid & 63; C.wave = __builtin_amdgcn_readfirstlane(C.tid >> 6); }
DI void p0_mod_unit(const Ctx& C0, int u) {
    Ctx C = C0; fresh(C);
    const int l = u / 96, rem = u % 96, cb = rem >> 3, ke = rem & 7, k0 = ke * 256;
    LAS float* sc = (LAS float*)C.lds;
    for (int idx = C.tid; idx < 256 * 40; idx += 512) { const int r = idx >> 8, kk = idx & 255;
        const float cv = (r < 8) ? C.in[I_CP][r * DM + k0 + kk] : C.in[I_CS][(r - 8) * DM + k0 + kk]; sc[kk * 40 + r] = silu_f(cv); }
    __syncthreads();
    const int j = cb * 512 + C.tid;
    const float* W = C.in[I_WADA] + (size_t)l * DM * NIN + (size_t)k0 * NIN + j;
    float acc[40];
#pragma unroll
    for (int r = 0; r < 40; ++r) acc[r] = 0.f;
    for (int kk = 0; kk < 256; kk += 4) {
        float w[4];
#pragma unroll
        for (int q = 0; q < 4; ++q) w[q] = W[(size_t)(kk + q) * NIN];
#pragma unroll
        for (int q = 0; q < 4; ++q) { const LAS f32x4* s = (const LAS f32x4*)(sc + (kk + q) * 40);
#pragma unroll
            for (int t = 0; t < 10; ++t) { const f32x4 v = s[t]; acc[4 * t] += v.x * w[q]; acc[4 * t + 1] += v.y * w[q]; acc[4 * t + 2] += v.z * w[q]; acc[4 * t + 3] += v.w * w[q]; } }
    }
    float* M = (float*)(C.ws + WS_MOD) + (size_t)l * 40 * NIN + j;
    const float bias = (ke == 0) ? C.in[I_BADA][l * NIN + j] : 0.f;
#pragma unroll
    for (int r = 0; r < 40; ++r) unsafeAtomicAdd(M + (size_t)r * NIN, acc[r] + bias);
    __syncthreads();
}
DI void p0_transpose_item(const float* W, int K, int N, bf16* WT, LAS float* scr, int item, int lane) {
    const int nblk = N / 32, kb = item / nblk, nb = item % nblk, k0 = 64 * kb, n0 = 32 * nb;
#pragma unroll 8
    for (int i = 0; i < 32; ++i) { const int kk = 2 * i + (lane >> 5); scr[kk * 33 + (lane & 31)] = W[(size_t)(k0 + kk) * N + n0 + (lane & 31)]; }
    asm volatile("s_waitcnt lgkmcnt(0)" ::: "memory");
    const int c = lane & 7;
#pragma unroll
    for (int j = 0; j < 4; ++j) { const int n = (lane >> 3) + 8 * j; const LAS float* s = scr + (8 * c) * 33 + n;
        v4u o; o.x = pk2(s[0 * 33], s[1 * 33]); o.y = pk2(s[2 * 33], s[3 * 33]); o.z = pk2(s[4 * 33], s[5 * 33]); o.w = pk2(s[6 * 33], s[7 * 33]);
        *(v4u*)(WT + (size_t)(n0 + n) * K + k0 + 8 * c) = o; }
    asm volatile("s_waitcnt lgkmcnt(0)" ::: "memory");
}
DI void p0_ssm_params(const Ctx& C, int l, int g, int lane) {
    unsigned char* blk = C.ws + WS_SSMP + (size_t)l * SSMP_LAYER;
    const int gp = (l * 32 + g) * 64 + lane;
    const float dt = expf(C.in[I_LDT][l * 32 + g]);
    const float ar = C.in[I_AR][gp], ai = C.in[I_AI][gp];
    const float x = ar * dt, ang = ai * dt;
    float sn, cs; sincosf(ang, &sn, &cs);
    const float mag = expf(x), em1 = expm1f(x);
    const float abr = mag * cs, abi = mag * sn;
    float sh, ch; sincosf(0.5f * ang, &sh, &ch); (void)ch;
    const float nr = em1 * cs - 2.f * sh * sh, ni = abi;
    const float den = ar * ar + ai * ai;
    const float cr = (nr * ar + ni * ai) / den, ci = (ni * ar - nr * ai) / den;
    float* AB = (float*)(blk + SSMP_ABAR) + g * 128; AB[lane] = abr; AB[64 + lane] = abi;
    { float s64, c64; sincosf(64.f * ang, &s64, &c64); const float m64 = expf(64.f * x); float* A6 = (float*)(blk + SSMP_ABAR64) + g * 128; A6[lane] = m64 * c64; A6[64 + lane] = m64 * s64; }
    const float* br = C.in[I_BR] + (size_t)gp * 16; const float* bi = C.in[I_BI] + (size_t)gp * 16;
    float bbr[16], bbi[16];
#pragma unroll
    for (int c = 0; c < 16; ++c) { const float b_r = br[c], b_i = bi[c]; bbr[c] = cr * b_r - ci * b_i; bbi[c] = cr * b_i + ci * b_r; }
    v4u* BF = (v4u*)(blk + SSMP_BF) + (size_t)g * 4 * 64;
#pragma unroll
    for (int half = 0; half < 2; ++half) {
        v4u o; o.x = pk2(bbr[8 * half], bbr[8 * half + 1]); o.y = pk2(bbr[8 * half + 2], bbr[8 * half + 3]); o.z = pk2(bbr[8 * half + 4], bbr[8 * half + 5]); o.w = pk2(bbr[8 * half + 6], bbr[8 * half + 7]);
        BF[(0 + half) * 64 + lane] = o;
        o.x = pk2(bbi[8 * half], bbi[8 * half + 1]); o.y = pk2(bbi[8 * half + 2], bbi[8 * half + 3]); o.z = pk2(bbi[8 * half + 4], bbi[8 * half + 5]); o.w = pk2(bbi[8 * half + 6], bbi[8 * half + 7]);
        BF[(2 + half) * 64 + lane] = o; }
    v4u* CF = (v4u*)(blk + SSMP_CF) + (size_t)g * 4 * 64;
    const int c = lane & 15, kq = lane >> 4;
    const float* crp = C.in[I_CR] + ((size_t)(l * 32 + g) * 16 + c) * 64; const float* cip = C.in[I_CI] + ((size_t)(l * 32 + g) * 16 + c) * 64;
#pragma unroll
    for (int kap = 0; kap < 4; ++kap) { const int p0 = 16 * kap + 4 * kq;
        v4u o; o.x = pk2(crp[p0], -cip[p0]); o.y = pk2(crp[p0 + 1], -cip[p0 + 1]); o.z = pk2(crp[p0 + 2], -cip[p0 + 2]); o.w = pk2(crp[p0 + 3], -cip[p0 + 3]);
        CF[kap * 64 + lane] = o; }
}
DI void p0_prologue(const Ctx& C0) {
    for (int u = C0.bid; u < 384; u += C0.G) p0_mod_unit(C0, u);
    __syncthreads();
    Ctx C = C0; fresh(C);
    const int gw = C.bid * 8 + C.wave, NGW = C.G * 8, lane = C.lane;
    LAS float* scr = (LAS float*)(C.lds + C.wave * 16384);
    constexpr int I_IN = (DM / 64) * (NIN / 32), I_OUT = (DM / 64) * (DM / 32);
    for (int it = gw; it < DEPTH * (I_IN + I_OUT); it += NGW) {
        const int l = it / (I_IN + I_OUT), r = it % (I_IN + I_OUT);
        if (r < I_IN) p0_transpose_item(C.in[I_WIN] + (size_t)l * DM * NIN, DM, NIN, C.WIN + (size_t)l * NIN * DM, scr, r, lane);
        else p0_transpose_item(C.in[I_WOUT] + (size_t)l * DM * DM, DM, DM, C.WOUT + (size_t)l * DM * DM, scr, r - I_IN, lane);
    }
    for (int it = gw; it < DEPTH * 1024; it += NGW) { const int l = it >> 10, ct = (it >> 5) & 31, kap = it & 31;
        const float* w = C.in[I_WGLU] + (size_t)l * 512 * 1024 + (size_t)(16 * kap + 8 * (lane >> 5)) * 1024 + 32 * ct + (lane & 31);
        v4u o; o.x = pk2(w[0], w[1024]); o.y = pk2(w[2048], w[3072]); o.z = pk2(w[4096], w[5120]); o.w = pk2(w[6144], w[7168]);
        ((v4u*)(C.ws + WS_WGLU))[(size_t)it * 64 + lane] = o; }
    for (int it = gw; it < DEPTH * 128; it += NGW) { const int lg = it >> 5, ct = (it >> 3) & 3, kap = it & 7;
        const float* w = C.in[I_WPOOL] + (size_t)lg * 128 * 128 + (size_t)(16 * kap + 8 * (lane >> 5)) * 128 + 32 * ct + (lane & 31);
        v4u o; o.x = pk2(w[0], w[128]); o.y = pk2(w[256], w[384]); o.z = pk2(w[512], w[640]); o.w = pk2(w[768], w[896]);
        ((v4u*)(C.ws + WS_WPOOL))[(size_t)it * 64 + lane] = o; }
    for (int it = gw; it < DEPTH * 32; it += NGW) p0_ssm_params(C, it >> 5, it & 31, lane);
    { const size_t n8 = (size_t)DEPTH * NBS * 512 * 1024 / 8; const size_t stride = (size_t)C.G * 512;
      for (size_t i = (size_t)C.bid * 512 + C.tid; i < 2 * n8; i += stride) { const bool isv = i >= n8; const size_t e = (isv ? i - n8 : i) * 8;
          const float* s = (isv ? C.in[I_CV] : C.in[I_CK]) + e; const f32x4 a = *(const f32x4*)s, b = *(const f32x4*)(s + 4);
          v4u o; o.x = pk2(a.x, a.y); o.y = pk2(a.z, a.w); o.z = pk2(b.x, b.y); o.w = pk2(b.z, b.w); *(v4u*)((isv ? C.VC : C.KC) + e) = o; } }
}

DI void norm_phase(const Ctx& C0, int l) {
    Ctx C = C0; fresh(C);
    const int gw = C.bid * 8 + C.wave, NGW = C.G * 8, lane = C.lane;
    const int rpw = (MT + NGW - 1) / NGW;
    const bool fin = (l == DEPTH);
    const float* gvec = fin ? C.in[I_FNG] : C.in[I_NORMG] + (size_t)l * DM;
    for (int i = 0; i < rpw; ++i) { const int m = gw * rpw + i; if (m >= MT) break;
        const float* xr = (l == 0) ? (m < MP ? C.in[I_XP] + (size_t)m * DM : C.in[I_XS] + (size_t)(m - MP) * DM) : C.out + (size_t)m * DM;
        const f32x4* x4 = (const f32x4*)xr + lane;
        f32x4 v[8]; float s = 0.f;
#pragma unroll
        for (int j = 0; j < 8; ++j) { v[j] = x4[64 * j]; s += (v[j].x * v[j].x + v[j].y * v[j].y) + (v[j].z * v[j].z + v[j].w * v[j].w); }
        const float rstd = rsqrtf(wave_sum(s) * (1.f / DM) + EPSN);
        if (fin) { f32x4* o4 = (f32x4*)(C.out + (size_t)m * DM) + lane;
#pragma unroll
            for (int j = 0; j < 8; ++j) { const f32x4 g = ((const f32x4*)gvec)[lane + 64 * j]; o4[64 * j] = v[j] * rstd * g; } }
        else { const int brow = (m < MP) ? (m >> 12) : 8 + ((m - MP) >> 6);
            const float* md = C.MOD + ((size_t)l * 40 + brow) * NIN;
            v2u* o8 = (v2u*)(C.HY + (size_t)m * DM) + lane;
#pragma unroll
            for (int j = 0; j < 8; ++j) { const f32x4 g = ((const f32x4*)gvec)[lane + 64 * j], sh = ((const f32x4*)md)[lane + 64 * j], sc = ((const f32x4*)(md + DM))[lane + 64 * j];
                const f32x4 h = v[j] * rstd * g * (sc + 1.f) + sh; v2u o; o.x = pk2(h.x, h.y); o.y = pk2(h.z, h.w); o8[64 * j] = o; } }
    }
}

constexpr int ROWP = 1040;
DI void branch_tail(const Ctx& C, int l, int row0, LAS unsigned char* ST, LAS float* ssq, LAS float* rstd_l, int zcol, int ycol) {
    if (C.tid < 64) { float t = 0.f;
#pragma unroll
        for (int w = 0; w < 8; ++w) t += ssq[w * 64 + C.tid];
        rstd_l[C.tid] = rsqrtf(t * (1.f / 512.f) + EPSN); }
    __syncthreads();
    const float* gb = C.in[I_BNG] + (size_t)l * DM + ycol;
#pragma unroll 2
    for (int it = 0; it < 8; ++it) { const int idx = C.tid + 512 * it, row = idx >> 6, ch = idx & 63;
        const v4u raw = *(const LAS v4u*)(ST + row * ROWP + ch * 16);
        const v4u zz = *(const v4u*)(C.PROJ + (size_t)(row0 + row) * NIN + zcol + ch * 8);
        const f32x4 g0 = *(const f32x4*)(gb + ch * 8), g1 = *(const f32x4*)(gb + ch * 8 + 4);
        float r[8], z[8]; unpack8(raw, r); unpack8(zz, z); const float rs = rstd_l[row];
        const float gg[8] = {g0.x, g0.y, g0.z, g0.w, g1.x, g1.y, g1.z, g1.w}; float o[8];
#pragma unroll
        for (int e = 0; e < 8; ++e) o[e] = r[e] * rs * gg[e] * silu_f(z[e]);
        v4u w; w.x = pk2(o[0], o[1]); w.y = pk2(o[2], o[3]); w.z = pk2(o[4], o[5]); w.w = pk2(o[6], o[7]);
        *(v4u*)(C.HY + (size_t)(row0 + row) * DM + ycol + ch * 8) = w; }
    __syncthreads();
}

struct SsmGroup { float ar, ai; bf16x8 bf[4]; };
DI void ssm_load_group(const Ctx& C, int l, int g, int lane, SsmGroup& S) {
    const unsigned char* blk = C.ws + WS_SSMP + (size_t)l * SSMP_LAYER;
    const float* AB = (const float*)(blk + SSMP_ABAR) + g * 128; S.ar = AB[lane]; S.ai = AB[64 + lane];
    const bf16x8* BF = (const bf16x8*)(blk + SSMP_BF) + (size_t)g * 4 * 64;
#pragma unroll
    for (int f = 0; f < 4; ++f) S.bf[f] = BF[f * 64 + lane];
}
DI void ssm_bu_block(const Ctx& C, const SsmGroup& S, int rowblk, int g, int lane, f32x16& dre, f32x16& dim) {
    const int i = lane & 31, kh = lane >> 5, ti = 4 * (i >> 3) + (i & 3); const bool act = ((i >> 2) & 1) == kh;
    const bf16* src = C.PROJ + (size_t)(rowblk + ti) * NIN + COL_US + 16 * g;
    bf16x8 a0 = ld8(src), a1 = ld8(src + 8);
    if (!act) { a0 = zero8(); a1 = zero8(); }
    const f32x16 z = {};
    dre = mfma32(a0, S.bf[0], z); dre = mfma32(a1, S.bf[1], dre);
    dim = mfma32(a0, S.bf[2], z); dim = mfma32(a1, S.bf[3], dim);
}
DI void ssm_local_unit(const Ctx& C0, int l, int u) {
    Ctx C = C0; fresh(C);
    const int lane = C.lane, row0 = (u >> 6) * LP + (u & 63) * 64;
    float* SL = (float*)(C.ws + WS_SLOC) + (size_t)u * 4096;
    for (int gi = 0; gi < 4; ++gi) { const int g = C.wave * 4 + gi;
        SsmGroup S; ssm_load_group(C, l, g, lane, S);
        float hr = 0.f, hi = 0.f;
        for (int blk = 0; blk < 4; ++blk) { f32x16 dre, dim; ssm_bu_block(C, S, row0 + 16 * blk, g, lane, dre, dim);
#pragma unroll
            for (int r = 0; r < 16; ++r) { const float nr = S.ar * hr - S.ai * hi + dre[r], ni = S.ar * hi + S.ai * hr + dim[r]; hr = nr; hi = ni; } }
        SL[g * 64 + lane] = hr; SL[2048 + g * 64 + lane] = hi; }
}
DI void ssm_main_unit(const Ctx& C0, int l, int u) {
    Ctx C = C0; fresh(C);
    const int lane = C.lane, wave = C.wave; const bool samp = u >= 512;
    const int b = samp ? u - 512 : (u >> 6), n = samp ? 0 : (u & 63), row0 = samp ? MP + 64 * b : b * LP + 64 * n;
    LAS unsigned char* GG = C.lds; LAS unsigned char* HT = C.lds + 64 * ROWP + wave * 4352;
    LAS float* ssq = (LAS float*)(C.lds + 64 * ROWP + 8 * 4352); LAS float* rstd_l = ssq + 512;
    const unsigned char* blk_p = C.ws + WS_SSMP + (size_t)l * SSMP_LAYER;
#pragma unroll 1
    for (int gi = 0; gi < 4; ++gi) { const int g = wave * 4 + gi;
        SsmGroup S; ssm_load_group(C, l, g, lane, S);
        bf16x8 cf[4]; { const bf16x8* CF = (const bf16x8*)(blk_p + SSMP_CF) + (size_t)g * 4 * 64;
#pragma unroll
            for (int k = 0; k < 4; ++k) cf[k] = CF[k * 64 + lane]; }
        const int t16 = lane & 15, kq = lane >> 4;
        const f32x4 dsk = *(const f32x4*)(C.in[I_SD] + (size_t)(l * 32 + g) * 16 + 4 * kq);
        float hr, hi;
        if (samp) { hr = C.in[I_SRE][((size_t)(l * NBS + b) * 32 + g) * 64 + lane]; hi = C.in[I_SIM][((size_t)(l * NBS + b) * 32 + g) * 64 + lane]; }
        else { const float* A6 = (const float*)(blk_p + SSMP_ABAR64) + g * 128; const float a6r = A6[lane], a6i = A6[64 + lane]; hr = 0.f; hi = 0.f;
            const float* SL = (const float*)(C.ws + WS_SLOC) + (size_t)(b * 64) * 4096 + g * 64 + lane;
            for (int j = 0; j < n; ++j) { const float sr = SL[(size_t)j * 4096], si = SL[(size_t)j * 4096 + 2048];
                const float nr = a6r * hr - a6i * hi + sr, ni = a6r * hi + a6i * hr + si; hr = nr; hi = ni; } }
#pragma unroll 1
        for (int blk = 0; blk < 4; ++blk) { f32x16 dre, dim; ssm_bu_block(C, S, row0 + 16 * blk, g, lane, dre, dim);
#pragma unroll
            for (int r = 0; r < 16; ++r) { const float nr = S.ar * hr - S.ai * hi + dre[r], ni = S.ar * hi + S.ai * hr + dim[r]; hr = nr; hi = ni;
                *(LAS unsigned*)(HT + r * 272 + lane * 4) = pk2(nr, ni); }
            f32x4 yt = {0.f, 0.f, 0.f, 0.f};
#pragma unroll
            for (int k = 0; k < 4; ++k) { const bf16x8 hb = *(const LAS bf16x8*)(HT + t16 * 272 + (32 * k + 8 * kq) * 2); yt = mfma16(cf[k], hb, yt); }
            const v2u uu = *(const v2u*)(C.PROJ + (size_t)(row0 + 16 * blk + t16) * NIN + COL_US + 16 * g + 4 * kq);
            const float y0 = gelu_tanh_f(yt[0] + dsk[0] * bflo(uu.x)), y1 = gelu_tanh_f(yt[1] + dsk[1] * bfhi(uu.x)), y2 = gelu_tanh_f(yt[2] + dsk[2] * bflo(uu.y)), y3 = gelu_tanh_f(yt[3] + dsk[3] * bfhi(uu.y));
            v2u o; o.x = pk2(y0, y1); o.y = pk2(y2, y3);
            *(LAS v2u*)(GG + (16 * blk + t16) * ROWP + (16 * g + 4 * kq) * 2) = o; }
        if (samp || n == 63) { float* ore = C.out + (samp ? O_SRS + ((size_t)(l * NBS + b) * 2048) : O_SRP + ((size_t)(l * NBP + b) * 2048)) + g * 64 + lane;
            float* oim = C.out + (samp ? O_SIS + ((size_t)(l * NBS + b) * 2048) : O_SIP + ((size_t)(l * NBP + b) * 2048)) + g * 64 + lane; *ore = hr; *oim = hi; }
    }
    __syncthreads();
    const int hi5 = lane >> 5, r32 = lane & 31;
    f32x16 acc[4][2];
#pragma unroll
    for (int c = 0; c < 4; ++c) { acc[c][0] = f32x16{}; acc[c][1] = f32x16{}; }
    const bf16x8* WG = (const bf16x8*)(C.ws + WS_WGLU) + (size_t)l * 1024 * 64 + lane;
#pragma unroll 2
    for (int kap = 0; kap < 32; ++kap) {
        bf16x8 af[4], bt[2];
#pragma unroll
        for (int c = 0; c < 4; ++c) { const int ct = (c < 2) ? (2 * wave + c) : (16 + 2 * wave + (c - 2)); af[c] = WG[(size_t)(ct * 32 + kap) * 64]; }
#pragma unroll
        for (int tt = 0; tt < 2; ++tt) bt[tt] = *(const LAS bf16x8*)(GG + (32 * tt + r32) * ROWP + (16 * kap + 8 * hi5) * 2);
#pragma unroll
        for (int c = 0; c < 4; ++c)
#pragma unroll
            for (int tt = 0; tt < 2; ++tt) acc[c][tt] = mfma32(af[c], bt[tt], acc[c][tt]);
    }
    const float* bg = C.in[I_BGLU] + (size_t)l * 1024;
    float sq[2] = {0.f, 0.f};
#pragma unroll
    for (int c = 0; c < 2; ++c)
#pragma unroll
        for (int rr = 0; rr < 4; ++rr) { const int ch0 = 64 * wave + 32 * c + 8 * rr + 4 * hi5; const f32x4 bv = *(const f32x4*)(bg + ch0), bgt = *(const f32x4*)(bg + 512 + ch0);
#pragma unroll
            for (int tt = 0; tt < 2; ++tt)
#pragma unroll
                for (int e = 0; e < 4; ++e) { const float o = (acc[c][tt][4 * rr + e] + bv[e]) * sigm_f(acc[2 + c][tt][4 * rr + e] + bgt[e]); acc[c][tt][4 * rr + e] = o; sq[tt] += o * o; } }
#pragma unroll
    for (int tt = 0; tt < 2; ++tt) { const float t = xh_sum(sq[tt]); if (hi5 == 0) ssq[wave * 64 + 32 * tt + r32] = t; }
    __syncthreads();
#pragma unroll
    for (int c = 0; c < 2; ++c)
#pragma unroll
        for (int rr = 0; rr < 4; ++rr) { const int ch0 = 64 * wave + 32 * c + 8 * rr + 4 * hi5;
#pragma unroll
            for (int tt = 0; tt < 2; ++tt) { v2u o; o.x = pk2(acc[c][tt][4 * rr], acc[c][tt][4 * rr + 1]); o.y = pk2(acc[c][tt][4 * rr + 2], acc[c][tt][4 * rr + 3]);
                *(LAS v2u*)(GG + (32 * tt + r32) * ROWP + ch0 * 2) = o; } }
    __syncthreads();
    branch_tail(C, l, row0, GG, ssq, rstd_l, COL_ZS, 1024);
}

DI void pool_unit(const Ctx& C0, int l, int u) {
    Ctx C = C0; fresh(C);
    const int lane = C.lane, wave = C.wave; const bool samp = u >= 512;
    const int b = samp ? u - 512 : (u >> 6), n = samp ? 0 : (u & 63), row0 = samp ? MP + 64 * b : b * LP + 64 * n;
    LAS unsigned char* DF = C.lds; LAS float* ssq = (LAS float*)(C.lds + 64 * ROWP); LAS float* rstd_l = ssq + 512;
    { const int gi = wave >> 1, w = 2 << gi, ch0 = 128 * gi + 8 * (lane & 15);
      const bool last = samp || n == 63;
      float* po = C.out + (samp ? O_PS + (size_t)(l * NBS + b) * 15 * 512 : O_PP + (size_t)(l * NBP + b) * 15 * 512);
      const float* sp = C.in[I_SPOOL] + (size_t)(l * NBS + b) * 15 * 512;
      for (int it = 0; it < 8; ++it) { const int t = (wave & 1) * 32 + 4 * it + (lane >> 4);
          float sum[8], tok[8];
#pragma unroll
          for (int e = 0; e < 8; ++e) sum[e] = 0.f;
          for (int j = 0; j < w; ++j) { const int rel = t - j; float v[8];
              if (rel >= 0 || (!samp && n > 0)) { unpack8(*(const v4u*)(C.PROJ + (size_t)(row0 + rel) * NIN + COL_UP + ch0), v); }
              else if (samp) { const float* s = sp + (size_t)(15 + rel) * 512 + ch0; const f32x4 a = *(const f32x4*)s, c4 = *(const f32x4*)(s + 4); v[0] = a.x; v[1] = a.y; v[2] = a.z; v[3] = a.w; v[4] = c4.x; v[5] = c4.y; v[6] = c4.z; v[7] = c4.w; }
              else {
#pragma unroll
                  for (int e = 0; e < 8; ++e) v[e] = 0.f; }
#pragma unroll
              for (int e = 0; e < 8; ++e) { sum[e] += v[e]; if (j == 0) tok[e] = v[e]; } }
          const int pos = 64 * n + t; const float cnt = samp ? (float)w : (float)((pos + 1 < w) ? pos + 1 : w), ic = 1.f / cnt;
          float d[8];
#pragma unroll
          for (int e = 0; e < 8; ++e) d[e] = sum[e] * ic - tok[e];
          v4u o; o.x = pk2(d[0], d[1]); o.y = pk2(d[2], d[3]); o.z = pk2(d[4], d[5]); o.w = pk2(d[6], d[7]);
          *(LAS v4u*)(DF + t * ROWP + ch0 * 2) = o;
          if (last && t >= 49) { float* p = po + (size_t)(t - 49) * 512 + ch0; *(f32x4*)p = (f32x4){tok[0], tok[1], tok[2], tok[3]}; *(f32x4*)(p + 4) = (f32x4){tok[4], tok[5], tok[6], tok[7]}; } } }
    __syncthreads();
    const int hi5 = lane >> 5, r32 = lane & 31, gi = wave >> 1;
    f32x16 acc[2][2];
#pragma unroll
    for (int c = 0; c < 2; ++c) { acc[c][0] = f32x16{}; acc[c][1] = f32x16{}; }
    const bf16x8* WP = (const bf16x8*)(C.ws + WS_WPOOL) + (size_t)((l * 4 + gi) * 32) * 64 + lane;
#pragma unroll
    for (int kap = 0; kap < 8; ++kap) { bf16x8 af[2], bt[2];
#pragma unroll
        for (int c = 0; c < 2; ++c) af[c] = WP[(size_t)((2 * (wave & 1) + c) * 8 + kap) * 64];
#pragma unroll
        for (int tt = 0; tt < 2; ++tt) bt[tt] = *(const LAS bf16x8*)(DF + (32 * tt + r32) * ROWP + (128 * gi + 16 * kap + 8 * hi5) * 2);
#pragma unroll
        for (int c = 0; c < 2; ++c)
#pragma unroll
            for (int tt = 0; tt < 2; ++tt) acc[c][tt] = mfma32(af[c], bt[tt], acc[c][tt]); }
    const float* ps = C.in[I_PSCALE] + (size_t)l * 512;
    float sq[2] = {0.f, 0.f};
#pragma unroll
    for (int c = 0; c < 2; ++c)
#pragma unroll
        for (int rr = 0; rr < 4; ++rr) { const int d0 = 128 * gi + 32 * (2 * (wave & 1) + c) + 8 * rr + 4 * hi5; const f32x4 sc = *(const f32x4*)(ps + d0);
#pragma unroll
            for (int tt = 0; tt < 2; ++tt)
#pragma unroll
                for (int e = 0; e < 4; ++e) { const float o = acc[c][tt][4 * rr + e] * sc[e]; acc[c][tt][4 * rr + e] = o; sq[tt] += o * o; } }
#pragma unroll
    for (int tt = 0; tt < 2; ++tt) { const float t = xh_sum(sq[tt]); if (hi5 == 0) ssq[wave * 64 + 32 * tt + r32] = t; }
    __syncthreads();
#pragma unroll
    for (int c = 0; c < 2; ++c)
#pragma unroll
        for (int rr = 0; rr < 4; ++rr) { const int d0 = 128 * gi + 32 * (2 * (wave & 1) + c) + 8 * rr + 4 * hi5;
#pragma unroll
            for (int tt = 0; tt < 2; ++tt) { v2u o; o.x = pk2(acc[c][tt][4 * rr], acc[c][tt][4 * rr + 1]); o.y = pk2(acc[c][tt][4 * rr + 2], acc[c][tt][4 * rr + 3]);
                *(LAS v2u*)(DF + (32 * tt + r32) * ROWP + d0 * 2) = o; } }
    __syncthreads();
    branch_tail(C, l, row0, DF, ssq, rstd_l, COL_ZP, 1536);
}

constexpr int ATT_WB = 10752;
DI void attn_unit(const Ctx& C0, int l, int u) {
    Ctx C = C0; fresh(C);
    const int lane = C.lane, wave = C.wave, r32 = lane & 31, hi = lane >> 5; const bool samp = u < 32;
    const int b = samp ? u : ((u - 32) & 7), n = samp ? 16 : 63 - ((u - 32) >> 3), rq0 = samp ? MP + 64 * b : b * LP + 64 * n;
    const int jstart = samp ? 0 : (n >= 8 ? 0 : 8 - n);
    LAS unsigned char* WL = C.lds + wave * ATT_WB; LAS float* TAB = (LAS float*)(WL + 9216);
    LAS float* ssq = (LAS float*)(C.lds + 8 * ATT_WB); LAS float* rstd_l = ssq + 512;
    const float c1 = 0.125f * LOG2E;
    float ssq_acc[2] = {0.f, 0.f};
    for (int hh = 0; hh < 2; ++hh) { const int h = 2 * wave + hh;
        { const float* rb = C.in[I_RELB] + (size_t)(l * 16 + h) * 513;
#pragma unroll
          for (int k = 0; k < 6; ++k) { const int y = lane + 64 * k; TAB[y] = rb[y < 64 ? 512 : 576 - y] * LOG2E; } }
        const float bconst = C.in[I_RELB][(size_t)(l * 16 + h) * 513 + 512] * LOG2E;
        const bf16* qp = C.PROJ + (size_t)(rq0 + r32) * NIN + COL_Q + h * 64 + 8 * hi;
        f32x16 O[2][2];
#pragma unroll
        for (int db = 0; db < 2; ++db) { O[db][0] = f32x16{}; O[db][1] = f32x16{}; }
        float mrun[2] = {-1e30f, -1e30f}, lrun[2] = {0.f, 0.f};
        for (int j = jstart; j < 9; ++j) {
            const bf16* kp; const bf16* vp; int pitch;
            if (samp && j < 8) { const size_t o = ((size_t)(l * NBS + b) * 512 + 64 * j) * 1024 + h * 64; kp = C.KC + o; vp = C.VC + o; pitch = 1024; }
            else { const size_t row = samp ? (size_t)rq0 : (size_t)(b * LP + 64 * (n - 8 + j)); kp = C.PROJ + row * NIN + COL_K + h * 64; vp = C.PROJ + row * NIN + COL_V + h * 64; pitch = NIN; }
            asm volatile("s_waitcnt lgkmcnt(0)" ::: "memory");
#pragma unroll
            for (int pc = 0; pc < 8; ++pc)
                __builtin_amdgcn_global_load_lds((const unsigned*)(vp + (size_t)(16 * (pc & 3) + (lane >> 2)) * pitch + (pc >> 2) * 32 + (lane & 3) * 8), (LAS unsigned*)(WL + pc * 1024), 16, 0, 0);
            f32x16 S[2][2];
#pragma unroll
            for (int kb = 0; kb < 2; ++kb) { S[kb][0] = f32x16{}; S[kb][1] = f32x16{}; }
#pragma unroll
            for (int k = 0; k < 4; ++k) { const bf16x8 q0 = ld8(qp + 16 * k), q1 = ld8(qp + (size_t)32 * NIN + 16 * k);
#pragma unroll
                for (int kb = 0; kb < 2; ++kb) { const bf16x8 kf = ld8(kp + (size_t)(32 * kb + r32) * pitch + 16 * k + 8 * hi);
                    S[kb][0] = mfma32(kf, q0, S[kb][0]); S[kb][1] = mfma32(kf, q1, S[kb][1]); } }
            bf16x8 pf[2][4];
            const int L0 = 64 * (8 - j);
#pragma unroll
            for (int qb = 0; qb < 2; ++qb) {
                __builtin_amdgcn_sched_barrier(0);
                float mx = -1e30f;
                if (j <= 3) {
#pragma unroll
                    for (int kb = 0; kb < 2; ++kb)
#pragma unroll
                        for (int r = 0; r < 16; ++r) { const float s = S[kb][qb][r] * c1 + bconst; S[kb][qb][r] = s; mx = fmaxf(mx, s); }
                } else {
                    const int ybase = 320 - L0 - (32 * qb + r32) + 4 * hi;
#pragma unroll
                    for (int kb = 0; kb < 2; ++kb)
#pragma unroll
                        for (int r = 0; r < 16; ++r) { const float s = S[kb][qb][r] * c1 + TAB[ybase + 32 * kb + 8 * (r >> 2) + (r & 3)]; S[kb][qb][r] = s; mx = fmaxf(mx, s); }
                }
                mx = xh_max(mx);
                const float mnew = fmaxf(mrun[qb], mx), alpha = ex2(mrun[qb] - mnew); mrun[qb] = mnew;
                float rs = 0.f;
#pragma unroll
                for (int kb = 0; kb < 2; ++kb)
#pragma unroll
                    for (int r = 0; r < 16; ++r) { const float p = ex2(S[kb][qb][r] - mnew); S[kb][qb][r] = p; rs += p; }
                lrun[qb] = lrun[qb] * alpha + rs;
#pragma unroll
                for (int db = 0; db < 2; ++db)
#pragma unroll
                    for (int r = 0; r < 16; ++r) O[db][qb][r] *= alpha;
#pragma unroll
                for (int ks = 0; ks < 4; ++ks) { const int kb = ks >> 1, s8 = 8 * (ks & 1); v4u w;
                    w.x = pk2(S[kb][qb][s8], S[kb][qb][s8 + 1]); w.y = pk2(S[kb][qb][s8 + 2], S[kb][qb][s8 + 3]); w.z = pk2(S[kb][qb][s8 + 4], S[kb][qb][s8 + 5]); w.w = pk2(S[kb][qb][s8 + 6], S[kb][qb][s8 + 7]);
                    pf[qb][ks] = __builtin_bit_cast(bf16x8, w); }
            }
            __builtin_amdgcn_sched_barrier(0);
            asm volatile("s_waitcnt vmcnt(0)" ::: "memory");
            LAS const unsigned char* vb = WL + (4 * hi + ((lane & 15) >> 2)) * 64 + ((lane >> 4) & 1) * 32 + (lane & 3) * 8;
#pragma unroll
            for (int ks = 0; ks < 4; ++ks)
#pragma unroll
                for (int db = 0; db < 2; ++db) { const s16x4 lo = lds_tr(vb + db * 4096 + ks * 1024), up = lds_tr(vb + db * 4096 + ks * 1024 + 512);
                    const bf16x8 vf = {lo[0], lo[1], lo[2], lo[3], up[0], up[1], up[2], up[3]};
                    O[db][0] = mfma32(vf, pf[0][ks], O[db][0]); O[db][1] = mfma32(vf, pf[1][ks], O[db][1]); }
        }
#pragma unroll
        for (int qb = 0; qb < 2; ++qb) { const float inv = 1.f / xh_sum(lrun[qb]); float sq = 0.f;
#pragma unroll
            for (int db = 0; db < 2; ++db)
#pragma unroll
                for (int rr = 0; rr < 4; ++rr) { float o[4];
#pragma unroll
                    for (int e = 0; e < 4; ++e) { o[e] = O[db][qb][4 * rr + e] * inv; sq += o[e] * o[e]; }
                    v2u w; w.x = pk2(o[0], o[1]); w.y = pk2(o[2], o[3]);
                    *(LAS v2u*)(WL + (32 * qb + r32) * 144 + (32 * db + 8 * rr + 4 * hi) * 2) = w; }
            ssq_acc[qb] += xh_sum(sq); }
#pragma unroll
        for (int it = 0; it < 8; ++it) { const int row = 8 * it + (lane >> 3), ch = lane & 7; const v4u v = *(const LAS v4u*)(WL + row * 144 + ch * 16);
            *(v4u*)(C.HY + (size_t)(rq0 + row) * DM + h * 64 + ch * 8) = v; }
    }
    if (hi == 0) { ssq[wave * 64 + r32] = ssq_acc[0]; ssq[wave * 64 + 32 + r32] = ssq_acc[1]; }
    asm volatile("s_waitcnt vmcnt(0)" ::: "memory");
    __syncthreads();
    if (C.tid < 64) { float t = 0.f;
#pragma unroll
        for (int w = 0; w < 8; ++w) t += ssq[w * 64 + C.tid];
        rstd_l[C.tid] = rsqrtf(t * (1.f / 1024.f) + EPSN); }
    __syncthreads();
    const float* gb = C.in[I_BNG] + (size_t)l * DM;
#pragma unroll 2
    for (int it = 0; it < 16; ++it) { const int idx = C.tid + 512 * it, row = idx >> 7, ch = idx & 127;
        bf16* yp = C.HY + (size_t)(rq0 + row) * DM + ch * 8;
        const v4u raw = *(const v4u*)yp; const v4u zz = *(const v4u*)(C.PROJ + (size_t)(rq0 + row) * NIN + COL_ZA + ch * 8);
        const f32x4 g0 = *(const f32x4*)(gb + ch * 8), g1 = *(const f32x4*)(gb + ch * 8 + 4);
        float r[8], z[8]; unpack8(raw, r); unpack8(zz, z); const float rs = rstd_l[row];
        const float gg[8] = {g0.x, g0.y, g0.z, g0.w, g1.x, g1.y, g1.z, g1.w}; float o[8];
#pragma unroll
        for (int e = 0; e < 8; ++e) o[e] = r[e] * rs * gg[e] * silu_f(z[e]);
        v4u w; w.x = pk2(o[0], o[1]); w.y = pk2(o[2], o[3]); w.z = pk2(o[4], o[5]); w.w = pk2(o[6], o[7]);
        *(v4u*)yp = w; }
    __syncthreads();
}

DI int q_next(const Ctx& C0, unsigned* ctr) {
    Ctx C = C0; fresh(C);
    LAS volatile int* slot = (LAS volatile int*)(C.lds + MISC_OFF + 32);
    if (C.tid == 0) *slot = (int)__hip_atomic_fetch_add(ctr, 1u, __ATOMIC_RELAXED, __HIP_MEMORY_SCOPE_AGENT);
    __syncthreads();
    const int v = *slot;
    __syncthreads();
    return v;
}

__global__ void __launch_bounds__(512, 2) hymba_fwd(Args args) {
    extern __shared__ __attribute__((aligned(16))) unsigned char lds_raw[];
    Ctx C; C.in = args.in; C.out = args.out; C.ws = args.ws; C.lds = (LAS unsigned char*)lds_raw;
    C.tid = threadIdx.x; C.lane = C.tid & 63; C.wave = __builtin_amdgcn_readfirstlane(C.tid >> 6); C.G = gridDim.x; C.bid = blockIdx.x;
    C.HY = (bf16*)(args.ws + WS_HY); C.PROJ = (bf16*)(args.ws + WS_PROJ); C.KC = (bf16*)(args.ws + WS_KC); C.VC = (bf16*)(args.ws + WS_VC);
    C.WIN = (bf16*)(args.ws + WS_WIN); C.WOUT = (bf16*)(args.ws + WS_WOUT); C.MOD = (float*)(args.ws + WS_MOD); C.ctl = (unsigned*)(args.ws + WS_CTL);
    if (C.tid < 16) ((LAS unsigned*)(C.lds + MISC_OFF))[C.tid] = 0u;
    __syncthreads();
    const int lo = args.ph_lo, hi = args.ph_hi;
    const bool multi = (hi - lo) > 1;
    XcdBarrier bar; bar.bar = C.ctl + CW_BAR; bar.x = 0; bar.st = nullptr;
    if (multi) bar = xcd_barrier_post(C.ctl + CW_BAR, (volatile LAS unsigned*)(C.lds + MISC_OFF));
#define IN(k) (lo <= (k) && (k) < hi)
#define SEAM(k) do { if (IN(k) && IN((k) + 1)) xcd_barrier(bar); } while (0)
    int ph = 0;
#ifndef PHM
#define PHM 0xff
#endif
    if ((PHM & 1) && IN(ph)) p0_prologue(C);
    SEAM(ph); ++ph;
    if ((PHM & 2) && IN(ph)) norm_phase(C, 0);
    SEAM(ph); ++ph;
    for (int l = 0; l < DEPTH; ++l) {
        if ((PHM & 4) && IN(ph)) {
            pg8::Gemm g{C.HY, C.WIN + (size_t)l * NIN * DM, MT, NIN, DM}; pg8::StaticOrder S; S.init(MT, NIN, C.G, C.bid);
            pg8::EpiProj E{C.PROJ, C.out + O_KP + (size_t)l * NBP * 512 * 1024, C.out + O_VP + (size_t)l * NBP * 512 * 1024, C.out + O_KS + (size_t)l * NBS * 64 * 1024, C.out + O_VS + (size_t)l * NBS * 64 * 1024};
            pg8::gemm_phase<pg8::EpiProj, pg8::StaticOrder, true, true>(C.lds, g, S, E);
        }
        SEAM(ph); ++ph;
        if ((PHM & 8) && IN(ph)) { for (int u = C.bid; u < 512; u += C.G) ssm_local_unit(C, l, u); }
        SEAM(ph); ++ph;
        if ((PHM & 0x70) && IN(ph)) {
            unsigned* ctr = C.ctl + CW_Q + 64 * 3 * l;
            if (PHM & 0x10) for (;;) { const int u = q_next(C, ctr); if (u >= 544) break; attn_unit(C, l, u); }
            if (PHM & 0x20) for (;;) { const int u = q_next(C, ctr + 64); if (u >= 544) break; ssm_main_unit(C, l, u); }
            if (PHM & 0x40) for (;;) { const int u = q_next(C, ctr + 128); if (u >= 544) break; pool_unit(C, l, u); }
        }
        SEAM(ph); ++ph;
        if ((PHM & 0x80) && IN(ph)) {
            pg8::Gemm g{C.HY, C.WOUT + (size_t)l * DM * DM, MT, DM, DM}; pg8::StaticOrder S; S.init(MT, DM, C.G, C.bid);
            pg8::EpiRes E{l == 0 ? C.in[I_XP] : C.out, l == 0 ? C.in[I_XS] : C.out + (size_t)MP * DM, C.out, C.MOD + (size_t)l * 40 * NIN + 2 * DM};
            pg8::gemm_phase<pg8::EpiRes, pg8::StaticOrder, true, true>(C.lds, g, S, E);
        }
        SEAM(ph); ++ph;
        if ((PHM & 2) && IN(ph)) norm_phase(C, l + 1);
        SEAM(ph); ++ph;
    }
#undef IN
#undef SEAM
}

#ifndef N_LAUNCH_MODE
#define N_LAUNCH_MODE 0
#endif
extern "C" void kernel_launch(void* const* d_in, const int* in_sizes, int n_in, void* d_out, int out_size, void* d_ws, size_t ws_size, hipStream_t stream) {
    static int grid = 0;
    if (grid == 0) {
        if (n_in != N_IN || (size_t)out_size != O_END || ws_size < WS_END) { fprintf(stderr, "kernel_launch: unexpected sizes n_in %d out %d ws %zu (need %zu)\n", n_in, out_size, ws_size, (size_t)WS_END); grid = -1; return; }
        int dev = 0, cus = 0, per_cu = 0;
        if (hipGetDevice(&dev) != hipSuccess || hipDeviceGetAttribute(&cus, hipDeviceAttributeMultiprocessorCount, dev) != hipSuccess) { grid = -1; return; }
        if (hipFuncSetAttribute((const void*)hymba_fwd, hipFuncAttributeMaxDynamicSharedMemorySize, LDS_BYTES) != hipSuccess) { fprintf(stderr, "kernel_launch: hipFuncSetAttribute failed\n"); grid = -1; return; }
        if (hipOccupancyMaxActiveBlocksPerMultiprocessor(&per_cu, (const void*)hymba_fwd, 512, LDS_BYTES) != hipSuccess || per_cu < 1) fprintf(stderr, "kernel_launch: occupancy query says %d\n", per_cu);
        (void)hipGetLastError();
        grid = cus;
    }
    if (grid < 0) return;
    (void)in_sizes;
    if (hipMemsetAsync((char*)d_ws + WS_CTL, 0, ZERO_BYTES, stream) != hipSuccess) return;
    Args a{};
    for (int i = 0; i < N_IN; ++i) a.in[i] = (const float*)d_in[i];
    a.out = (float*)d_out; a.ws = (unsigned char*)d_ws;
#if N_LAUNCH_MODE == 1
    a.ph_lo = 0; a.ph_hi = NPH;
    hipLaunchKernelGGL(hymba_fwd, dim3(grid), dim3(512), LDS_BYTES, stream, a);
#else
    for (int p = 0; p < NPH; ++p) { a.ph_lo = p; a.ph_hi = p + 1; hipLaunchKernelGGL(hymba_fwd, dim3(grid), dim3(512), LDS_BYTES, stream, a); }
#endif
}
```

```cpp
#include <hip/hip_runtime.h>
#include <cstdio>
#include <cstdint>
namespace pg8 {
#define PG8_LAS __attribute__((address_space(3)))
typedef unsigned short bf16_t;
typedef short bf16x8 __attribute__((ext_vector_type(8)));
typedef float f32x4 __attribute__((ext_vector_type(4)));
typedef unsigned u32x4 __attribute__((ext_vector_type(4)));
constexpr int BM = 256, BK = 64, HALF = 128, HTB = HALF * BK * 2  , STAGE_BYTES = 8 * HTB, NXCD = 8, WGM = 8;

__host__ __device__ __forceinline__ int lds_byte(int r, int c) { const int st = (r >> 4) * 2 + (c >> 5), rr = r & 15, cc = c & 31, ob = rr * 64 + cc * 2; return st * 1024 + (ob ^ (((ob >> 9) & 1) << 5)); }
__host__ __device__ __forceinline__ void stage_rc(int b, int& R, int& C) { const int st = b / 1024, sb = b % 1024, swz = sb ^ (((sb >> 9) & 1) << 5); R = (st >> 1) * 16 + swz / 64; C = (st & 1) * 32 + (swz % 64) / 2; }
__host__ __device__ __forceinline__ int perm32(int rho) { const int n = rho >> 4, i = rho & 15; return 8 * (i >> 2) + 4 * n + (i & 3); }

struct Unit { int pm, pn; };
struct Gemm { const bf16_t* A; const bf16_t* Bt; int M, N, K; };

struct StaticOrder {
    int nM, nN, nwg, G, c;
    __host__ __device__ void init(int M, int N, int G_, int c_) { nM = M / BM; nN = N / BM; nwg = nM * nN; G = G_; c = c_; }
    __host__ __device__ bool next(int i, Unit& u) const {
        const long L = (long)i * G + c; if (L >= nwg) return false;
        int wgid = (int)L; { const int q = nwg / NXCD, r = nwg % NXCD, xcd = wgid % NXCD, off = wgid / NXCD; wgid = (xcd < r ? xcd * (q + 1) : r * (q + 1) + (xcd - r) * q) + off; }
        const int nig = WGM * nN, gid = wgid / nig, fm = gid * WGM, gsz = (nM - fm) < WGM ? (nM - fm) : WGM;
        u.pm = fm + ((wgid % nig) % gsz); u.pn = (wgid % nig) / gsz; return true;
    }
    __device__ __forceinline__ void a_ready(const Unit&) const {}
    __device__ __forceinline__ void done(const Unit&) const {}
};

__device__ __forceinline__ unsigned cvt_pk_bf16(float lo, float hi) { unsigned r; asm volatile("v_cvt_pk_bf16_f32 %0, %1, %2" : "=v"(r) : "v"(lo), "v"(hi)); return r; }
typedef float f32x2 __attribute__((ext_vector_type(2)));
struct EpiProj {
    static constexpr bool PERM = true, AFTER_DRAIN = false;
    bf16_t* O; float* kp; float* vp; float* ks; float* vs;
    __device__ __forceinline__ void operator()(const f32x4 (&acc)[2][2][4][2], const Unit& u, int wr, int wc, int fr, int fq) const {
        const int lrow0 = wr * 64 + fr, col0 = u.pn * BM + wc * 32 + 8 * fq;
        float* fo = nullptr;
        const bool isk = (u.pn >= 4 && u.pn < 8), isv = (u.pn >= 8 && u.pn < 12);
        if (isk || isv) {
            if (u.pm >= 128) fo = (isk ? ks : vs) + (size_t)(u.pm - 128) * 256 * 1024;
            else if ((u.pm & 15) >= 14) fo = (isk ? kp : vp) + ((size_t)(u.pm >> 4) * 512 + (size_t)((u.pm & 15) - 14) * 256) * 1024;
        }
        const int fcol0 = (u.pn & 3) * 256 + wc * 32 + 8 * fq;
#pragma unroll
        for (int ai = 0; ai < 2; ++ai)
#pragma unroll
            for (int m = 0; m < 4; ++m) { const int lr = lrow0 + ai * HALF + m * 16; bf16_t* rowp = O + (size_t)(u.pm * BM + lr) * 6144 + col0;
#pragma unroll
                for (int bj = 0; bj < 2; ++bj) { const f32x4 v0 = acc[ai][bj][m][0], v1 = acc[ai][bj][m][1];
                    u32x4 w; w.x = cvt_pk_bf16(v0[0], v0[1]); w.y = cvt_pk_bf16(v0[2], v0[3]); w.z = cvt_pk_bf16(v1[0], v1[1]); w.w = cvt_pk_bf16(v1[2], v1[3]);
                    *(u32x4*)(rowp + bj * HALF) = w; } }
        if (fo) {
            float* fb = fo + (size_t)lrow0 * 1024 + fcol0;
#pragma unroll
            for (int ai = 0; ai < 2; ++ai)
#pragma unroll
                for (int m = 0; m < 4; ++m)
#pragma unroll
                    for (int bj = 0; bj < 2; ++bj) { float* fp = fb + (ai * HALF + m * 16) * 1024 + bj * HALF; *(f32x4*)fp = acc[ai][bj][m][0]; *(f32x4*)(fp + 4) = acc[ai][bj][m][1]; }
        }
    }
};
struct EpiRes {
    static constexpr bool PERM = false, AFTER_DRAIN = false;
    const float* xin_p; const float* xin_s; float* xout; const float* gate;
    __device__ __forceinline__ void operator()(const f32x4 (&acc)[2][2][4][2], const Unit& u, int wr, int wc, int fr, int fq) const {
        const int col0 = u.pn * BM + wc * 32 + 4 * fq;
#pragma unroll
        for (int ai = 0; ai < 2; ++ai) {
            const int brow = (u.pm < 128) ? (u.pm >> 4) : (8 + (u.pm - 128) * 4 + 2 * ai + wr);
            f32x4 gv[2][2];
#pragma unroll
            for (int bj = 0; bj < 2; ++bj)
#pragma unroll
                for (int n = 0; n < 2; ++n) gv[bj][n] = *(const f32x4*)(gate + (size_t)brow * 6144 + col0 + bj * HALF + n * 16);
#pragma unroll
            for (int m = 0; m < 4; ++m) { const int r = u.pm * BM + ai * HALF + wr * 64 + m * 16 + fr;
                const float* xi = (u.pm < 128) ? (xin_p + (size_t)r * 2048) : (xin_s + (size_t)(r - 32768) * 2048); float* xo = xout + (size_t)r * 2048;
#pragma unroll
                for (int bj = 0; bj < 2; ++bj)
#pragma unroll
                    for (int n = 0; n < 2; ++n) { const f32x4 xv = *(const f32x4*)(xi + col0 + bj * HALF + n * 16); *(f32x4*)(xo + col0 + bj * HALF + n * 16) = xv + gv[bj][n] * acc[ai][bj][m][n]; }
                asm volatile("" ::: "memory"); }
        }
    }
};

template <class Epi, class Sched, bool ALIGN_EPI = false, bool SP2 = false>
__device__ __forceinline__ void gemm_phase(PG8_LAS unsigned char* lds, const Gemm g, const Sched& S, const Epi& E) {
    int tid_ = threadIdx.x; asm volatile("" : "+v"(tid_));
    const int tid = tid_, wid = __builtin_amdgcn_readfirstlane(tid >> 6), lane = tid & 63, wr = wid >> 2, wc = wid & 3, fr = lane & 15, fq = lane >> 4;
    const int K = g.K, nt = K / BK;
    unsigned voffA[2], voffB[2];
#pragma unroll
    for (int i = 0; i < 2; ++i) { int R, C; stage_rc(tid * 16 + i * 8192, R, C); const int Rb = Epi::PERM ? ((R & ~31) + perm32(R & 31)) : R;
        voffA[i] = (unsigned)(R * K + C) * 2u; voffB[i] = (unsigned)(Rb * K + C) * 2u; }
    const size_t kstep = (size_t)(BK * 2);
    const size_t hstep = (size_t)HALF * K * 2;
    const size_t tstep = 2 * hstep;
    const unsigned ldsw = (unsigned)wid * 1024u;
    const int aoff = lds_byte(wr * 64 + fr, fq * 8), boff = lds_byte(wc * 32 + fr, fq * 8);
#define PG8_SA(b, h) (((b) * 2 + (h)) * HTB)
#define PG8_SB(b, h) ((4 + (b) * 2 + (h)) * HTB)
#define PG8_STAGE(bufoff, gbase, voff) do { _Pragma("unroll") for (int _i = 0; _i < 2; ++_i) \
        __builtin_amdgcn_global_load_lds((const unsigned*)((const char*)(gbase) + (voff)[_i]), (PG8_LAS unsigned*)(lds + (bufoff) + ldsw + _i * 8192), 16, 0, 0); } while (0)
#define PG8_LDA(dst, b, h) do { _Pragma("unroll") for (int m = 0; m < 4; ++m) _Pragma("unroll") for (int k = 0; k < 2; ++k) dst[m][k] = *(const PG8_LAS bf16x8*)(lds + PG8_SA(b, h) + aoff + m * 2048 + k * 1024); } while (0)
#define PG8_LDB(dst, b, h) do { _Pragma("unroll") for (int n = 0; n < 2; ++n) _Pragma("unroll") for (int k = 0; k < 2; ++k) dst[n][k] = *(const PG8_LAS bf16x8*)(lds + PG8_SB(b, h) + boff + n * 2048 + k * 1024); } while (0)
#define PG8_MMA(ai, bj, At, Bt) do { __builtin_amdgcn_s_setprio(1); _Pragma("unroll") for (int m = 0; m < 4; ++m) _Pragma("unroll") for (int n = 0; n < 2; ++n) _Pragma("unroll") for (int k = 0; k < 2; ++k) \
        acc[ai][bj][m][n] = __builtin_amdgcn_mfma_f32_16x16x32_bf16(Bt[n][k], At[m][k], acc[ai][bj][m][n], 0, 0, 0); __builtin_amdgcn_s_setprio(0); } while (0)
#define PG8_WAIT_V(n) asm volatile("s_waitcnt vmcnt(" #n ")" ::: "memory")
#define PG8_WAIT_L(n) asm volatile("s_waitcnt lgkmcnt(" #n ")" ::: "memory")
#define PG8_BAR __builtin_amdgcn_s_barrier()
#define PG8_SCHED __builtin_amdgcn_sched_barrier(0)
    Unit cur, nxt; int ui = 0;
    if (!S.next(0, cur)) return;
    f32x4 acc[2][2][4][2];
#pragma unroll
    for (int a = 0; a < 2; ++a)
#pragma unroll
        for (int b = 0; b < 2; ++b)
#pragma unroll
            for (int m = 0; m < 4; ++m)
#pragma unroll
                for (int n = 0; n < 2; ++n) acc[a][b][m][n] = (f32x4){0.f, 0.f, 0.f, 0.f};
    bf16x8 At[4][2], B0[2][2], B1[2][2];
    const char* cA = (const char*)g.A + (size_t)cur.pm * tstep; const char* cB = (const char*)g.Bt + (size_t)cur.pn * tstep;
    S.a_ready(cur);
    if constexpr (SP2) {
        PG8_STAGE(PG8_SB(0, 0), cB, voffB); PG8_STAGE(PG8_SB(0, 1), cB + hstep, voffB); PG8_STAGE(PG8_SA(0, 0), cA, voffA); PG8_STAGE(PG8_SA(0, 1), cA + hstep, voffA);
        if (wr == 1) PG8_BAR;
        PG8_WAIT_V(2); PG8_BAR;
        PG8_STAGE(PG8_SB(1, 0), cB + kstep, voffB); PG8_STAGE(PG8_SA(1, 0), cA + kstep, voffA); PG8_STAGE(PG8_SB(1, 1), cB + hstep + kstep, voffB);
        PG8_WAIT_V(6); PG8_BAR;
    } else {
        PG8_STAGE(PG8_SB(0, 0), cB, voffB); PG8_STAGE(PG8_SA(0, 0), cA, voffA); PG8_STAGE(PG8_SB(0, 1), cB + hstep, voffB); PG8_STAGE(PG8_SA(0, 1), cA + hstep, voffA);
        if (wr == 1) PG8_BAR;
        PG8_WAIT_V(4); PG8_BAR;
        PG8_STAGE(PG8_SB(1, 0), cB + kstep, voffB); PG8_STAGE(PG8_SA(1, 0), cA + kstep, voffA); PG8_STAGE(PG8_SB(1, 1), cB + hstep + kstep, voffB);
        PG8_WAIT_V(6); PG8_BAR;
    }
    for (;;) {
        const bool has_next = S.next(ui + 1, nxt);
        const char* nA = has_next ? (const char*)g.A + (size_t)nxt.pm * tstep : cA; const char* nB = has_next ? (const char*)g.Bt + (size_t)nxt.pn * tstep : cB;
        for (int t = 0; t < nt; t += 2) {
            const bool last = (t == nt - 2);
            const char* a1 = cA + (size_t)(t + 1) * kstep;
            const char* a2 = last ? nA : cA + (size_t)(t + 2) * kstep; const char* b2 = last ? nB : cB + (size_t)(t + 2) * kstep;
            const char* a3 = a2 + kstep; const char* b3 = b2 + kstep;
            if (last && has_next) S.a_ready(nxt);
            if constexpr (SP2) {
            PG8_LDB(B0, 0, 0); PG8_LDB(B1, 0, 1); PG8_SCHED; PG8_LDA(At, 0, 0); PG8_STAGE(PG8_SA(1, 1), a1 + hstep, voffA);
            PG8_WAIT_V(8); PG8_WAIT_L(0); PG8_BAR; PG8_MMA(0, 0, At, B0); PG8_MMA(0, 1, At, B1); PG8_BAR; PG8_SCHED;
            PG8_LDA(At, 0, 1); PG8_STAGE(PG8_SB(0, 0), b2, voffB); PG8_STAGE(PG8_SB(0, 1), b2 + hstep, voffB); PG8_STAGE(PG8_SA(0, 0), a2, voffA);
            PG8_WAIT_V(8); PG8_WAIT_L(0); PG8_BAR; PG8_MMA(1, 0, At, B0); PG8_MMA(1, 1, At, B1); PG8_BAR; PG8_SCHED;
            PG8_LDB(B0, 1, 0); PG8_LDB(B1, 1, 1); PG8_SCHED; PG8_LDA(At, 1, 0); PG8_STAGE(PG8_SA(0, 1), a2 + hstep, voffA);
            PG8_WAIT_V(8); PG8_WAIT_L(0); PG8_BAR; PG8_MMA(0, 0, At, B0); PG8_MMA(0, 1, At, B1); PG8_BAR; PG8_SCHED;
            PG8_LDA(At, 1, 1); PG8_STAGE(PG8_SB(1, 0), b3, voffB); PG8_STAGE(PG8_SB(1, 1), b3 + hstep, voffB); PG8_STAGE(PG8_SA(1, 0), a3, voffA);
            PG8_WAIT_V(8); PG8_WAIT_L(0); PG8_BAR; PG8_MMA(1, 0, At, B0); PG8_MMA(1, 1, At, B1); PG8_BAR; PG8_SCHED;
            } else {
            PG8_LDB(B0, 0, 0); PG8_SCHED; PG8_LDA(At, 0, 0); PG8_STAGE(PG8_SA(1, 1), a1 + hstep, voffA);
            PG8_WAIT_L(8); PG8_BAR; PG8_WAIT_L(0); PG8_MMA(0, 0, At, B0); PG8_BAR; PG8_SCHED;
            PG8_LDB(B1, 0, 1); PG8_STAGE(PG8_SB(0, 0), b2, voffB);
            PG8_BAR; PG8_WAIT_L(0); PG8_MMA(0, 1, At, B1); PG8_BAR;
            PG8_LDA(At, 0, 1); PG8_STAGE(PG8_SA(0, 0), a2, voffA);
            PG8_BAR; PG8_WAIT_L(0); PG8_MMA(1, 0, At, B0); PG8_BAR; PG8_SCHED;
            PG8_STAGE(PG8_SB(0, 1), b2 + hstep, voffB);
            PG8_WAIT_V(6); PG8_BAR; PG8_MMA(1, 1, At, B1); PG8_BAR;
            PG8_LDB(B0, 1, 0); PG8_SCHED; PG8_LDA(At, 1, 0); PG8_STAGE(PG8_SA(0, 1), a2 + hstep, voffA);
            PG8_WAIT_L(8); PG8_BAR; PG8_WAIT_L(0); PG8_MMA(0, 0, At, B0); PG8_BAR; PG8_SCHED;
            PG8_LDB(B1, 1, 1); PG8_STAGE(PG8_SB(1, 0), b3, voffB);
            PG8_BAR; PG8_WAIT_L(0); PG8_MMA(0, 1, At, B1); PG8_BAR;
            PG8_LDA(At, 1, 1); PG8_STAGE(PG8_SA(1, 0), a3, voffA);
            PG8_BAR; PG8_WAIT_L(0); PG8_MMA(1, 0, At, B0); PG8_BAR; PG8_SCHED;
            PG8_STAGE(PG8_SB(1, 1), b3 + hstep, voffB);
            PG8_WAIT_V(6); PG8_BAR; PG8_MMA(1, 1, At, B1); PG8_BAR;
            }
        }
        if constexpr (ALIGN_EPI) { if (wr == 0) PG8_BAR; }
        if constexpr (!Epi::AFTER_DRAIN) { E(acc, cur, wr, wc, fr, fq); S.done(cur); }
        if (!has_next) break;
#pragma unroll
        for (int a = 0; a < 2; ++a)
#pragma unroll
            for (int b = 0; b < 2; ++b)
#pragma unroll
                for (int m = 0; m < 4; ++m)
#pragma unroll
                    for (int n = 0; n < 2; ++n) acc[a][b][m][n] = (f32x4){0.f, 0.f, 0.f, 0.f};
        cur = nxt; cA = nA; cB = nB; ++ui;
        if constexpr (ALIGN_EPI) { if (wr == 1) PG8_BAR; }
    }
    PG8_WAIT_V(0);
    if constexpr (!ALIGN_EPI) { if (wr == 0) PG8_BAR; }
    PG8_BAR;
    if constexpr (Epi::AFTER_DRAIN) { E.fused(acc, cur, wr, wc, fr, fq, lds, wid, lane); S.done(cur); }
#undef PG8_SA
#undef PG8_SB
#undef PG8_STAGE
#undef PG8_LDA
#undef PG8_LDB
#undef PG8_MMA
#undef PG8_WAIT_V
#undef PG8_WAIT_L
#undef PG8_BAR
#undef PG8_SCHED
}
}
#define LAS __attribute__((address_space(3)))
#define XB_TMO      128
#define XB_XCNT(j)  (256  + 64 * (j))
#define XB_XSUB(j)  (1280 + 64 * (j))
#define XB_XGEN(j)  (2304 + 64 * (j))
#define XB_TOP      3328
#define XB_TOPGEN   3392
#define XCD_BAR_WORDS 3456
#define XB_SPIN_CAP (1u << 18)
#define LAS __attribute__((address_space(3)))

__device__ __forceinline__ unsigned xb_ld(unsigned* p)              { return __hip_atomic_load(p, __ATOMIC_RELAXED, __HIP_MEMORY_SCOPE_AGENT); }
__device__ __forceinline__ unsigned xb_add(unsigned* p, unsigned v) { return __hip_atomic_fetch_add(p, v, __ATOMIC_RELAXED, __HIP_MEMORY_SCOPE_AGENT); }
__device__ __forceinline__ unsigned xb_xcc_id() { return (unsigned)__builtin_amdgcn_s_getreg((3 << 11) | 20) & 0xFu; }
#define XB_SPIN(cond, bar) do { unsigned _sp = 0; while (cond) { __builtin_amdgcn_s_sleep(1); \
    if ((++_sp & 255u) == 0u) { if (xb_ld(&(bar)[XB_TMO])) break; if (_sp > XB_SPIN_CAP) { atomicAdd(&(bar)[XB_TMO], 1u); break; } } } } while (0)

struct XcdBarrier {
    unsigned* bar; unsigned x;
    volatile LAS unsigned* st;
};

__device__ __forceinline__ XcdBarrier xcd_barrier_post(unsigned* bar, volatile LAS unsigned* st) {
    XcdBarrier b; b.bar = bar; b.x = xb_xcc_id(); b.st = st;
    if (threadIdx.x == 0) (void)xb_add(&bar[XB_XCNT(b.x)], 1u);
    return b;
}
__device__ __forceinline__ void xcd_barrier_complete(unsigned* bar, unsigned x, unsigned& nloc, unsigned& nx) {
    const unsigned G = gridDim.x * gridDim.y * gridDim.z;
    unsigned sum, cnt, mine, sp = 0u;
    for (;;) {
        sum = 0u; cnt = 0u; mine = 0u;
#pragma unroll
        for (unsigned j = 0; j < 16; ++j) { const unsigned c = xb_ld(&bar[XB_XCNT(j)]); sum += c; cnt += (c > 0u) ? 1u : 0u; mine = (j == x) ? c : mine; }
        if (sum == G) break;
        __builtin_amdgcn_s_sleep(1);
        if ((++sp & 255u) == 0u) { if (xb_ld(&bar[XB_TMO])) break; if (sp > XB_SPIN_CAP) { atomicAdd(&bar[XB_TMO], 1u); break; } }
    }
    nloc = mine > 0u ? mine : 1u; nx = cnt > 0u ? cnt : 1u;
}

__device__ __forceinline__ void xcd_barrier(const XcdBarrier& b) {
    asm volatile("s_waitcnt vmcnt(0)" ::: "memory");
    __syncthreads();
    if (threadIdx.x == 0) {
        unsigned* bar = b.bar;
        __builtin_amdgcn_s_waitcnt(0);
        unsigned nloc = b.st[0], nx = b.st[1];
        if (nloc == 0u) { xcd_barrier_complete(bar, b.x, nloc, nx); b.st[0] = nloc; b.st[1] = nx; }
        const unsigned old = xb_add(&bar[XB_XSUB(b.x)], 1u);
        const unsigned gen = old / nloc;
        if (old + 1u == (gen + 1u) * nloc) {
            __builtin_amdgcn_fence(__ATOMIC_RELEASE, "agent");
            asm volatile("s_waitcnt vmcnt(0)" ::: "memory");
            const unsigned og = xb_add(&bar[XB_TOP], 1u);
            const unsigned tg = og / nx;
            if (og + 1u == (tg + 1u) * nx) xb_add(&bar[XB_TOPGEN], 1u);
            else XB_SPIN(xb_ld(&bar[XB_TOPGEN]) == tg, bar);
            __builtin_amdgcn_fence(__ATOMIC_ACQUIRE, "agent");
            xb_add(&bar[XB_XGEN(b.x)], 1u);
            asm volatile("s_waitcnt vmcnt(0)" ::: "memory");
        } else {
            XB_SPIN(xb_ld(&bar[XB_XGEN(b.x)]) == gen, bar);
            __builtin_amdgcn_fence(__ATOMIC_ACQUIRE, "agent");
            asm volatile("s_waitcnt vmcnt(0)" ::: "memory");
        }
    }
    __syncthreads();
}

constexpr int DM = 2048, NIN = 6144, MP = 32768, MS = 2048, MT = MP + MS, DEPTH = 4;
constexpr int NBP = 8, LP = 4096, NBS = 32, LSQ = 64;
constexpr int COL_Q = 0, COL_K = 1024, COL_V = 2048, COL_ZA = 3072, COL_US = 4096, COL_ZS = 4608, COL_UP = 5120, COL_ZP = 5632;
constexpr float EPSN = 1e-6f, LOG2E = 1.4426950408889634f;
constexpr size_t O_YP = 0, O_YS = O_YP + (size_t)MP * DM, O_KP = O_YS + (size_t)MS * DM, O_VP = O_KP + (size_t)DEPTH * NBP * 512 * 1024,
    O_SRP = O_VP + (size_t)DEPTH * NBP * 512 * 1024, O_SIP = O_SRP + (size_t)DEPTH * NBP * 2048, O_PP = O_SIP + (size_t)DEPTH * NBP * 2048,
    O_KS = O_PP + (size_t)DEPTH * NBP * 15 * 512, O_VS = O_KS + (size_t)DEPTH * NBS * 64 * 1024, O_SRS = O_VS + (size_t)DEPTH * NBS * 64 * 1024,
    O_SIS = O_SRS + (size_t)DEPTH * NBS * 2048, O_PS = O_SIS + (size_t)DEPTH * NBS * 2048, O_END = O_PS + (size_t)DEPTH * NBS * 15 * 512;
enum { I_XP = 0, I_XS, I_CP, I_CS, I_CK, I_CV, I_SRE, I_SIM, I_SPOOL, I_NORMG, I_WADA, I_BADA, I_WIN, I_RELB, I_AR, I_AI, I_LDT, I_BR, I_BI, I_CR, I_CI, I_SD, I_WGLU, I_BGLU,
       I_WPOOL, I_PSCALE, I_BNG, I_WOUT, I_FNG, N_IN };
constexpr size_t MiB = 1u << 20;
constexpr size_t WS_CTL = 0, WS_MOD = 1 * MiB, ZERO_BYTES = 5 * MiB, WS_SSMP = 5 * MiB, SSMP_LAYER = 512 * 1024, WS_WGLU = 7 * MiB, WS_WPOOL = 11 * MiB, WS_SLOC = 12 * MiB,
    WS_WOUT = 20 * MiB, WS_WIN = 52 * MiB, WS_HY = 148 * MiB, WS_PROJ = 284 * MiB, WS_KC = 692 * MiB, WS_VC = 820 * MiB, WS_END = 948 * MiB;
constexpr size_t SSMP_ABAR = 0, SSMP_ABAR64 = 16384, SSMP_BF = 32768, SSMP_CF = 32768 + 131072;
constexpr int CW_BAR = 4096, CW_Q = 16384;
constexpr int LDS_BYTES = 147456, MISC_OFF = LDS_BYTES - 64;
constexpr int NPH = 2 + 5 * DEPTH;

#define GAS __attribute__((address_space(1)))
typedef unsigned short bf16;
typedef unsigned v4u __attribute__((ext_vector_type(4)));
typedef unsigned v2u __attribute__((ext_vector_type(2)));
typedef float f32x4 __attribute__((ext_vector_type(4)));
typedef float f32x16 __attribute__((ext_vector_type(16)));
typedef short bf16x8 __attribute__((ext_vector_type(8)));
typedef short s16x4 __attribute__((ext_vector_type(4)));
typedef float f32x2_t __attribute__((ext_vector_type(2)));
typedef __bf16 bf16x2_t __attribute__((ext_vector_type(2)));
#define DI __device__ __forceinline__
DI unsigned pk2(float lo, float hi) { f32x2_t v = {lo, hi}; bf16x2_t b = __builtin_convertvector(v, bf16x2_t); return __builtin_bit_cast(unsigned, b); }
DI float bflo(unsigned u) { return __uint_as_float(u << 16); }
DI float bfhi(unsigned u) { return __uint_as_float(u & 0xffff0000u); }
DI float ex2(float x) { return __builtin_amdgcn_exp2f(x); }
DI float rcpf_(float x) { return __builtin_amdgcn_rcpf(x); }
DI float silu_f(float z) { return z * rcpf_(1.f + ex2(-LOG2E * z)); }
DI float sigm_f(float z) { return rcpf_(1.f + ex2(-LOG2E * z)); }
DI float gelu_tanh_f(float x) { const float t = x + 0.044715f * x * x * x; return x * rcpf_(1.f + ex2(-(1.5957691216057308f * LOG2E) * t)); }
DI float xh_max(float v) { auto rr = __builtin_amdgcn_permlane32_swap(__float_as_uint(v), __float_as_uint(v), false, false); return fmaxf(__uint_as_float(rr[0]), __uint_as_float(rr[1])); }
DI float xh_sum(float v) { auto rr = __builtin_amdgcn_permlane32_swap(__float_as_uint(v), __float_as_uint(v), false, false); return __uint_as_float(rr[0]) + __uint_as_float(rr[1]); }
DI float wave_sum(float v) {
#pragma unroll
    for (int o = 1; o < 64; o <<= 1) v += __shfl_xor(v, o);
    return v; }
DI f32x16 mfma32(bf16x8 a, bf16x8 b, f32x16 c) { return __builtin_amdgcn_mfma_f32_32x32x16_bf16(a, b, c, 0, 0, 0); }
DI f32x4 mfma16(bf16x8 a, bf16x8 b, f32x4 c) { return __builtin_amdgcn_mfma_f32_16x16x32_bf16(a, b, c, 0, 0, 0); }
typedef short v4i16_t __attribute__((ext_vector_type(4)));
DI s16x4 lds_tr(LAS const unsigned char* p) { return __builtin_bit_cast(s16x4, __builtin_amdgcn_ds_read_tr16_b64_v4i16((LAS v4i16_t*)p)); }
DI bf16x8 zero8() { return (bf16x8){0, 0, 0, 0, 0, 0, 0, 0}; }
DI bf16x8 ld8(const bf16* p) { return *(const bf16x8*)p; }
DI void unpack8(v4u w, float (&f)[8]) { f[0] = bflo(w.x); f[1] = bfhi(w.x); f[2] = bflo(w.y); f[3] = bfhi(w.y); f[4] = bflo(w.z); f[5] = bfhi(w.z); f[6] = bflo(w.w); f[7] = bfhi(w.w); }

struct Args { const float* in[N_IN]; float* out; unsigned char* ws; int ph_lo, ph_hi; };
static_assert(sizeof(Args) == (N_IN + 2) * 8 + 8, "Args has no padding");

DI int otid() { int t = threadIdx.x; asm volatile("" : "+v"(t)); return t; }
struct Ctx {
    const float* const* in; float* out; unsigned char* ws; LAS unsigned char* lds;
    int tid, lane, wave, G, bid;
    bf16* HY; bf16* PROJ; bf16* KC; bf16* VC; bf16* WIN; bf16* WOUT; float* MOD; unsigned* ctl;
};

DI void fresh(Ctx& C) { C.tid = otid(); C.lane = C.tid & 63; C.wave = __builtin_amdgcn_readfirstlane(C.tid >> 6); }
DI void p0_mod_unit(const Ctx& C0, int u) {
    Ctx C = C0; fresh(C);
    const int l = u / 96, rem = u % 96, cb = rem >> 3, ke = rem & 7, k0 = ke * 256;
    LAS float* sc = (LAS float*)C.lds;
    for (int idx = C.tid; idx < 256 * 40; idx += 512) { const int r = idx >> 8, kk = idx & 255;
        const float cv = (r < 8) ? C.in[I_CP][r * DM + k0 + kk] : C.in[I_CS][(r - 8) * DM + k0 + kk]; sc[kk * 40 + r] = silu_f(cv); }
    __syncthreads();
    const int j = cb * 512 + C.tid;
    const float* W = C.in[I_WADA] + (size_t)l * DM * NIN + (size_t)k0 * NIN + j;
    float acc[40];
#pragma unroll
    for (int r = 0; r < 40; ++r) acc[r] = 0.f;
    for (int kk = 0; kk < 256; kk += 4) {
        float w[4];
#pragma unroll
        for (int q = 0; q < 4; ++q) w[q] = W[(size_t)(kk + q) * NIN];
#pragma unroll
        for (int q = 0; q < 4; ++q) { const LAS f32x4* s = (const LAS f32x4*)(sc + (kk + q) * 40);
#pragma unroll
            for (int t = 0; t < 10; ++t) { const f32x4 v = s[t]; acc[4 * t] += v.x * w[q]; acc[4 * t + 1] += v.y * w[q]; acc[4 * t + 2] += v.z * w[q]; acc[4 * t + 3] += v.w * w[q]; } }
    }
    float* M = (float*)(C.ws + WS_MOD) + (size_t)l * 40 * NIN + j;
    const float bias = (ke == 0) ? C.in[I_BADA][l * NIN + j] : 0.f;
#pragma unroll
    for (int r = 0; r < 40; ++r) unsafeAtomicAdd(M + (size_t)r * NIN, acc[r] + bias);
    __syncthreads();
}
DI void p0_transpose_item(const float* W, int K, int N, bf16* WT, LAS float* scr, int item, int lane) {
    const int nblk = N / 32, kb = item / nblk, nb = item % nblk, k0 = 64 * kb, n0 = 32 * nb;
#pragma unroll 8
    for (int i = 0; i < 32; ++i) { const int kk = 2 * i + (lane >> 5); scr[kk * 33 + (lane & 31)] = W[(size_t)(k0 + kk) * N + n0 + (lane & 31)]; }
    asm volatile("s_waitcnt lgkmcnt(0)" ::: "memory");
    const int c = lane & 7;
#pragma unroll
    for (int j = 0; j < 4; ++j) { const int n = (lane >> 3) + 8 * j; const LAS float* s = scr + (8 * c) * 33 + n;
        v4u o; o.x = pk2(s[0 * 33], s[1 * 33]); o.y = pk2(s[2 * 33], s[3 * 33]); o.z = pk2(s[4 * 33], s[5 * 33]); o.w = pk2(s[6 * 33], s[7 * 33]);
        *(v4u*)(WT + (size_t)(n0 + n) * K + k0 + 8 * c) = o; }
    asm volatile("s_waitcnt lgkmcnt(0)" ::: "memory");
}
DI void p0_ssm_params(const Ctx& C, int l, int g, int lane) {
    unsigned char* blk = C.ws + WS_SSMP + (size_t)l * SSMP_LAYER;
    const int gp = (l * 32 + g) * 64 + lane;
    const float dt = expf(C.in[I_LDT][l * 32 + g]);
    const float ar = C.in[I_AR][gp], ai = C.in[I_AI][gp];
    const float x = ar * dt, ang = ai * dt;
    float sn, cs; sincosf(ang, &sn, &cs);
    const float mag = expf(x), em1 = expm1f(x);
    const float abr = mag * cs, abi = mag * sn;
    float sh, ch; sincosf(0.5f * ang, &sh, &ch); (void)ch;
    const float nr = em1 * cs - 2.f * sh * sh, ni = abi;
    const float den = ar * ar + ai * ai;
    const float cr = (nr * ar + ni * ai) / den, ci = (ni * ar - nr * ai) / den;
    float* AB = (float*)(blk + SSMP_ABAR) + g * 128; AB[lane] = abr; AB[64 + lane] = abi;
    { float s64, c64; sincosf(64.f * ang, &s64, &c64); const float m64 = expf(64.f * x); float* A6 = (float*)(blk + SSMP_ABAR64) + g * 128; A6[lane] = m64 * c64; A6[64 + lane] = m64 * s64; }
    const float* br = C.in[I_BR] + (size_t)gp * 16; const float* bi = C.in[I_BI] + (size_t)gp * 16;
    float bbr[16], bbi[16];
#pragma unroll
    for (int c = 0; c < 16; ++c) { const float b_r = br[c], b_i = bi[c]; bbr[c] = cr * b_r - ci * b_i; bbi[c] = cr * b_i + ci * b_r; }
    v4u* BF = (v4u*)(blk + SSMP_BF) + (size_t)g * 4 * 64;
#pragma unroll
    for (int half = 0; half < 2; ++half) {
        v4u o; o.x = pk2(bbr[8 * half], bbr[8 * half + 1]); o.y = pk2(bbr[8 * half + 2], bbr[8 * half + 3]); o.z = pk2(bbr[8 * half + 4], bbr[8 * half + 5]); o.w = pk2(bbr[8 * half + 6], bbr[8 * half + 7]);
        BF[(0 + half) * 64 + lane] = o;
        o.x = pk2(bbi[8 * half], bbi[8 * half + 1]); o.y = pk2(bbi[8 * half + 2], bbi[8 * half + 3]); o.z = pk2(bbi[8 * half + 4], bbi[8 * half + 5]); o.w = pk2(bbi[8 * half + 6], bbi[8 * half + 7]);
        BF[(2 + half) * 64 + lane] = o; }
    v4u* CF = (v4u*)(blk + SSMP_CF) + (size_t)g * 4 * 64;
    const int c = lane & 15, kq = lane >> 4;
    const float* crp = C.in[I_CR] + ((size_t)(l * 32 + g) * 16 + c) * 64; const float* cip = C.in[I_CI] + ((size_t)(l * 32 + g) * 16 + c) * 64;
#pragma unroll
    for (int kap = 0; kap < 4; ++kap) { const int p0 = 16 * kap + 4 * kq;
        v4u o; o.x = pk2(crp[p0], -cip[p0]); o.y = pk2(crp[p0 + 1], -cip[p0 + 1]); o.z = pk2(crp[p0 + 2], -cip[p0 + 2]); o.w = pk2(crp[p0 + 3], -cip[p0 + 3]);
        CF[kap * 64 + lane] = o; }
}
DI void p0_prologue(const Ctx& C0) {
    for (int u = C0.bid; u < 384; u += C0.G) p0_mod_unit(C0, u);
    __syncthreads();
    Ctx C = C0; fresh(C);
    const int gw = C.bid * 8 + C.wave, NGW = C.G * 8, lane = C.lane;
    LAS float* scr = (LAS float*)(C.lds + C.wave * 16384);
    constexpr int I_IN = (DM / 64) * (NIN / 32), I_OUT = (DM / 64) * (DM / 32);
    for (int it = gw; it < DEPTH * (I_IN + I_OUT); it += NGW) {
        const int l = it / (I_IN + I_OUT), r = it % (I_IN + I_OUT);
        if (r < I_IN) p0_transpose_item(C.in[I_WIN] + (size_t)l * DM * NIN, DM, NIN, C.WIN + (size_t)l * NIN * DM, scr, r, lane);
        else p0_transpose_item(C.in[I_WOUT] + (size_t)l * DM * DM, DM, DM, C.WOUT + (size_t)l * DM * DM, scr, r - I_IN, lane);
    }
    for (int it = gw; it < DEPTH * 1024; it += NGW) { const int l = it >> 10, ct = (it >> 5) & 31, kap = it & 31;
        const float* w = C.in[I_WGLU] + (size_t)l * 512 * 1024 + (size_t)(16 * kap + 8 * (lane >> 5)) * 1024 + 32 * ct + (lane & 31);
        v4u o; o.x = pk2(w[0], w[1024]); o.y = pk2(w[2048], w[3072]); o.z = pk2(w[4096], w[5120]); o.w = pk2(w[6144], w[7168]);
        ((v4u*)(C.ws + WS_WGLU))[(size_t)it * 64 + lane] = o; }
    for (int it = gw; it < DEPTH * 128; it += NGW) { const int lg = it >> 5, ct = (it >> 3) & 3, kap = it & 7;
        const float* w = C.in[I_WPOOL] + (size_t)lg * 128 * 128 + (size_t)(16 * kap + 8 * (lane >> 5)) * 128 + 32 * ct + (lane & 31);
        v4u o; o.x = pk2(w[0], w[128]); o.y = pk2(w[256], w[384]); o.z = pk2(w[512], w[640]); o.w = pk2(w[768], w[896]);
        ((v4u*)(C.ws + WS_WPOOL))[(size_t)it * 64 + lane] = o; }
    for (int it = gw; it < DEPTH * 32; it += NGW) p0_ssm_params(C, it >> 5, it & 31, lane);
    { const size_t n8 = (size_t)DEPTH * NBS * 512 * 1024 / 8; const size_t stride = (size_t)C.G * 512;
      for (size_t i = (size_t)C.bid * 512 + C.tid; i < 2 * n8; i += stride) { const bool isv = i >= n8; const size_t e = (isv ? i - n8 : i) * 8;
          const float* s = (isv ? C.in[I_CV] : C.in[I_CK]) + e; const f32x4 a = *(const f32x4*)s, b = *(const f32x4*)(s + 4);
          v4u o; o.x = pk2(a.x, a.y); o.y = pk2(a.z, a.w); o.z = pk2(b.x, b.y); o.w = pk2(b.z, b.w); *(v4u*)((isv ? C.VC : C.KC) + e) = o; } }
}

DI void norm_phase(const Ctx& C0, int l) {
    Ctx C = C0; fresh(C);
    const int gw = C.bid * 8 + C.wave, NGW = C.G * 8, lane = C.lane;
    const int rpw = (MT + NGW - 1) / NGW;
    const bool fin = (l == DEPTH);
    const float* gvec = fin ? C.in[I_FNG] : C.in[I_NORMG] + (size_t)l * DM;
    for (int i = 0; i < rpw; ++i) { const int m = gw * rpw + i; if (m >= MT) break;
        const float* xr = (l == 0) ? (m < MP ? C.in[I_XP] + (size_t)m * DM : C.in[I_XS] + (size_t)(m - MP) * DM) : C.out + (size_t)m * DM;
        const f32x4* x4 = (const f32x4*)xr + lane;
        f32x4 v[8]; float s = 0.f;
#pragma unroll
        for (int j = 0; j < 8; ++j) { v[j] = x4[64 * j]; s += (v[j].x * v[j].x + v[j].y * v[j].y) + (v[j].z * v[j].z + v[j].w * v[j].w); }
        const float rstd = rsqrtf(wave_sum(s) * (1.f / DM) + EPSN);
        if (fin) { f32x4* o4 = (f32x4*)(C.out + (size_t)m * DM) + lane;
#pragma unroll
            for (int j = 0; j < 8; ++j) { const f32x4 g = ((const f32x4*)gvec)[lane + 64 * j]; o4[64 * j] = v[j] * rstd * g; } }
        else { const int brow = (m < MP) ? (m >> 12) : 8 + ((m - MP) >> 6);
            const float* md = C.MOD + ((size_t)l * 40 + brow) * NIN;
            v2u* o8 = (v2u*)(C.HY + (size_t)m * DM) + lane;
#pragma unroll
            for (int j = 0; j < 8; ++j) { const f32x4 g = ((const f32x4*)gvec)[lane + 64 * j], sh = ((const f32x4*)md)[lane + 64 * j], sc = ((const f32x4*)(md + DM))[lane + 64 * j];
                const f32x4 h = v[j] * rstd * g * (sc + 1.f) + sh; v2u o; o.x = pk2(h.x, h.y); o.y = pk2(h.z, h.w); o8[64 * j] = o; } }
    }
}

constexpr int ROWP = 1040;
DI void branch_tail(const Ctx& C, int l, int row0, LAS unsigned char* ST, LAS float* ssq, LAS float* rstd_l, int zcol, int ycol) {
    if (C.tid < 64) { float t = 0.f;
#pragma unroll
        for (int w = 0; w < 8; ++w) t += ssq[w * 64 + C.tid];
        rstd_l[C.tid] = rsqrtf(t * (1.f / 512.f) + EPSN); }
    __syncthreads();
    const float* gb = C.in[I_BNG] + (size_t)l * DM + ycol;
#pragma unroll 2
    for (int it = 0; it < 8; ++it) { const int idx = C.tid + 512 * it, row = idx >> 6, ch = idx & 63;
        const v4u raw = *(const LAS v4u*)(ST + row * ROWP + ch * 16);
        const v4u zz = *(const v4u*)(C.PROJ + (size_t)(row0 + row) * NIN + zcol + ch * 8);
        const f32x4 g0 = *(const f32x4*)(gb + ch * 8), g1 = *(const f32x4*)(gb + ch * 8 + 4);
        float r[8], z[8]; unpack8(raw, r); unpack8(zz, z); const float rs = rstd_l[row];
        const float gg[8] = {g0.x, g0.y, g0.z, g0.w, g1.x, g1.y, g1.z, g1.w}; float o[8];
#pragma unroll
        for (int e = 0; e < 8; ++e) o[e] = r[e] * rs * gg[e] * silu_f(z[e]);
        v4u w; w.x = pk2(o[0], o[1]); w.y = pk2(o[2], o[3]); w.z = pk2(o[4], o[5]); w.w = pk2(o[6], o[7]);
        *(v4u*)(C.HY + (size_t)(row0 + row) * DM + ycol + ch * 8) = w; }
    __syncthreads();
}

struct SsmGroup { float ar, ai; bf16x8 bf[4]; };
DI void ssm_load_group(const Ctx& C, int l, int g, int lane, SsmGroup& S) {
    const unsigned char* blk = C.ws + WS_SSMP + (size_t)l * SSMP_LAYER;
    const float* AB = (const float*)(blk + SSMP_ABAR) + g * 128; S.ar = AB[lane]; S.ai = AB[64 + lane];
    const bf16x8* BF = (const bf16x8*)(blk + SSMP_BF) + (size_t)g * 4 * 64;
#pragma unroll
    for (int f = 0; f < 4; ++f) S.bf[f] = BF[f * 64 + lane];
}
DI void ssm_bu_block(const Ctx& C, const SsmGroup& S, int rowblk, int g, int lane, f32x16& dre, f32x16& dim) {
    const int i = lane & 31, kh = lane >> 5, ti = 4 * (i >> 3) + (i & 3); const bool act = ((i >> 2) & 1) == kh;
    const bf16* src = C.PROJ + (size_t)(rowblk + ti) * NIN + COL_US + 16 * g;
    bf16x8 a0 = ld8(src), a1 = ld8(src + 8);
    if (!act) { a0 = zero8(); a1 = zero8(); }
    const f32x16 z = {};
    dre = mfma32(a0, S.bf[0], z); dre = mfma32(a1, S.bf[1], dre);
    dim = mfma32(a0, S.bf[2], z); dim = mfma32(a1, S.bf[3], dim);
}
DI void ssm_local_unit(const Ctx& C0, int l, int u) {
    Ctx C = C0; fresh(C);
    const int lane = C.lane, row0 = (u >> 6) * LP + (u & 63) * 64;
    float* SL = (float*)(C.ws + WS_SLOC) + (size_t)u * 4096;
    for (int gi = 0; gi < 4; ++gi) { const int g = C.wave * 4 + gi;
        SsmGroup S; ssm_load_group(C, l, g, lane, S);
        float hr = 0.f, hi = 0.f;
        for (int blk = 0; blk < 4; ++blk) { f32x16 dre, dim; ssm_bu_block(C, S, row0 + 16 * blk, g, lane, dre, dim);
#pragma unroll
            for (int r = 0; r < 16; ++r) { const float nr = S.ar * hr - S.ai * hi + dre[r], ni = S.ar * hi + S.ai * hr + dim[r]; hr = nr; hi = ni; } }
        SL[g * 64 + lane] = hr; SL[2048 + g * 64 + lane] = hi; }
}
DI void ssm_main_unit(const Ctx& C0, int l, int u) {
    Ctx C = C0; fresh(C);
    const int lane = C.lane, wave = C.wave; const bool samp = u >= 512;
    const int b = samp ? u - 512 : (u >> 6), n = samp ? 0 : (u & 63), row0 = samp ? MP + 64 * b : b * LP + 64 * n;
    LAS unsigned char* GG = C.lds; LAS unsigned char* HT = C.lds + 64 * ROWP + wave * 4352;
    LAS float* ssq = (LAS float*)(C.lds + 64 * ROWP + 8 * 4352); LAS float* rstd_l = ssq + 512;
    const unsigned char* blk_p = C.ws + WS_SSMP + (size_t)l * SSMP_LAYER;
#pragma unroll 1
    for (int gi = 0; gi < 4; ++gi) { const int g = wave * 4 + gi;
        SsmGroup S; ssm_load_group(C, l, g, lane, S);
        bf16x8 cf[4]; { const bf16x8* CF = (const bf16x8*)(blk_p + SSMP_CF) + (size_t)g * 4 * 64;
#pragma unroll
            for (int k = 0; k < 4; ++k) cf[k] = CF[k * 64 + lane]; }
        const int t16 = lane & 15, kq = lane >> 4;
        const f32x4 dsk = *(const f32x4*)(C.in[I_SD] + (size_t)(l * 32 + g) * 16 + 4 * kq);
        float hr, hi;
        if (samp) { hr = C.in[I_SRE][((size_t)(l * NBS + b) * 32 + g) * 64 + lane]; hi = C.in[I_SIM][((size_t)(l * NBS + b) * 32 + g) * 64 + lane]; }
        else { const float* A6 = (const float*)(blk_p + SSMP_ABAR64) + g * 128; const float a6r = A6[lane], a6i = A6[64 + lane]; hr = 0.f; hi = 0.f;
            const float* SL = (const float*)(C.ws + WS_SLOC) + (size_t)(b * 64) * 4096 + g * 64 + lane;
            for (int j = 0; j < n; ++j) { const float sr = SL[(size_t)j * 4096], si = SL[(size_t)j * 4096 + 2048];
                const float nr = a6r * hr - a6i * hi + sr, ni = a6r * hi + a6i * hr + si; hr = nr; hi = ni; } }
#pragma unroll 1
        for (int blk = 0; blk < 4; ++blk) { f32x16 dre, dim; ssm_bu_block(C, S, row0 + 16 * blk, g, lane, dre, dim);
#pragma unroll
            for (int r = 0; r < 16; ++r) { const float nr = S.ar * hr - S.ai * hi + dre[r], ni = S.ar * hi + S.ai * hr + dim[r]; hr = nr; hi = ni;
                *(LAS unsigned*)(HT + r * 272 + lane * 4) = pk2(nr, ni); }
            f32x4 yt = {0.f, 0.f, 0.f, 0.f};
#pragma unroll
            for (int k = 0; k < 4; ++k) { const bf16x8 hb = *(const LAS bf16x8*)(HT + t16 * 272 + (32 * k + 8 * kq) * 2); yt = mfma16(cf[k], hb, yt); }
            const v2u uu = *(const v2u*)(C.PROJ + (size_t)(row0 + 16 * blk + t16) * NIN + COL_US + 16 * g + 4 * kq);
            const float y0 = gelu_tanh_f(yt[0] + dsk[0] * bflo(uu.x)), y1 = gelu_tanh_f(yt[1] + dsk[1] * bfhi(uu.x)), y2 = gelu_tanh_f(yt[2] + dsk[2] * bflo(uu.y)), y3 = gelu_tanh_f(yt[3] + dsk[3] * bfhi(uu.y));
            v2u o; o.x = pk2(y0, y1); o.y = pk2(y2, y3);
            *(LAS v2u*)(GG + (16 * blk + t16) * ROWP + (16 * g + 4 * kq) * 2) = o; }
        if (samp || n == 63) { float* ore = C.out + (samp ? O_SRS + ((size_t)(l * NBS + b) * 2048) : O_SRP + ((size_t)(l * NBP + b) * 2048)) + g * 64 + lane;
            float* oim = C.out + (samp ? O_SIS + ((size_t)(l * NBS + b) * 2048) : O_SIP + ((size_t)(l * NBP + b) * 2048)) + g * 64 + lane; *ore = hr; *oim = hi; }
    }
    __syncthreads();
    const int hi5 = lane >> 5, r32 = lane & 31;
    f32x16 acc[4][2];
#pragma unroll
    for (int c = 0; c < 4; ++c) { acc[c][0] = f32x16{}; acc[c][1] = f32x16{}; }
    const bf16x8* WG = (const bf16x8*)(C.ws + WS_WGLU) + (size_t)l * 1024 * 64 + lane;
#pragma unroll 2
    for (int kap = 0; kap < 32; ++kap) {
        bf16x8 af[4], bt[2];
#pragma unroll
        for (int c = 0; c < 4; ++c) { const int ct = (c < 2) ? (2 * wave + c) : (16 + 2 * wave + (c - 2)); af[c] = WG[(size_t)(ct * 32 + kap) * 64]; }
#pragma unroll
        for (int tt = 0; tt < 2; ++tt) bt[tt] = *(const LAS bf16x8*)(GG + (32 * tt + r32) * ROWP + (16 * kap + 8 * hi5) * 2);
#pragma unroll
        for (int c = 0; c < 4; ++c)
#pragma unroll
            for (int tt = 0; tt < 2; ++tt) acc[c][tt] = mfma32(af[c], bt[tt], acc[c][tt]);
    }
    const float* bg = C.in[I_BGLU] + (size_t)l * 1024;
    float sq[2] = {0.f, 0.f};
#pragma unroll
    for (int c = 0; c < 2; ++c)
#pragma unroll
        for (int rr = 0; rr < 4; ++rr) { const int ch0 = 64 * wave + 32 * c + 8 * rr + 4 * hi5; const f32x4 bv = *(const f32x4*)(bg + ch0), bgt = *(const f32x4*)(bg + 512 + ch0);
#pragma unroll
            for (int tt = 0; tt < 2; ++tt)
#pragma unroll
                for (int e = 0; e < 4; ++e) { const float o = (acc[c][tt][4 * rr + e] + bv[e]) * sigm_f(acc[2 + c][tt][4 * rr + e] + bgt[e]); acc[c][tt][4 * rr + e] = o; sq[tt] += o * o; } }
#pragma unroll
    for (int tt = 0; tt < 2; ++tt) { const float t = xh_sum(sq[tt]); if (hi5 == 0) ssq[wave * 64 + 32 * tt + r32] = t; }
    __syncthreads();
#pragma unroll
    for (int c = 0; c < 2; ++c)
#pragma unroll
        for (int rr = 0; rr < 4; ++rr) { const int ch0 = 64 * wave + 32 * c + 8 * rr + 4 * hi5;
#pragma unroll
            for (int tt = 0; tt < 2; ++tt) { v2u o; o.x = pk2(acc[c][tt][4 * rr], acc[c][tt][4 * rr + 1]); o.y = pk2(acc[c][tt][4 * rr + 2], acc[c][tt][4 * rr + 3]);
                *(LAS v2u*)(GG + (32 * tt + r32) * ROWP + ch0 * 2) = o; } }
    __syncthreads();
    branch_tail(C, l, row0, GG, ssq, rstd_l, COL_ZS, 1024);
}

DI void pool_unit(const Ctx& C0, int l, int u) {
    Ctx C = C0; fresh(C);
    const int lane = C.lane, wave = C.wave; const bool samp = u >= 512;
    const int b = samp ? u - 512 : (u >> 6), n = samp ? 0 : (u & 63), row0 = samp ? MP + 64 * b : b * LP + 64 * n;
    LAS unsigned char* DF = C.lds; LAS float* ssq = (LAS float*)(C.lds + 64 * ROWP); LAS float* rstd_l = ssq + 512;
    { const int gi = wave >> 1, w = 2 << gi, ch0 = 128 * gi + 8 * (lane & 15);
      const bool last = samp || n == 63;
      float* po = C.out + (samp ? O_PS + (size_t)(l * NBS + b) * 15 * 512 : O_PP + (size_t)(l * NBP + b) * 15 * 512);
      const float* sp = C.in[I_SPOOL] + (size_t)(l * NBS + b) * 15 * 512;
      for (int it = 0; it < 8; ++it) { const int t = (wave & 1) * 32 + 4 * it + (lane >> 4);
          float sum[8], tok[8];
#pragma unroll
          for (int e = 0; e < 8; ++e) sum[e] = 0.f;
          for (int j = 0; j < w; ++j) { const int rel = t - j; float v[8];
              if (rel >= 0 || (!samp && n > 0)) { unpack8(*(const v4u*)(C.PROJ + (size_t)(row0 + rel) * NIN + COL_UP + ch0), v); }
              else if (samp) { const float* s = sp + (size_t)(15 + rel) * 512 + ch0; const f32x4 a = *(const f32x4*)s, c4 = *(const f32x4*)(s + 4); v[0] = a.x; v[1] = a.y; v[2] = a.z; v[3] = a.w; v[4] = c4.x; v[5] = c4.y; v[6] = c4.z; v[7] = c4.w; }
              else {
#pragma unroll
                  for (int e = 0; e < 8; ++e) v[e] = 0.f; }
#pragma unroll
              for (int e = 0; e < 8; ++e) { sum[e] += v[e]; if (j == 0) tok[e] = v[e]; } }
          const int pos = 64 * n + t; const float cnt = samp ? (float)w : (float)((pos + 1 < w) ? pos + 1 : w), ic = 1.f / cnt;
          float d[8];
#pragma unroll
          for (int e = 0; e < 8; ++e) d[e] = sum[e] * ic - tok[e];
          v4u o; o.x = pk2(d[0], d[1]); o.y = pk2(d[2], d[3]); o.z = pk2(d[4], d[5]); o.w = pk2(d[6], d[7]);
          *(LAS v4u*)(DF + t * ROWP + ch0 * 2) = o;
          if (last && t >= 49) { float* p = po + (size_t)(t - 49) * 512 + ch0; *(f32x4*)p = (f32x4){tok[0], tok[1], tok[2], tok[3]}; *(f32x4*)(p + 4) = (f32x4){tok[4], tok[5], tok[6], tok[7]}; } } }
    __syncthreads();
    const int hi5 = lane >> 5, r32 = lane & 31, gi = wave >> 1;
    f32x16 acc[2][2];
#pragma unroll
    for (int c = 0; c < 2; ++c) { acc[c][0] = f32x16{}; acc[c][1] = f32x16{}; }
    const bf16x8* WP = (const bf16x8*)(C.ws + WS_WPOOL) + (size_t)((l * 4 + gi) * 32) * 64 + lane;
#pragma unroll
    for (int kap = 0; kap < 8; ++kap) { bf16x8 af[2], bt[2];
#pragma unroll
        for (int c = 0; c < 2; ++c) af[c] = WP[(size_t)((2 * (wave & 1) + c) * 8 + kap) * 64];
#pragma unroll
        for (int tt = 0; tt < 2; ++tt) bt[tt] = *(const LAS bf16x8*)(DF + (32 * tt + r32) * ROWP + (128 * gi + 16 * kap + 8 * hi5) * 2);
#pragma unroll
        for (int c = 0; c < 2; ++c)
#pragma unroll
            for (int tt = 0; tt < 2; ++tt) acc[c][tt] = mfma32(af[c], bt[tt], acc[c][tt]); }
    const float* ps = C.in[I_PSCALE] + (size_t)l * 512;
    float sq[2] = {0.f, 0.f};
#pragma unroll
    for (int c = 0; c < 2; ++c)
#pragma unroll
        for (int rr = 0; rr < 4; ++rr) { const int d0 = 128 * gi + 32 * (2 * (wave & 1) + c) + 8 * rr + 4 * hi5; const f32x4 sc = *(const f32x4*)(ps + d0);
#pragma unroll
            for (int tt = 0; tt < 2; ++tt)
#pragma unroll
                for (int e = 0; e < 4; ++e) { const float o = acc[c][tt][4 * rr + e] * sc[e]; acc[c][tt][4 * rr + e] = o; sq[tt] += o * o; } }
#pragma unroll
    for (int tt = 0; tt < 2; ++tt) { const float t = xh_sum(sq[tt]); if (hi5 == 0) ssq[wave * 64 + 32 * tt + r32] = t; }
    __syncthreads();
#pragma unroll
    for (int c = 0; c < 2; ++c)
#pragma unroll
        for (int rr = 0; rr < 4; ++rr) { const int d0 = 128 * gi + 32 * (2 * (wave & 1) + c) + 8 * rr + 4 * hi5;
#pragma unroll
            for (int tt = 0; tt < 2; ++tt) { v2u o; o.x = pk2(acc[c][tt][4 * rr], acc[c][tt][4 * rr + 1]); o.y = pk2(acc[c][tt][4 * rr + 2], acc[c][tt][4 * rr + 3]);
                *(LAS v2u*)(DF + (32 * tt + r32) * ROWP + d0 * 2) = o; } }
    __syncthreads();
    branch_tail(C, l, row0, DF, ssq, rstd_l, COL_ZP, 1536);
}

constexpr int ATT_WB = 10752;
DI void attn_unit(const Ctx& C0, int l, int u) {
    Ctx C = C0; fresh(C);
    const int lane = C.lane, wave = C.wave, r32 = lane & 31, hi = lane >> 5; const bool samp = u < 32;
    const int b = samp ? u : ((u - 32) & 7), n = samp ? 16 : 63 - ((u - 32) >> 3), rq0 = samp ? MP + 64 * b : b * LP + 64 * n;
    const int jstart = samp ? 0 : (n >= 8 ? 0 : 8 - n);
    LAS unsigned char* WL = C.lds + wave * ATT_WB; LAS float* TAB = (LAS float*)(WL + 9216);
    LAS float* ssq = (LAS float*)(C.lds + 8 * ATT_WB); LAS float* rstd_l = ssq + 512;
    const float c1 = 0.125f * LOG2E;
    float ssq_acc[2] = {0.f, 0.f};
    for (int hh = 0; hh < 2; ++hh) { const int h = 2 * wave + hh;
        { const float* rb = C.in[I_RELB] + (size_t)(l * 16 + h) * 513;
#pragma unroll
          for (int k = 0; k < 6; ++k) { const int y = lane + 64 * k; TAB[y] = rb[y < 64 ? 512 : 576 - y] * LOG2E; } }
        const float bconst = C.in[I_RELB][(size_t)(l * 16 + h) * 513 + 512] * LOG2E;
        const bf16* qp = C.PROJ + (size_t)(rq0 + r32) * NIN + COL_Q + h * 64 + 8 * hi;
        f32x16 O[2][2];
#pragma unroll
        for (int db = 0; db < 2; ++db) { O[db][0] = f32x16{}; O[db][1] = f32x16{}; }
        float mrun[2] = {-1e30f, -1e30f}, lrun[2] = {0.f, 0.f};
        for (int j = jstart; j < 9; ++j) {
            const bf16* kp; const bf16* vp; int pitch;
            if (samp && j < 8) { const size_t o = ((size_t)(l * NBS + b) * 512 + 64 * j) * 1024 + h * 64; kp = C.KC + o; vp = C.VC + o; pitch = 1024; }
            else { const size_t row = samp ? (size_t)rq0 : (size_t)(b * LP + 64 * (n - 8 + j)); kp = C.PROJ + row * NIN + COL_K + h * 64; vp = C.PROJ + row * NIN + COL_V + h * 64; pitch = NIN; }
            asm volatile("s_waitcnt lgkmcnt(0)" ::: "memory");
#pragma unroll
            for (int pc = 0; pc < 8; ++pc)
                __builtin_amdgcn_global_load_lds((const unsigned*)(vp + (size_t)(16 * (pc & 3) + (lane >> 2)) * pitch + (pc >> 2) * 32 + (lane & 3) * 8), (LAS unsigned*)(WL + pc * 1024), 16, 0, 0);
            f32x16 S[2][2];
#pragma unroll
            for (int kb = 0; kb < 2; ++kb) { S[kb][0] = f32x16{}; S[kb][1] = f32x16{}; }
#pragma unroll
            for (int k = 0; k < 4; ++k) { const bf16x8 q0 = ld8(qp + 16 * k), q1 = ld8(qp + (size_t)32 * NIN + 16 * k);
#pragma unroll
                for (int kb = 0; kb < 2; ++kb) { const bf16x8 kf = ld8(kp + (size_t)(32 * kb + r32) * pitch + 16 * k + 8 * hi);
                    S[kb][0] = mfma32(kf, q0, S[kb][0]); S[kb][1] = mfma32(kf, q1, S[kb][1]); } }
            bf16x8 pf[2][4];
            const int L0 = 64 * (8 - j);
#pragma unroll
            for (int qb = 0; qb < 2; ++qb) {
                __builtin_amdgcn_sched_barrier(0);
                float mx = -1e30f;
                if (j <= 3) {
#pragma unroll
                    for (int kb = 0; kb < 2; ++kb)
#pragma unroll
                        for (int r = 0; r < 16; ++r) { const float s = S[kb][qb][r] * c1 + bconst; S[kb][qb][r] = s; mx = fmaxf(mx, s); }
                } else {
                    const int ybase = 320 - L0 - (32 * qb + r32) + 4 * hi;
#pragma unroll
                    for (int kb = 0; kb < 2; ++kb)
#pragma unroll
                        for (int r = 0; r < 16; ++r) { const float s = S[kb][qb][r] * c1 + TAB[ybase + 32 * kb + 8 * (r >> 2) + (r & 3)]; S[kb][qb][r] = s; mx = fmaxf(mx, s); }
                }
                mx = xh_max(mx);
                const float mnew = fmaxf(mrun[qb], mx), alpha = ex2(mrun[qb] - mnew); mrun[qb] = mnew;
                float rs = 0.f;
#pragma unroll
                for (int kb = 0; kb < 2; ++kb)
#pragma unroll
                    for (int r = 0; r < 16; ++r) { const float p = ex2(S[kb][qb][r] - mnew); S[kb][qb][r] = p; rs += p; }
                lrun[qb] = lrun[qb] * alpha + rs;
#pragma unroll
                for (int db = 0; db < 2; ++db)
#pragma unroll
                    for (int r = 0; r < 16; ++r) O[db][qb][r] *= alpha;
#pragma unroll
                for (int ks = 0; ks < 4; ++ks) { const int kb = ks >> 1, s8 = 8 * (ks & 1); v4u w;
                    w.x = pk2(S[kb][qb][s8], S[kb][qb][s8 + 1]); w.y = pk2(S[kb][qb][s8 + 2], S[kb][qb][s8 + 3]); w.z = pk2(S[kb][qb][s8 + 4], S[kb][qb][s8 + 5]); w.w = pk2(S[kb][qb][s8 + 6], S[kb][qb][s8 + 7]);
                    pf[qb][ks] = __builtin_bit_cast(bf16x8, w); }
            }
            __builtin_amdgcn_sched_barrier(0);
            asm volatile("s_waitcnt vmcnt(0)" ::: "memory");
            LAS const unsigned char* vb = WL + (4 * hi + ((lane & 15) >> 2)) * 64 + ((lane >> 4) & 1) * 32 + (lane & 3) * 8;
#pragma unroll
            for (int ks = 0; ks < 4; ++ks)
#pragma unroll
                for (int db = 0; db < 2; ++db) { const s16x4 lo = lds_tr(vb + db * 4096 + ks * 1024), up = lds_tr(vb + db * 4096 + ks * 1024 + 512);
                    const bf16x8 vf = {lo[0], lo[1], lo[2], lo[3], up[0], up[1], up[2], up[3]};
                    O[db][0] = mfma32(vf, pf[0][ks], O[db][0]); O[db][1] = mfma32(vf, pf[1][ks], O[db][1]); }
        }
#pragma unroll
        for (int qb = 0; qb < 2; ++qb) { const float inv = 1.f / xh_sum(lrun[qb]); float sq = 0.f;
#pragma unroll
            for (int db = 0; db < 2; ++db)
#pragma unroll
                for (int rr = 0; rr < 4; ++rr) { float o[4];
#pragma unroll
                    for (int e = 0; e < 4; ++e) { o[e] = O[db][qb][4 * rr + e] * inv; sq += o[e] * o[e]; }
                    v2u w; w.x = pk2(o[0], o[1]); w.y = pk2(o[2], o[3]);
                    *(LAS v2u*)(WL + (32 * qb + r32) * 144 + (32 * db + 8 * rr + 4 * hi) * 2) = w; }
            ssq_acc[qb] += xh_sum(sq); }
#pragma unroll
        for (int it = 0; it < 8; ++it) { const int row = 8 * it + (lane >> 3), ch = lane & 7; const v4u v = *(const LAS v4u*)(WL + row * 144 + ch * 16);
            *(v4u*)(C.HY + (size_t)(rq0 + row) * DM + h * 64 + ch * 8) = v; }
    }
    if (hi == 0) { ssq[wave * 64 + r32] = ssq_acc[0]; ssq[wave * 64 + 32 + r32] = ssq_acc[1]; }
    asm volatile("s_waitcnt vmcnt(0)" ::: "memory");
    __syncthreads();
    if (C.tid < 64) { float t = 0.f;
#pragma unroll
        for (int w = 0; w < 8; ++w) t += ssq[w * 64 + C.tid];
        rstd_l[C.tid] = rsqrtf(t * (1.f / 1024.f) + EPSN); }
    __syncthreads();
    const float* gb = C.in[I_BNG] + (size_t)l * DM;
#pragma unroll 2
    for (int it = 0; it < 16; ++it) { const int idx = C.tid + 512 * it, row = idx >> 7, ch = idx & 127;
        bf16* yp = C.HY + (size_t)(rq0 + row) * DM + ch * 8;
        const v4u raw = *(const v4u*)yp; const v4u zz = *(const v4u*)(C.PROJ + (size_t)(rq0 + row) * NIN + COL_ZA + ch * 8);
        const f32x4 g0 = *(const f32x4*)(gb + ch * 8), g1 = *(const f32x4*)(gb + ch * 8 + 4);
        float r[8], z[8]; unpack8(raw, r); unpack8(zz, z); const float rs = rstd_l[row];
        const float gg[8] = {g0.x, g0.y, g0.z, g0.w, g1.x, g1.y, g1.z, g1.w}; float o[8];
#pragma unroll
        for (int e = 0; e < 8; ++e) o[e] = r[e] * rs * gg[e] * silu_f(z[e]);
        v4u w; w.x = pk2(o[0], o[1]); w.y = pk2(o[2], o[3]); w.z = pk2(o[4], o[5]); w.w = pk2(o[6], o[7]);
        *(v4u*)yp = w; }
    __syncthreads();
}

DI int q_next(const Ctx& C0, unsigned* ctr) {
    Ctx C = C0; fresh(C);
    LAS volatile int* slot = (LAS volatile int*)(C.lds + MISC_OFF + 32);
    if (C.tid == 0) *slot = (int)__hip_atomic_fetch_add(ctr, 1u, __ATOMIC_RELAXED, __HIP_MEMORY_SCOPE_AGENT);
    __syncthreads();
    const int v = *slot;
    __syncthreads();
    return v;
}

__global__ void __launch_bounds__(512, 2) hymba_fwd(Args args) {
    extern __shared__ __attribute__((aligned(16))) unsigned char lds_raw[];
    Ctx C; C.in = args.in; C.out = args.out; C.ws = args.ws; C.lds = (LAS unsigned char*)lds_raw;
    C.tid = threadIdx.x; C.lane = C.tid & 63; C.wave = __builtin_amdgcn_readfirstlane(C.tid >> 6); C.G = gridDim.x; C.bid = blockIdx.x;
    C.HY = (bf16*)(args.ws + WS_HY); C.PROJ = (bf16*)(args.ws + WS_PROJ); C.KC = (bf16*)(args.ws + WS_KC); C.VC = (bf16*)(args.ws + WS_VC);
    C.WIN = (bf16*)(args.ws + WS_WIN); C.WOUT = (bf16*)(args.ws + WS_WOUT); C.MOD = (float*)(args.ws + WS_MOD); C.ctl = (unsigned*)(args.ws + WS_CTL);
    if (C.tid < 16) ((LAS unsigned*)(C.lds + MISC_OFF))[C.tid] = 0u;
    __syncthreads();
    const int lo = args.ph_lo, hi = args.ph_hi;
    const bool multi = (hi - lo) > 1;
    XcdBarrier bar; bar.bar = C.ctl + CW_BAR; bar.x = 0; bar.st = nullptr;
    if (multi) bar = xcd_barrier_post(C.ctl + CW_BAR, (volatile LAS unsigned*)(C.lds + MISC_OFF));
#define IN(k) (lo <= (k) && (k) < hi)
#define SEAM(k) do { if (IN(k) && IN((k) + 1)) xcd_barrier(bar); } while (0)
    int ph = 0;
#ifndef PHM
#define PHM 0xff
#endif
    if ((PHM & 1) && IN(ph)) p0_prologue(C);
    SEAM(ph); ++ph;
    if ((PHM & 2) && IN(ph)) norm_phase(C, 0);
    SEAM(ph); ++ph;
    for (int l = 0; l < DEPTH; ++l) {
        if ((PHM & 4) && IN(ph)) {
            pg8::Gemm g{C.HY, C.WIN + (size_t)l * NIN * DM, MT, NIN, DM}; pg8::StaticOrder S; S.init(MT, NIN, C.G, C.bid);
            pg8::EpiProj E{C.PROJ, C.out + O_KP + (size_t)l * NBP * 512 * 1024, C.out + O_VP + (size_t)l * NBP * 512 * 1024, C.out + O_KS + (size_t)l * NBS * 64 * 1024, C.out + O_VS + (size_t)l * NBS * 64 * 1024};
            pg8::gemm_phase<pg8::EpiProj, pg8::StaticOrder, true, true>(C.lds, g, S, E);
        }
        SEAM(ph); ++ph;
        if ((PHM & 8) && IN(ph)) { for (int u = C.bid; u < 512; u += C.G) ssm_local_unit(C, l, u); }
        SEAM(ph); ++ph;
        if ((PHM & 0x70) && IN(ph)) {
            unsigned* ctr = C.ctl + CW_Q + 64 * 3 * l;
            if (PHM & 0x10) for (;;) { const int u = q_next(C, ctr); if (u >= 544) break; attn_unit(C, l, u); }
            if (PHM & 0x20) for (;;) { const int u = q_next(C, ctr + 64); if (u >= 544) break; ssm_main_unit(C, l, u); }
            if (PHM & 0x40) for (;;) { const int u = q_next(C, ctr + 128); if (u >= 544) break; pool_unit(C, l, u); }
        }
        SEAM(ph); ++ph;
        if ((PHM & 0x80) && IN(ph)) {
            pg8::Gemm g{C.HY, C.WOUT + (size_t)l * DM * DM, MT, DM, DM}; pg8::StaticOrder S; S.init(MT, DM, C.G, C.bid);
            pg8::EpiRes E{l == 0 ? C.in[I_XP] : C.out, l == 0 ? C.in[I_XS] : C.out + (size_t)MP * DM, C.out, C.MOD + (size_t)l * 40 * NIN + 2 * DM};
            pg8::gemm_phase<pg8::EpiRes, pg8::StaticOrder, true, true>(C.lds, g, S, E);
        }
        SEAM(ph); ++ph;
        if ((PHM & 2) && IN(ph)) norm_phase(C, l + 1);
        SEAM(ph); ++ph;
    }
#undef IN
#undef SEAM
}

#ifndef N_LAUNCH_MODE
#define N_LAUNCH_MODE 1
#endif
extern "C" void kernel_launch(void* const* d_in, const int* in_sizes, int n_in, void* d_out, int out_size, void* d_ws, size_t ws_size, hipStream_t stream) {
    static int grid = 0;
    if (grid == 0) {
        if (n_in != N_IN || (size_t)out_size != O_END || ws_size < WS_END) { fprintf(stderr, "kernel_launch: unexpected sizes n_in %d out %d ws %zu (need %zu)\n", n_in, out_size, ws_size, (size_t)WS_END); grid = -1; return; }
        int dev = 0, cus = 0, per_cu = 0;
        if (hipGetDevice(&dev) != hipSuccess || hipDeviceGetAttribute(&cus, hipDeviceAttributeMultiprocessorCount, dev) != hipSuccess) { grid = -1; return; }
        if (hipFuncSetAttribute((const void*)hymba_fwd, hipFuncAttributeMaxDynamicSharedMemorySize, LDS_BYTES) != hipSuccess) { fprintf(stderr, "kernel_launch: hipFuncSetAttribute failed\n"); grid = -1; return; }
        if (hipOccupancyMaxActiveBlocksPerMultiprocessor(&per_cu, (const void*)hymba_fwd, 512, LDS_BYTES) != hipSuccess || per_cu < 1) fprintf(stderr, "kernel_launch: occupancy query says %d\n", per_cu);
        (void)hipGetLastError();
        grid = cus;
    }
    if (grid < 0) return;
    (void)in_sizes;
    if (hipMemsetAsync((char*)d_ws + WS_CTL, 0, ZERO_BYTES, stream) != hipSuccess) return;
    Args a{};
    for (int i = 0; i < N_IN; ++i) a.in[i] = (const float*)d_in[i];
    a.out = (float*)d_out; a.ws = (unsigned char*)d_ws;
#if N_LAUNCH_MODE == 1
    a.ph_lo = 0; a.ph_hi = NPH;
    hipLaunchKernelGGL(hymba_fwd, dim3(grid), dim3(512), LDS_BYTES, stream, a);
#else
    for (int p = 0; p < NPH; ++p) { a.ph_lo = p; a.ph_hi = p + 1; hipLaunchKernelGGL(hymba_fwd, dim3(grid), dim3(512), LDS_BYTES, stream, a); }
#endif
}
```

```cpp
#include <hip/hip_runtime.h>
#include <cstdio>
#include <cstdint>
#include <type_traits>
namespace pg8 {
#define PG8_LAS __attribute__((address_space(3)))
typedef unsigned short bf16_t;
typedef short bf16x8 __attribute__((ext_vector_type(8)));
typedef float f32x4 __attribute__((ext_vector_type(4)));
typedef unsigned u32x4 __attribute__((ext_vector_type(4)));
constexpr int BM = 256, BK = 64, HALF = 128, HTB = HALF * BK * 2  , STAGE_BYTES = 8 * HTB, NXCD = 8, WGM = 8;

__host__ __device__ __forceinline__ int lds_byte(int r, int c) { const int st = (r >> 4) * 2 + (c >> 5), rr = r & 15, cc = c & 31, ob = rr * 64 + cc * 2; return st * 1024 + (ob ^ (((ob >> 9) & 1) << 5)); }
__host__ __device__ __forceinline__ void stage_rc(int b, int& R, int& C) { const int st = b / 1024, sb = b % 1024, swz = sb ^ (((sb >> 9) & 1) << 5); R = (st >> 1) * 16 + swz / 64; C = (st & 1) * 32 + (swz % 64) / 2; }
__host__ __device__ __forceinline__ int perm32(int rho) { const int n = rho >> 4, i = rho & 15; return 8 * (i >> 2) + 4 * n + (i & 3); }

struct Unit { int pm, pn; };
struct Gemm { const bf16_t* A; const bf16_t* Bt; int M, N, K; };

struct StaticOrder {
    int nM, nN, nwg, G, c;
    __host__ __device__ void init(int M, int N, int G_, int c_) { nM = M / BM; nN = N / BM; nwg = nM * nN; G = G_; c = c_; }
    __host__ __device__ bool next(int i, Unit& u) const {
        const long L = (long)i * G + c; if (L >= nwg) return false;
        int wgid = (int)L; { const int q = nwg / NXCD, r = nwg % NXCD, xcd = wgid % NXCD, off = wgid / NXCD; wgid = (xcd < r ? xcd * (q + 1) : r * (q + 1) + (xcd - r) * q) + off; }
        const int nig = WGM * nN, gid = wgid / nig, fm = gid * WGM, gsz = (nM - fm) < WGM ? (nM - fm) : WGM;
        u.pm = fm + ((wgid % nig) % gsz); u.pn = (wgid % nig) / gsz; return true;
    }
    __device__ __forceinline__ void a_ready(const Unit&) const {}
    __device__ __forceinline__ void done(const Unit&) const {}
};

__device__ __forceinline__ unsigned cvt_pk_bf16(float lo, float hi) { unsigned r; asm volatile("v_cvt_pk_bf16_f32 %0, %1, %2" : "=v"(r) : "v"(lo), "v"(hi)); return r; }
typedef float f32x2 __attribute__((ext_vector_type(2)));
struct EpiProj {
    static constexpr bool PERM = true, AFTER_DRAIN = false;
    bf16_t* O; float* kp; float* vp; float* ks; float* vs;
    __device__ __forceinline__ void operator()(const f32x4 (&acc)[2][2][4][2], const Unit& u, int wr, int wc, int fr, int fq) const {
        const int lrow0 = wr * 64 + fr, col0 = u.pn * BM + wc * 32 + 8 * fq;
        float* fo = nullptr;
        const bool isk = (u.pn >= 4 && u.pn < 8), isv = (u.pn >= 8 && u.pn < 12);
        if (isk || isv) {
            if (u.pm >= 128) fo = (isk ? ks : vs) + (size_t)(u.pm - 128) * 256 * 1024;
            else if ((u.pm & 15) >= 14) fo = (isk ? kp : vp) + ((size_t)(u.pm >> 4) * 512 + (size_t)((u.pm & 15) - 14) * 256) * 1024;
        }
        const int fcol0 = (u.pn & 3) * 256 + wc * 32 + 8 * fq;
#pragma unroll
        for (int ai = 0; ai < 2; ++ai)
#pragma unroll
            for (int m = 0; m < 4; ++m) { const int lr = lrow0 + ai * HALF + m * 16; bf16_t* rowp = O + (size_t)(u.pm * BM + lr) * 6144 + col0;
#pragma unroll
                for (int bj = 0; bj < 2; ++bj) { const f32x4 v0 = acc[ai][bj][m][0], v1 = acc[ai][bj][m][1];
                    u32x4 w; w.x = cvt_pk_bf16(v0[0], v0[1]); w.y = cvt_pk_bf16(v0[2], v0[3]); w.z = cvt_pk_bf16(v1[0], v1[1]); w.w = cvt_pk_bf16(v1[2], v1[3]);
                    *(u32x4*)(rowp + bj * HALF) = w; } }
        if (fo) {
            float* fb = fo + (size_t)lrow0 * 1024 + fcol0;
#pragma unroll
            for (int ai = 0; ai < 2; ++ai)
#pragma unroll
                for (int m = 0; m < 4; ++m)
#pragma unroll
                    for (int bj = 0; bj < 2; ++bj) { float* fp = fb + (ai * HALF + m * 16) * 1024 + bj * HALF; *(f32x4*)fp = acc[ai][bj][m][0]; *(f32x4*)(fp + 4) = acc[ai][bj][m][1]; }
        }
    }
};
struct EpiRes {
    static constexpr bool PERM = false, AFTER_DRAIN = false;
    const float* xin_p; const float* xin_s; float* xout; const float* gate;
    __device__ __forceinline__ void operator()(const f32x4 (&acc)[2][2][4][2], const Unit& u, int wr, int wc, int fr, int fq) const {
        const int col0 = u.pn * BM + wc * 32 + 4 * fq;
#pragma unroll
        for (int ai = 0; ai < 2; ++ai) {
            const int brow = (u.pm < 128) ? (u.pm >> 4) : (8 + (u.pm - 128) * 4 + 2 * ai + wr);
            f32x4 gv[2][2];
#pragma unroll
            for (int bj = 0; bj < 2; ++bj)
#pragma unroll
                for (int n = 0; n < 2; ++n) gv[bj][n] = *(const f32x4*)(gate + (size_t)brow * 6144 + col0 + bj * HALF + n * 16);
#pragma unroll
            for (int m = 0; m < 4; ++m) { const int r = u.pm * BM + ai * HALF + wr * 64 + m * 16 + fr;
                const float* xi = (u.pm < 128) ? (xin_p + (size_t)r * 2048) : (xin_s + (size_t)(r - 32768) * 2048); float* xo = xout + (size_t)r * 2048;
#pragma unroll
                for (int bj = 0; bj < 2; ++bj)
#pragma unroll
                    for (int n = 0; n < 2; ++n) { const f32x4 xv = *(const f32x4*)(xi + col0 + bj * HALF + n * 16); *(f32x4*)(xo + col0 + bj * HALF + n * 16) = xv + gv[bj][n] * acc[ai][bj][m][n]; }
                asm volatile("" ::: "memory"); }
        }
    }
};

template <class Epi, class Sched, bool ALIGN_EPI = false, bool SP2 = false>
__device__ __forceinline__ void gemm_phase(PG8_LAS unsigned char* lds, const Gemm g, const Sched& S, const Epi& E) {
    int tid_ = threadIdx.x; asm volatile("" : "+v"(tid_));
    const int tid = tid_, wid = __builtin_amdgcn_readfirstlane(tid >> 6), lane = tid & 63, wr = wid >> 2, wc = wid & 3, fr = lane & 15, fq = lane >> 4;
    const int K = g.K, nt = K / BK;
    unsigned voffA[2], voffB[2];
#pragma unroll
    for (int i = 0; i < 2; ++i) { int R, C; stage_rc(tid * 16 + i * 8192, R, C); const int Rb = Epi::PERM ? ((R & ~31) + perm32(R & 31)) : R;
        voffA[i] = (unsigned)(R * K + C) * 2u; voffB[i] = (unsigned)(Rb * K + C) * 2u; }
    const size_t kstep = (size_t)(BK * 2);
    const size_t hstep = (size_t)HALF * K * 2;
    const size_t tstep = 2 * hstep;
    const unsigned ldsw = (unsigned)wid * 1024u;
    const int aoff = lds_byte(wr * 64 + fr, fq * 8), boff = lds_byte(wc * 32 + fr, fq * 8);
#define PG8_SA(b, h) (((b) * 2 + (h)) * HTB)
#define PG8_SB(b, h) ((4 + (b) * 2 + (h)) * HTB)
#define PG8_STAGE(bufoff, gbase, voff) do { _Pragma("unroll") for (int _i = 0; _i < 2; ++_i) \
        __builtin_amdgcn_global_load_lds((const unsigned*)((const char*)(gbase) + (voff)[_i]), (PG8_LAS unsigned*)(lds + (bufoff) + ldsw + _i * 8192), 16, 0, 0); } while (0)
#define PG8_LDA(dst, b, h) do { _Pragma("unroll") for (int m = 0; m < 4; ++m) _Pragma("unroll") for (int k = 0; k < 2; ++k) dst[m][k] = *(const PG8_LAS bf16x8*)(lds + PG8_SA(b, h) + aoff + m * 2048 + k * 1024); } while (0)
#define PG8_LDB(dst, b, h) do { _Pragma("unroll") for (int n = 0; n < 2; ++n) _Pragma("unroll") for (int k = 0; k < 2; ++k) dst[n][k] = *(const PG8_LAS bf16x8*)(lds + PG8_SB(b, h) + boff + n * 2048 + k * 1024); } while (0)
#define PG8_MMA(ai, bj, At, Bt) do { __builtin_amdgcn_s_setprio(1); _Pragma("unroll") for (int m = 0; m < 4; ++m) _Pragma("unroll") for (int n = 0; n < 2; ++n) _Pragma("unroll") for (int k = 0; k < 2; ++k) \
        acc[ai][bj][m][n] = __builtin_amdgcn_mfma_f32_16x16x32_bf16(Bt[n][k], At[m][k], acc[ai][bj][m][n], 0, 0, 0); __builtin_amdgcn_s_setprio(0); } while (0)
#define PG8_WAIT_V(n) asm volatile("s_waitcnt vmcnt(" #n ")" ::: "memory")
#define PG8_WAIT_L(n) asm volatile("s_waitcnt lgkmcnt(" #n ")" ::: "memory")
#define PG8_BAR __builtin_amdgcn_s_barrier()
#define PG8_SCHED __builtin_amdgcn_sched_barrier(0)
    Unit cur, nxt; int ui = 0;
    if (!S.next(0, cur)) return;
    f32x4 acc[2][2][4][2];
#pragma unroll
    for (int a = 0; a < 2; ++a)
#pragma unroll
        for (int b = 0; b < 2; ++b)
#pragma unroll
            for (int m = 0; m < 4; ++m)
#pragma unroll
                for (int n = 0; n < 2; ++n) acc[a][b][m][n] = (f32x4){0.f, 0.f, 0.f, 0.f};
    bf16x8 At[4][2], B0[2][2], B1[2][2];
    const char* cA = (const char*)g.A + (size_t)cur.pm * tstep; const char* cB = (const char*)g.Bt + (size_t)cur.pn * tstep;
    S.a_ready(cur);
    if constexpr (SP2) {
        PG8_STAGE(PG8_SB(0, 0), cB, voffB); PG8_STAGE(PG8_SB(0, 1), cB + hstep, voffB); PG8_STAGE(PG8_SA(0, 0), cA, voffA); PG8_STAGE(PG8_SA(0, 1), cA + hstep, voffA);
        if (wr == 1) PG8_BAR;
        PG8_WAIT_V(2); PG8_BAR;
        PG8_STAGE(PG8_SB(1, 0), cB + kstep, voffB); PG8_STAGE(PG8_SA(1, 0), cA + kstep, voffA); PG8_STAGE(PG8_SB(1, 1), cB + hstep + kstep, voffB);
        PG8_WAIT_V(6); PG8_BAR;
    } else {
        PG8_STAGE(PG8_SB(0, 0), cB, voffB); PG8_STAGE(PG8_SA(0, 0), cA, voffA); PG8_STAGE(PG8_SB(0, 1), cB + hstep, voffB); PG8_STAGE(PG8_SA(0, 1), cA + hstep, voffA);
        if (wr == 1) PG8_BAR;
        PG8_WAIT_V(4); PG8_BAR;
        PG8_STAGE(PG8_SB(1, 0), cB + kstep, voffB); PG8_STAGE(PG8_SA(1, 0), cA + kstep, voffA); PG8_STAGE(PG8_SB(1, 1), cB + hstep + kstep, voffB);
        PG8_WAIT_V(6); PG8_BAR;
    }
    for (;;) {
        const bool has_next = S.next(ui + 1, nxt);
        const char* nA = has_next ? (const char*)g.A + (size_t)nxt.pm * tstep : cA; const char* nB = has_next ? (const char*)g.Bt + (size_t)nxt.pn * tstep : cB;
        for (int t = 0; t < nt; t += 2) {
            const bool last = (t == nt - 2);
            const char* a1 = cA + (size_t)(t + 1) * kstep;
            const char* a2 = last ? nA : cA + (size_t)(t + 2) * kstep; const char* b2 = last ? nB : cB + (size_t)(t + 2) * kstep;
            const char* a3 = a2 + kstep; const char* b3 = b2 + kstep;
            if (last && has_next) S.a_ready(nxt);
            if constexpr (SP2) {
            PG8_LDB(B0, 0, 0); PG8_LDB(B1, 0, 1); PG8_SCHED; PG8_LDA(At, 0, 0); PG8_STAGE(PG8_SA(1, 1), a1 + hstep, voffA);
            PG8_WAIT_V(8); PG8_WAIT_L(0); PG8_BAR; PG8_MMA(0, 0, At, B0); PG8_MMA(0, 1, At, B1); PG8_BAR; PG8_SCHED;
            PG8_LDA(At, 0, 1); PG8_STAGE(PG8_SB(0, 0), b2, voffB); PG8_STAGE(PG8_SB(0, 1), b2 + hstep, voffB); PG8_STAGE(PG8_SA(0, 0), a2, voffA);
            PG8_WAIT_V(8); PG8_WAIT_L(0); PG8_BAR; PG8_MMA(1, 0, At, B0); PG8_MMA(1, 1, At, B1); PG8_BAR; PG8_SCHED;
            PG8_LDB(B0, 1, 0); PG8_LDB(B1, 1, 1); PG8_SCHED; PG8_LDA(At, 1, 0); PG8_STAGE(PG8_SA(0, 1), a2 + hstep, voffA);
            PG8_WAIT_V(8); PG8_WAIT_L(0); PG8_BAR; PG8_MMA(0, 0, At, B0); PG8_MMA(0, 1, At, B1); PG8_BAR; PG8_SCHED;
            PG8_LDA(At, 1, 1); PG8_STAGE(PG8_SB(1, 0), b3, voffB); PG8_STAGE(PG8_SB(1, 1), b3 + hstep, voffB); PG8_STAGE(PG8_SA(1, 0), a3, voffA);
            PG8_WAIT_V(8); PG8_WAIT_L(0); PG8_BAR; PG8_MMA(1, 0, At, B0); PG8_MMA(1, 1, At, B1); PG8_BAR; PG8_SCHED;
            } else {
            PG8_LDB(B0, 0, 0); PG8_SCHED; PG8_LDA(At, 0, 0); PG8_STAGE(PG8_SA(1, 1), a1 + hstep, voffA);
            PG8_WAIT_L(8); PG8_BAR; PG8_WAIT_L(0); PG8_MMA(0, 0, At, B0); PG8_BAR; PG8_SCHED;
            PG8_LDB(B1, 0, 1); PG8_STAGE(PG8_SB(0, 0), b2, voffB);
            PG8_BAR; PG8_WAIT_L(0); PG8_MMA(0, 1, At, B1); PG8_BAR;
            PG8_LDA(At, 0, 1); PG8_STAGE(PG8_SA(0, 0), a2, voffA);
            PG8_BAR; PG8_WAIT_L(0); PG8_MMA(1, 0, At, B0); PG8_BAR; PG8_SCHED;
            PG8_STAGE(PG8_SB(0, 1), b2 + hstep, voffB);
            PG8_WAIT_V(6); PG8_BAR; PG8_MMA(1, 1, At, B1); PG8_BAR;
            PG8_LDB(B0, 1, 0); PG8_SCHED; PG8_LDA(At, 1, 0); PG8_STAGE(PG8_SA(0, 1), a2 + hstep, voffA);
            PG8_WAIT_L(8); PG8_BAR; PG8_WAIT_L(0); PG8_MMA(0, 0, At, B0); PG8_BAR; PG8_SCHED;
            PG8_LDB(B1, 1, 1); PG8_STAGE(PG8_SB(1, 0), b3, voffB);
            PG8_BAR; PG8_WAIT_L(0); PG8_MMA(0, 1, At, B1); PG8_BAR;
            PG8_LDA(At, 1, 1); PG8_STAGE(PG8_SA(1, 0), a3, voffA);
            PG8_BAR; PG8_WAIT_L(0); PG8_MMA(1, 0, At, B0); PG8_BAR; PG8_SCHED;
            PG8_STAGE(PG8_SB(1, 1), b3 + hstep, voffB);
            PG8_WAIT_V(6); PG8_BAR; PG8_MMA(1, 1, At, B1); PG8_BAR;
            }
        }
        if constexpr (ALIGN_EPI) { if (wr == 0) PG8_BAR; }
        if constexpr (!Epi::AFTER_DRAIN) { E(acc, cur, wr, wc, fr, fq); S.done(cur); }
        if (!has_next) break;
#pragma unroll
        for (int a = 0; a < 2; ++a)
#pragma unroll
            for (int b = 0; b < 2; ++b)
#pragma unroll
                for (int m = 0; m < 4; ++m)
#pragma unroll
                    for (int n = 0; n < 2; ++n) acc[a][b][m][n] = (f32x4){0.f, 0.f, 0.f, 0.f};
        cur = nxt; cA = nA; cB = nB; ++ui;
        if constexpr (ALIGN_EPI) { if (wr == 1) PG8_BAR; }
    }
    PG8_WAIT_V(0);
    if constexpr (!ALIGN_EPI) { if (wr == 0) PG8_BAR; }
    PG8_BAR;
    if constexpr (Epi::AFTER_DRAIN) { E.fused(acc, cur, wr, wc, fr, fq, lds, wid, lane); S.done(cur); }
#undef PG8_SA
#undef PG8_SB
#undef PG8_STAGE
#undef PG8_LDA
#undef PG8_LDB
#undef PG8_MMA
#undef PG8_WAIT_V
#undef PG8_WAIT_L
#undef PG8_BAR
#undef PG8_SCHED
}
}
#define LAS __attribute__((address_space(3)))
#define XB_TMO      128
#define XB_XCNT(j)  (256  + 64 * (j))
#define XB_XSUB(j)  (1280 + 64 * (j))
#define XB_XGEN(j)  (2304 + 64 * (j))
#define XB_TOP      3328
#define XB_TOPGEN   3392
#define XCD_BAR_WORDS 3456
#define XB_SPIN_CAP (1u << 18)
#define LAS __attribute__((address_space(3)))

__device__ __forceinline__ unsigned xb_ld(unsigned* p)              { return __hip_atomic_load(p, __ATOMIC_RELAXED, __HIP_MEMORY_SCOPE_AGENT); }
__device__ __forceinline__ unsigned xb_add(unsigned* p, unsigned v) { return __hip_atomic_fetch_add(p, v, __ATOMIC_RELAXED, __HIP_MEMORY_SCOPE_AGENT); }
__device__ __forceinline__ unsigned xb_xcc_id() { return (unsigned)__builtin_amdgcn_s_getreg((3 << 11) | 20) & 0xFu; }
#define XB_SPIN(cond, bar) do { unsigned _sp = 0; while (cond) { __builtin_amdgcn_s_sleep(1); \
    if ((++_sp & 255u) == 0u) { if (xb_ld(&(bar)[XB_TMO])) break; if (_sp > XB_SPIN_CAP) { atomicAdd(&(bar)[XB_TMO], 1u); break; } } } } while (0)

struct XcdBarrier {
    unsigned* bar; unsigned x;
    volatile LAS unsigned* st;
};

__device__ __forceinline__ XcdBarrier xcd_barrier_post(unsigned* bar, volatile LAS unsigned* st) {
    XcdBarrier b; b.bar = bar; b.x = xb_xcc_id(); b.st = st;
    if (threadIdx.x == 0) (void)xb_add(&bar[XB_XCNT(b.x)], 1u);
    return b;
}
__device__ __forceinline__ void xcd_barrier_complete(unsigned* bar, unsigned x, unsigned& nloc, unsigned& nx) {
    const unsigned G = gridDim.x * gridDim.y * gridDim.z;
    unsigned sum, cnt, mine, sp = 0u;
    for (;;) {
        sum = 0u; cnt = 0u; mine = 0u;
#pragma unroll
        for (unsigned j = 0; j < 16; ++j) { const unsigned c = xb_ld(&bar[XB_XCNT(j)]); sum += c; cnt += (c > 0u) ? 1u : 0u; mine = (j == x) ? c : mine; }
        if (sum == G) break;
        __builtin_amdgcn_s_sleep(1);
        if ((++sp & 255u) == 0u) { if (xb_ld(&bar[XB_TMO])) break; if (sp > XB_SPIN_CAP) { atomicAdd(&bar[XB_TMO], 1u); break; } }
    }
    nloc = mine > 0u ? mine : 1u; nx = cnt > 0u ? cnt : 1u;
}

__device__ __forceinline__ void xcd_barrier(const XcdBarrier& b) {
    asm volatile("s_waitcnt vmcnt(0)" ::: "memory");
    __syncthreads();
    if (threadIdx.x == 0) {
        unsigned* bar = b.bar;
        __builtin_amdgcn_s_waitcnt(0);
        unsigned nloc = b.st[0], nx = b.st[1];
        if (nloc == 0u) { xcd_barrier_complete(bar, b.x, nloc, nx); b.st[0] = nloc; b.st[1] = nx; }
        const unsigned old = xb_add(&bar[XB_XSUB(b.x)], 1u);
        const unsigned gen = old / nloc;
        if (old + 1u == (gen + 1u) * nloc) {
            __builtin_amdgcn_fence(__ATOMIC_RELEASE, "agent");
            asm volatile("s_waitcnt vmcnt(0)" ::: "memory");
            const unsigned og = xb_add(&bar[XB_TOP], 1u);
            const unsigned tg = og / nx;
            if (og + 1u == (tg + 1u) * nx) xb_add(&bar[XB_TOPGEN], 1u);
            else XB_SPIN(xb_ld(&bar[XB_TOPGEN]) == tg, bar);
            __builtin_amdgcn_fence(__ATOMIC_ACQUIRE, "agent");
            xb_add(&bar[XB_XGEN(b.x)], 1u);
            asm volatile("s_waitcnt vmcnt(0)" ::: "memory");
        } else {
            XB_SPIN(xb_ld(&bar[XB_XGEN(b.x)]) == gen, bar);
            __builtin_amdgcn_fence(__ATOMIC_ACQUIRE, "agent");
            asm volatile("s_waitcnt vmcnt(0)" ::: "memory");
        }
    }
    __syncthreads();
}

#ifndef REP
#define REP 0
#endif
constexpr int DM = 2048, NIN = 6144, MP = 32768, MS = 2048, MT = MP + MS, DEPTH = 4;
constexpr int NBP = 8, LP = 4096, NBS = 32, LSQ = 64;
constexpr int COL_Q = 0, COL_K = 1024, COL_V = 2048, COL_ZA = 3072, COL_US = 4096, COL_ZS = 4608, COL_UP = 5120, COL_ZP = 5632;
constexpr float EPSN = 1e-6f, LOG2E = 1.4426950408889634f;
constexpr size_t O_YP = 0, O_YS = O_YP + (size_t)MP * DM, O_KP = O_YS + (size_t)MS * DM, O_VP = O_KP + (size_t)DEPTH * NBP * 512 * 1024,
    O_SRP = O_VP + (size_t)DEPTH * NBP * 512 * 1024, O_SIP = O_SRP + (size_t)DEPTH * NBP * 2048, O_PP = O_SIP + (size_t)DEPTH * NBP * 2048,
    O_KS = O_PP + (size_t)DEPTH * NBP * 15 * 512, O_VS = O_KS + (size_t)DEPTH * NBS * 64 * 1024, O_SRS = O_VS + (size_t)DEPTH * NBS * 64 * 1024,
    O_SIS = O_SRS + (size_t)DEPTH * NBS * 2048, O_PS = O_SIS + (size_t)DEPTH * NBS * 2048, O_END = O_PS + (size_t)DEPTH * NBS * 15 * 512;
enum { I_XP = 0, I_XS, I_CP, I_CS, I_CK, I_CV, I_SRE, I_SIM, I_SPOOL, I_NORMG, I_WADA, I_BADA, I_WIN, I_RELB, I_AR, I_AI, I_LDT, I_BR, I_BI, I_CR, I_CI, I_SD, I_WGLU, I_BGLU,
       I_WPOOL, I_PSCALE, I_BNG, I_WOUT, I_FNG, N_IN };
constexpr size_t MiB = 1u << 20;
constexpr size_t WS_CTL = 0, WS_MOD = 1 * MiB, ZERO_BYTES = 5 * MiB, WS_SSMP = 5 * MiB, SSMP_LAYER = 512 * 1024, WS_WGLU = 7 * MiB, WS_WPOOL = 11 * MiB, WS_SLOC = 12 * MiB,
    WS_WOUT = 20 * MiB, WS_WIN = 52 * MiB, WS_HY = 148 * MiB, WS_PROJ = 284 * MiB, WS_KC = 692 * MiB, WS_VC = 820 * MiB, WS_END = 948 * MiB;
constexpr size_t SSMP_ABAR = 0, SSMP_ABAR64 = 16384, SSMP_BF = 32768, SSMP_CF = 32768 + 131072;
constexpr int CW_BAR = 4096, CW_Q = 16384;
constexpr int LDS_BYTES = 147456, MISC_OFF = LDS_BYTES - 64;
constexpr int NPH = 2 + 6 * DEPTH;

#define GAS __attribute__((address_space(1)))
typedef unsigned short bf16;
typedef unsigned v4u __attribute__((ext_vector_type(4)));
typedef unsigned v2u __attribute__((ext_vector_type(2)));
typedef float f32x4 __attribute__((ext_vector_type(4)));
typedef float f32x16 __attribute__((ext_vector_type(16)));
typedef short bf16x8 __attribute__((ext_vector_type(8)));
typedef short s16x4 __attribute__((ext_vector_type(4)));
typedef float f32x2_t __attribute__((ext_vector_type(2)));
typedef __bf16 bf16x2_t __attribute__((ext_vector_type(2)));
#define DI __device__ __forceinline__
DI unsigned pk2(float lo, float hi) { f32x2_t v = {lo, hi}; bf16x2_t b = __builtin_convertvector(v, bf16x2_t); return __builtin_bit_cast(unsigned, b); }
DI float bflo(unsigned u) { return __uint_as_float(u << 16); }
DI float bfhi(unsigned u) { return __uint_as_float(u & 0xffff0000u); }
DI float ex2(float x) { return __builtin_amdgcn_exp2f(x); }
DI float rcpf_(float x) { return __builtin_amdgcn_rcpf(x); }
DI float silu_f(float z) { return z * rcpf_(1.f + ex2(-LOG2E * z)); }
DI float sigm_f(float z) { return rcpf_(1.f + ex2(-LOG2E * z)); }
DI float gelu_tanh_f(float x) { const float t = x + 0.044715f * x * x * x; return x * rcpf_(1.f + ex2(-(1.5957691216057308f * LOG2E) * t)); }
DI float xh_max(float v) { auto rr = __builtin_amdgcn_permlane32_swap(__float_as_uint(v), __float_as_uint(v), false, false); return fmaxf(__uint_as_float(rr[0]), __uint_as_float(rr[1])); }
DI float xh_sum(float v) { auto rr = __builtin_amdgcn_permlane32_swap(__float_as_uint(v), __float_as_uint(v), false, false); return __uint_as_float(rr[0]) + __uint_as_float(rr[1]); }
DI float wave_sum(float v) {
#pragma unroll
    for (int o = 1; o < 64; o <<= 1) v += __shfl_xor(v, o);
    return v; }
DI f32x16 mfma32(bf16x8 a, bf16x8 b, f32x16 c) { return __builtin_amdgcn_mfma_f32_32x32x16_bf16(a, b, c, 0, 0, 0); }
DI f32x4 mfma16(bf16x8 a, bf16x8 b, f32x4 c) { return __builtin_amdgcn_mfma_f32_16x16x32_bf16(a, b, c, 0, 0, 0); }
typedef short v4i16_t __attribute__((ext_vector_type(4)));
DI s16x4 lds_tr(LAS const unsigned char* p) { return __builtin_bit_cast(s16x4, __builtin_amdgcn_ds_read_tr16_b64_v4i16((LAS v4i16_t*)p)); }
DI bf16x8 zero8() { return (bf16x8){0, 0, 0, 0, 0, 0, 0, 0}; }
DI bf16x8 ld8(const bf16* p) { return *(const bf16x8*)p; }
DI void unpack8(v4u w, float (&f)[8]) { f[0] = bflo(w.x); f[1] = bfhi(w.x); f[2] = bflo(w.y); f[3] = bfhi(w.y); f[4] = bflo(w.z); f[5] = bfhi(w.z); f[6] = bflo(w.w); f[7] = bfhi(w.w); }

struct Args { const float* in[N_IN]; float* out; unsigned char* ws; int ph_lo, ph_hi; };
static_assert(sizeof(Args) == (N_IN + 2) * 8 + 8, "Args has no padding");

DI int otid() { int t = threadIdx.x; asm volatile("" : "+v"(t)); return t; }
struct Ctx {
    const float* const* in; float* out; unsigned char* ws; LAS unsigned char* lds;
    int tid, lane, wave, G, bid;
    bf16* HY; bf16* PROJ; bf16* KC; bf16* VC; bf16* WIN; bf16* WOUT; float* MOD; unsigned* ctl;
};

DI void fresh(Ctx& C) { C.tid = otid(); C.lane = C.tid & 63; C.wave = __builtin_amdgcn_readfirstlane(C.tid >> 6); }
DI void p0_mod_unit(const Ctx& C0, int u) {
    Ctx C = C0; fresh(C);
    const int l = u / 96, rem = u % 96, cb = rem >> 3, ke = rem & 7, k0 = ke * 256;
    LAS float* sc = (LAS float*)C.lds;
    for (int idx = C.tid; idx < 256 * 40; idx += 512) { const int r = idx >> 8, kk = idx & 255;
        const float cv = (r < 8) ? C.in[I_CP][r * DM + k0 + kk] : C.in[I_CS][(r - 8) * DM + k0 + kk]; sc[kk * 40 + r] = silu_f(cv); }
    __syncthreads();
    const int j = cb * 512 + C.tid;
    const float* W = C.in[I_WADA] + (size_t)l * DM * NIN + (size_t)k0 * NIN + j;
    float acc[40];
#pragma unroll
    for (int r = 0; r < 40; ++r) acc[r] = 0.f;
    for (int kk = 0; kk < 256; kk += 4) {
        float w[4];
#pragma unroll
        for (int q = 0; q < 4; ++q) w[q] = W[(size_t)(kk + q) * NIN];
#pragma unroll
        for (int q = 0; q < 4; ++q) { const LAS f32x4* s = (const LAS f32x4*)(sc + (kk + q) * 40);
#pragma unroll
            for (int t = 0; t < 10; ++t) { const f32x4 v = s[t]; acc[4 * t] += v.x * w[q]; acc[4 * t + 1] += v.y * w[q]; acc[4 * t + 2] += v.z * w[q]; acc[4 * t + 3] += v.w * w[q]; } }
    }
    float* M = (float*)(C.ws + WS_MOD) + (size_t)l * 40 * NIN + j;
    const float bias = (ke == 0) ? C.in[I_BADA][l * NIN + j] : 0.f;
#pragma unroll
    for (int r = 0; r < 40; ++r) unsafeAtomicAdd(M + (size_t)r * NIN, acc[r] + bias);
    __syncthreads();
}
DI void p0_transpose_item(const float* W, int K, int N, bf16* WT, LAS float* scr, int item, int lane) {
    const int nblk = N / 32, kb = item / nblk, nb = item % nblk, k0 = 64 * kb, n0 = 32 * nb;
#pragma unroll 8
    for (int i = 0; i < 32; ++i) { const int kk = 2 * i + (lane >> 5); scr[kk * 33 + (lane & 31)] = W[(size_t)(k0 + kk) * N + n0 + (lane & 31)]; }
    asm volatile("s_waitcnt lgkmcnt(0)" ::: "memory");
    const int c = lane & 7;
#pragma unroll
    for (int j = 0; j < 4; ++j) { const int n = (lane >> 3) + 8 * j; const LAS float* s = scr + (8 * c) * 33 + n;
        v4u o; o.x = pk2(s[0 * 33], s[1 * 33]); o.y = pk2(s[2 * 33], s[3 * 33]); o.z = pk2(s[4 * 33], s[5 * 33]); o.w = pk2(s[6 * 33], s[7 * 33]);
        *(v4u*)(WT + (size_t)(n0 + n) * K + k0 + 8 * c) = o; }
    asm volatile("s_waitcnt lgkmcnt(0)" ::: "memory");
}
DI void p0_ssm_params(const Ctx& C, int l, int g, int lane) {
    unsigned char* blk = C.ws + WS_SSMP + (size_t)l * SSMP_LAYER;
    const int gp = (l * 32 + g) * 64 + lane;
    const float dt = expf(C.in[I_LDT][l * 32 + g]);
    const float ar = C.in[I_AR][gp], ai = C.in[I_AI][gp];
    const float x = ar * dt, ang = ai * dt;
    float sn, cs; sincosf(ang, &sn, &cs);
    const float mag = expf(x), em1 = expm1f(x);
    const float abr = mag * cs, abi = mag * sn;
    float sh, ch; sincosf(0.5f * ang, &sh, &ch); (void)ch;
    const float nr = em1 * cs - 2.f * sh * sh, ni = abi;
    const float den = ar * ar + ai * ai;
    const float cr = (nr * ar + ni * ai) / den, ci = (ni * ar - nr * ai) / den;
    float* AB = (float*)(blk + SSMP_ABAR) + g * 128; AB[lane] = abr; AB[64 + lane] = abi;
    { float s64, c64; sincosf(64.f * ang, &s64, &c64); const float m64 = expf(64.f * x); float* A6 = (float*)(blk + SSMP_ABAR64) + g * 128; A6[lane] = m64 * c64; A6[64 + lane] = m64 * s64; }
    const float* br = C.in[I_BR] + (size_t)gp * 16; const float* bi = C.in[I_BI] + (size_t)gp * 16;
    float bbr[16], bbi[16];
#pragma unroll
    for (int c = 0; c < 16; ++c) { const float b_r = br[c], b_i = bi[c]; bbr[c] = cr * b_r - ci * b_i; bbi[c] = cr * b_i + ci * b_r; }
    v4u* BF = (v4u*)(blk + SSMP_BF) + (size_t)g * 4 * 64;
#pragma unroll
    for (int half = 0; half < 2; ++half) {
        v4u o; o.x = pk2(bbr[8 * half], bbr[8 * half + 1]); o.y = pk2(bbr[8 * half + 2], bbr[8 * half + 3]); o.z = pk2(bbr[8 * half + 4], bbr[8 * half + 5]); o.w = pk2(bbr[8 * half + 6], bbr[8 * half + 7]);
        BF[(0 + half) * 64 + lane] = o;
        o.x = pk2(bbi[8 * half], bbi[8 * half + 1]); o.y = pk2(bbi[8 * half + 2], bbi[8 * half + 3]); o.z = pk2(bbi[8 * half + 4], bbi[8 * half + 5]); o.w = pk2(bbi[8 * half + 6], bbi[8 * half + 7]);
        BF[(2 + half) * 64 + lane] = o; }
    v4u* CF = (v4u*)(blk + SSMP_CF) + (size_t)g * 4 * 64;
    const int c = lane & 15, kq = lane >> 4;
    const float* crp = C.in[I_CR] + ((size_t)(l * 32 + g) * 16 + c) * 64; const float* cip = C.in[I_CI] + ((size_t)(l * 32 + g) * 16 + c) * 64;
#pragma unroll
    for (int kap = 0; kap < 4; ++kap) { const int p0 = 16 * kap + 4 * kq;
        v4u o; o.x = pk2(crp[p0], -cip[p0]); o.y = pk2(crp[p0 + 1], -cip[p0 + 1]); o.z = pk2(crp[p0 + 2], -cip[p0 + 2]); o.w = pk2(crp[p0 + 3], -cip[p0 + 3]);
        CF[kap * 64 + lane] = o; }
}
DI void p0_prologue(const Ctx& C0, bool with_mod) {
    if (with_mod) for (int u = C0.bid; u < 384; u += C0.G) p0_mod_unit(C0, u);
    __syncthreads();
    Ctx C = C0; fresh(C);
    const int gw = C.bid * 8 + C.wave, NGW = C.G * 8, lane = C.lane;
    LAS float* scr = (LAS float*)(C.lds + C.wave * 16384);
    constexpr int I_IN = (DM / 64) * (NIN / 32), I_OUT = (DM / 64) * (DM / 32);
    for (int it = gw; it < DEPTH * (I_IN + I_OUT); it += NGW) {
        const int l = it / (I_IN + I_OUT), r = it % (I_IN + I_OUT);
        if (r < I_IN) p0_transpose_item(C.in[I_WIN] + (size_t)l * DM * NIN, DM, NIN, C.WIN + (size_t)l * NIN * DM, scr, r, lane);
        else p0_transpose_item(C.in[I_WOUT] + (size_t)l * DM * DM, DM, DM, C.WOUT + (size_t)l * DM * DM, scr, r - I_IN, lane);
    }
    for (int it = gw; it < DEPTH * 1024; it += NGW) { const int l = it >> 10, ct = (it >> 5) & 31, kap = it & 31;
        const float* w = C.in[I_WGLU] + (size_t)l * 512 * 1024 + (size_t)(16 * kap + 8 * (lane >> 5)) * 1024 + 32 * ct + (lane & 31);
        v4u o; o.x = pk2(w[0], w[1024]); o.y = pk2(w[2048], w[3072]); o.z = pk2(w[4096], w[5120]); o.w = pk2(w[6144], w[7168]);
        ((v4u*)(C.ws + WS_WGLU))[(size_t)it * 64 + lane] = o; }
    for (int it = gw; it < DEPTH * 128; it += NGW) { const int lg = it >> 5, ct = (it >> 3) & 3, kap = it & 7;
        const float* w = C.in[I_WPOOL] + (size_t)lg * 128 * 128 + (size_t)(16 * kap + 8 * (lane >> 5)) * 128 + 32 * ct + (lane & 31);
        v4u o; o.x = pk2(w[0], w[128]); o.y = pk2(w[256], w[384]); o.z = pk2(w[512], w[640]); o.w = pk2(w[768], w[896]);
        ((v4u*)(C.ws + WS_WPOOL))[(size_t)it * 64 + lane] = o; }
    for (int it = gw; it < DEPTH * 32; it += NGW) p0_ssm_params(C, it >> 5, it & 31, lane);
    { const size_t n8 = (size_t)DEPTH * NBS * 512 * 1024 / 8; const size_t stride = (size_t)C.G * 512;
      for (size_t i = (size_t)C.bid * 512 + C.tid; i < 2 * n8; i += stride) { const bool isv = i >= n8; const size_t e = (isv ? i - n8 : i) * 8;
          const float* s = (isv ? C.in[I_CV] : C.in[I_CK]) + e; const f32x4 a = *(const f32x4*)s, b = *(const f32x4*)(s + 4);
          v4u o; o.x = pk2(a.x, a.y); o.y = pk2(a.z, a.w); o.z = pk2(b.x, b.y); o.w = pk2(b.z, b.w); *(v4u*)((isv ? C.VC : C.KC) + e) = o; } }
}

DI void norm_phase(const Ctx& C0, int l) {
    Ctx C = C0; fresh(C);
    const int gw = C.bid * 8 + C.wave, NGW = C.G * 8, lane = C.lane;
    const int rpw = (MT + NGW - 1) / NGW;
    const bool fin = (l == DEPTH);
    const float* gvec = fin ? C.in[I_FNG] : C.in[I_NORMG] + (size_t)l * DM;
    for (int i = 0; i < rpw; ++i) { const int m = gw * rpw + i; if (m >= MT) break;
        const float* xr = (l == 0) ? (m < MP ? C.in[I_XP] + (size_t)m * DM : C.in[I_XS] + (size_t)(m - MP) * DM) : C.out + (size_t)m * DM;
        const f32x4* x4 = (const f32x4*)xr + lane;
        f32x4 v[8]; float s = 0.f;
#pragma unroll
        for (int j = 0; j < 8; ++j) { v[j] = x4[64 * j]; s += (v[j].x * v[j].x + v[j].y * v[j].y) + (v[j].z * v[j].z + v[j].w * v[j].w); }
        const float rstd = rsqrtf(wave_sum(s) * (1.f / DM) + EPSN);
        if (fin) { f32x4* o4 = (f32x4*)(C.out + (size_t)m * DM) + lane;
#pragma unroll
            for (int j = 0; j < 8; ++j) { const f32x4 g = ((const f32x4*)gvec)[lane + 64 * j]; o4[64 * j] = v[j] * rstd * g; } }
        else { const int brow = (m < MP) ? (m >> 12) : 8 + ((m - MP) >> 6);
            const float* md = C.MOD + ((size_t)l * 40 + brow) * NIN;
            v2u* o8 = (v2u*)(C.HY + (size_t)m * DM) + lane;
#pragma unroll
            for (int j = 0; j < 8; ++j) { const f32x4 g = ((const f32x4*)gvec)[lane + 64 * j], sh = ((const f32x4*)md)[lane + 64 * j], sc = ((const f32x4*)(md + DM))[lane + 64 * j];
                const f32x4 h = v[j] * rstd * g * (sc + 1.f) + sh; v2u o; o.x = pk2(h.x, h.y); o.y = pk2(h.z, h.w); o8[64 * j] = o; } }
    }
}

constexpr int ROWP = 1040;
DI void branch_tail(const Ctx& C, int l, int row0, LAS unsigned char* ST, LAS float* ssq, LAS float* rstd_l, int zcol, int ycol) {
    if (C.tid < 64) { float t = 0.f;
#pragma unroll
        for (int w = 0; w < 8; ++w) t += ssq[w * 64 + C.tid];
        rstd_l[C.tid] = rsqrtf(t * (1.f / 512.f) + EPSN); }
    __syncthreads();
    const float* gb = C.in[I_BNG] + (size_t)l * DM + ycol;
#pragma unroll 2
    for (int it = 0; it < 8; ++it) { const int idx = C.tid + 512 * it, row = idx >> 6, ch = idx & 63;
        const v4u raw = *(const LAS v4u*)(ST + row * ROWP + ch * 16);
        const v4u zz = *(const v4u*)(C.PROJ + (size_t)(row0 + row) * NIN + zcol + ch * 8);
        const f32x4 g0 = *(const f32x4*)(gb + ch * 8), g1 = *(const f32x4*)(gb + ch * 8 + 4);
        float r[8], z[8]; unpack8(raw, r); unpack8(zz, z); const float rs = rstd_l[row];
        const float gg[8] = {g0.x, g0.y, g0.z, g0.w, g1.x, g1.y, g1.z, g1.w}; float o[8];
#pragma unroll
        for (int e = 0; e < 8; ++e) o[e] = r[e] * rs * gg[e] * silu_f(z[e]);
        v4u w; w.x = pk2(o[0], o[1]); w.y = pk2(o[2], o[3]); w.z = pk2(o[4], o[5]); w.w = pk2(o[6], o[7]);
        *(v4u*)(C.HY + (size_t)(row0 + row) * DM + ycol + ch * 8) = w; }
    __syncthreads();
}

struct SsmGroup { float ar, ai; bf16x8 bf[4]; };
DI void ssm_load_group(const Ctx& C, int l, int g, int lane, SsmGroup& S) {
    const unsigned char* blk = C.ws + WS_SSMP + (size_t)l * SSMP_LAYER;
    const float* AB = (const float*)(blk + SSMP_ABAR) + g * 128; S.ar = AB[lane]; S.ai = AB[64 + lane];
    const bf16x8* BF = (const bf16x8*)(blk + SSMP_BF) + (size_t)g * 4 * 64;
#pragma unroll
    for (int f = 0; f < 4; ++f) S.bf[f] = BF[f * 64 + lane];
}
struct SsmA { bf16x8 a0[4], a1[4]; };
DI void ssm_load_a(const Ctx& C, int row0, int g, int lane, SsmA& A) {
    const int i = lane & 31, kh = lane >> 5, ti = 4 * (i >> 3) + (i & 3); const bool act = ((i >> 2) & 1) == kh;
    const bf16* src = C.PROJ + (size_t)(row0 + ti) * NIN + COL_US + 16 * g;
#pragma unroll
    for (int blk = 0; blk < 4; ++blk) { A.a0[blk] = ld8(src + (size_t)blk * 16 * NIN); A.a1[blk] = ld8(src + (size_t)blk * 16 * NIN + 8);
        if (!act) { A.a0[blk] = zero8(); A.a1[blk] = zero8(); } }
}
DI void ssm_bu(const SsmGroup& S, const bf16x8 a0, const bf16x8 a1, f32x16& dre, f32x16& dim) {
    const f32x16 z = {};
    dre = mfma32(a0, S.bf[0], z); dre = mfma32(a1, S.bf[1], dre);
    dim = mfma32(a0, S.bf[2], z); dim = mfma32(a1, S.bf[3], dim);
}
DI void ssm_local_unit(const Ctx& C0, int l, int u) {
    Ctx C = C0; fresh(C);
    const int lane = C.lane, row0 = (u >> 6) * LP + (u & 63) * 64;
    float* SL = (float*)(C.ws + WS_SLOC) + (size_t)u * 4096;
    SsmGroup S; SsmA A; ssm_load_group(C, l, C.wave * 4, lane, S); ssm_load_a(C, row0, C.wave * 4, lane, A);
#pragma unroll 1
    for (int gi = 0; gi < 4; ++gi) { const int g = C.wave * 4 + gi;
        SsmGroup Sn; SsmA An; if (gi < 3) { ssm_load_group(C, l, g + 1, lane, Sn); ssm_load_a(C, row0, g + 1, lane, An); }
        float hr = 0.f, hi = 0.f;
#pragma unroll
        for (int blk = 0; blk < 4; ++blk) { f32x16 dre, dim; ssm_bu(S, A.a0[blk], A.a1[blk], dre, dim);
#pragma unroll
            for (int r = 0; r < 16; ++r) { const float nr = S.ar * hr - S.ai * hi + dre[r], ni = S.ar * hi + S.ai * hr + dim[r]; hr = nr; hi = ni; } }
        SL[g * 64 + lane] = hr; SL[2048 + g * 64 + lane] = hi;
        if (gi < 3) { S = Sn; A = An; } }
}
DI void ssm_carry_phase(const Ctx& C0, int l) {
    Ctx C = C0; fresh(C);
    const int t = C.wave * C.G + C.bid; if (t >= 256) return;
    const int b = t >> 5, g = t & 31, lane = C.lane;
    const float* A6 = (const float*)(C.ws + WS_SSMP + (size_t)l * SSMP_LAYER + SSMP_ABAR64) + g * 128; const float a6r = A6[lane], a6i = A6[64 + lane];
    float* SL = (float*)(C.ws + WS_SLOC) + (size_t)(b * 64) * 4096 + g * 64 + lane;
    float hr = 0.f, hi = 0.f;
#pragma unroll 1
    for (int nb = 0; nb < 4; ++nb) { float sr[16], si[16];
#pragma unroll
        for (int i = 0; i < 16; ++i) { sr[i] = SL[(size_t)(16 * nb + i) * 4096]; si[i] = SL[(size_t)(16 * nb + i) * 4096 + 2048]; }
#pragma unroll
        for (int i = 0; i < 16; ++i) { SL[(size_t)(16 * nb + i) * 4096] = hr; SL[(size_t)(16 * nb + i) * 4096 + 2048] = hi;
            const float nr = a6r * hr - a6i * hi + sr[i], ni = a6r * hi + a6i * hr + si[i]; hr = nr; hi = ni; } }
}
struct SsmPre { SsmGroup S; SsmA A; bf16x8 cf[4]; f32x4 dsk; v2u uu[4]; float hr, hi; };
DI void ssm_prefetch(const Ctx& C, int l, int g, int row0, bool samp, int b, int n, int lane, SsmPre& P) {
    const unsigned char* blk_p = C.ws + WS_SSMP + (size_t)l * SSMP_LAYER;
    ssm_load_group(C, l, g, lane, P.S); ssm_load_a(C, row0, g, lane, P.A);
    const bf16x8* CF = (const bf16x8*)(blk_p + SSMP_CF) + (size_t)g * 4 * 64;
#pragma unroll
    for (int k = 0; k < 4; ++k) P.cf[k] = CF[k * 64 + lane];
    const int t16 = lane & 15, kq = lane >> 4;
    P.dsk = *(const f32x4*)(C.in[I_SD] + (size_t)(l * 32 + g) * 16 + 4 * kq);
#pragma unroll
    for (int blk = 0; blk < 4; ++blk) P.uu[blk] = *(const v2u*)(C.PROJ + (size_t)(row0 + 16 * blk + t16) * NIN + COL_US + 16 * g + 4 * kq);
    if (samp) { P.hr = C.in[I_SRE][((size_t)(l * NBS + b) * 32 + g) * 64 + lane]; P.hi = C.in[I_SIM][((size_t)(l * NBS + b) * 32 + g) * 64 + lane]; }
    else { const float* SL = (const float*)(C.ws + WS_SLOC) + (size_t)(b * 64 + n) * 4096 + g * 64 + lane; P.hr = SL[0]; P.hi = SL[2048]; }
}
DI void ssm_main_unit(const Ctx& C0, int l, int u) {
    Ctx C = C0; fresh(C);
    const int lane = C.lane, wave = C.wave; const bool samp = u >= 512;
    const int b = samp ? u - 512 : (u >> 6), n = samp ? 0 : (u & 63), row0 = samp ? MP + 64 * b : b * LP + 64 * n;
    LAS unsigned char* GG = C.lds; LAS unsigned char* HT = C.lds + 64 * ROWP + wave * 4352;
    LAS float* ssq = (LAS float*)(C.lds + 64 * ROWP + 8 * 4352); LAS float* rstd_l = ssq + 512;
    { SsmPre P; ssm_prefetch(C, l, wave * 4, row0, samp, b, n, lane, P);
#pragma unroll 1
      for (int gi = 0; gi < 4; ++gi) { const int g = wave * 4 + gi;
        SsmPre Pn; if (gi < 3) ssm_prefetch(C, l, g + 1, row0, samp, b, n, lane, Pn);
        const int t16 = lane & 15, kq = lane >> 4;
        float hr = P.hr, hi = P.hi;
#pragma unroll
        for (int blk = 0; blk < 4; ++blk) { f32x16 dre, dim; ssm_bu(P.S, P.A.a0[blk], P.A.a1[blk], dre, dim);
#pragma unroll
            for (int r = 0; r < 16; ++r) { const float nr = P.S.ar * hr - P.S.ai * hi + dre[r], ni = P.S.ar * hi + P.S.ai * hr + dim[r]; hr = nr; hi = ni;
                *(LAS unsigned*)(HT + r * 272 + lane * 4) = pk2(nr, ni); }
            f32x4 yt = {0.f, 0.f, 0.f, 0.f};
#pragma unroll
            for (int k = 0; k < 4; ++k) { const bf16x8 hb = *(const LAS bf16x8*)(HT + t16 * 272 + (32 * k + 8 * kq) * 2); yt = mfma16(P.cf[k], hb, yt); }
            const v2u uu = P.uu[blk];
            const float y0 = gelu_tanh_f(yt[0] + P.dsk[0] * bflo(uu.x)), y1 = gelu_tanh_f(yt[1] + P.dsk[1] * bfhi(uu.x)), y2 = gelu_tanh_f(yt[2] + P.dsk[2] * bflo(uu.y)), y3 = gelu_tanh_f(yt[3] + P.dsk[3] * bfhi(uu.y));
            v2u o; o.x = pk2(y0, y1); o.y = pk2(y2, y3);
            *(LAS v2u*)(GG + (16 * blk + t16) * ROWP + (16 * g + 4 * kq) * 2) = o; }
        if (samp || n == 63) { float* ore = C.out + (samp ? O_SRS + ((size_t)(l * NBS + b) * 2048) : O_SRP + ((size_t)(l * NBP + b) * 2048)) + g * 64 + lane;
            float* oim = C.out + (samp ? O_SIS + ((size_t)(l * NBS + b) * 2048) : O_SIP + ((size_t)(l * NBP + b) * 2048)) + g * 64 + lane; *ore = hr; *oim = hi; }
        if (gi < 3) P = Pn; } }
    __syncthreads();
    const int hi5 = lane >> 5, r32 = lane & 31;
    const bf16x8* WG = (const bf16x8*)(C.ws + WS_WGLU) + (size_t)l * 1024 * 64 + lane;
    const float* bg = C.in[I_BGLU] + (size_t)l * 1024;
    float sq[2] = {0.f, 0.f}; v2u ost[2][4][2];
#pragma unroll
    for (int c = 0; c < 2; ++c) {
        const bf16x8* Wv = WG + (size_t)((2 * wave + c) * 32) * 64; const bf16x8* Wt = WG + (size_t)((16 + 2 * wave + c) * 32) * 64;
        f32x16 av[2], ag[2]; av[0] = f32x16{}; av[1] = f32x16{}; ag[0] = f32x16{}; ag[1] = f32x16{};
        bf16x8 rv[8], rg[8];
#pragma unroll
        for (int i = 0; i < 8; ++i) { rv[i] = Wv[(size_t)i * 64]; rg[i] = Wt[(size_t)i * 64]; }
#pragma unroll 1
        for (int k0 = 0; k0 < 32; k0 += 8) {
#pragma unroll
            for (int i = 0; i < 8; ++i) { const int kap = k0 + i;
                const bf16x8 b0 = *(const LAS bf16x8*)(GG + r32 * ROWP + (16 * kap + 8 * hi5) * 2), b1 = *(const LAS bf16x8*)(GG + (32 + r32) * ROWP + (16 * kap + 8 * hi5) * 2);
                av[0] = mfma32(rv[i], b0, av[0]); av[1] = mfma32(rv[i], b1, av[1]); ag[0] = mfma32(rg[i], b0, ag[0]); ag[1] = mfma32(rg[i], b1, ag[1]);
                if (kap + 8 < 32) { rv[i] = Wv[(size_t)(kap + 8) * 64]; rg[i] = Wt[(size_t)(kap + 8) * 64]; } } }
#pragma unroll
        for (int rr = 0; rr < 4; ++rr) { const int ch0 = 64 * wave + 32 * c + 8 * rr + 4 * hi5; const f32x4 bv = *(const f32x4*)(bg + ch0), bgt = *(const f32x4*)(bg + 512 + ch0);
#pragma unroll
            for (int tt = 0; tt < 2; ++tt) { float o[4];
#pragma unroll
                for (int e = 0; e < 4; ++e) { o[e] = (av[tt][4 * rr + e] + bv[e]) * sigm_f(ag[tt][4 * rr + e] + bgt[e]); sq[tt] += o[e] * o[e]; }
                ost[c][rr][tt].x = pk2(o[0], o[1]); ost[c][rr][tt].y = pk2(o[2], o[3]); } }
    }
#pragma unroll
    for (int tt = 0; tt < 2; ++tt) { const float t = xh_sum(sq[tt]); if (hi5 == 0) ssq[wave * 64 + 32 * tt + r32] = t; }
    __syncthreads();
#pragma unroll
    for (int c = 0; c < 2; ++c)
#pragma unroll
        for (int rr = 0; rr < 4; ++rr) { const int ch0 = 64 * wave + 32 * c + 8 * rr + 4 * hi5;
#pragma unroll
            for (int tt = 0; tt < 2; ++tt) *(LAS v2u*)(GG + (32 * tt + r32) * ROWP + ch0 * 2) = ost[c][rr][tt]; }
    __syncthreads();
    branch_tail(C, l, row0, GG, ssq, rstd_l, COL_ZS, 1024);
}

template <int W> DI void pool_diff(const Ctx& C, int l, bool samp, int b, int n, int row0, int gi, int th, int lane, LAS unsigned char* DF) {
    const int t0 = 32 * th + 8 * (lane >> 4), ch0 = 128 * gi + 8 * (lane & 15);
    const float* sp = C.in[I_SPOOL] + (size_t)(l * NBS + b) * 15 * 512;
    float x[W + 7][8];
#pragma unroll
    for (int i = 0; i < W + 7; ++i) { const int rel = t0 - (W - 1) + i;
        if (rel >= 0 || (!samp && n > 0)) unpack8(*(const v4u*)(C.PROJ + (size_t)(row0 + rel) * NIN + COL_UP + ch0), x[i]);
        else if (samp) { const float* s = sp + (size_t)(15 + rel) * 512 + ch0; const f32x4 a = *(const f32x4*)s, c4 = *(const f32x4*)(s + 4); x[i][0] = a.x; x[i][1] = a.y; x[i][2] = a.z; x[i][3] = a.w; x[i][4] = c4.x; x[i][5] = c4.y; x[i][6] = c4.z; x[i][7] = c4.w; }
        else {
#pragma unroll
            for (int e = 0; e < 8; ++e) x[i][e] = 0.f; } }
    const bool last = samp || n == 63;
    float* po = C.out + (samp ? O_PS + (size_t)(l * NBS + b) * 15 * 512 : O_PP + (size_t)(l * NBP + b) * 15 * 512);
#pragma unroll
    for (int tt = 0; tt < 8; ++tt) { const int t = t0 + tt, pos = 64 * n + t; float d[8];
        const float cnt = samp ? (float)W : (float)((pos + 1 < W) ? pos + 1 : W), ic = 1.f / cnt;
#pragma unroll
        for (int e = 0; e < 8; ++e) { float s = 0.f;
#pragma unroll
            for (int j = 0; j < W; ++j) s += x[tt + j][e];
            d[e] = s * ic - x[tt + W - 1][e]; }
        v4u o; o.x = pk2(d[0], d[1]); o.y = pk2(d[2], d[3]); o.z = pk2(d[4], d[5]); o.w = pk2(d[6], d[7]);
        *(LAS v4u*)(DF + t * ROWP + ch0 * 2) = o;
        if (last && t >= 49) { float* p = po + (size_t)(t - 49) * 512 + ch0; *(f32x4*)p = (f32x4){x[tt + W - 1][0], x[tt + W - 1][1], x[tt + W - 1][2], x[tt + W - 1][3]}; *(f32x4*)(p + 4) = (f32x4){x[tt + W - 1][4], x[tt + W - 1][5], x[tt + W - 1][6], x[tt + W - 1][7]}; } }
}
DI void pool_unit(const Ctx& C0, int l, int u) {
    Ctx C = C0; fresh(C);
    const int lane = C.lane, wave = C.wave; const bool samp = u >= 512;
    const int b = samp ? u - 512 : (u >> 6), n = samp ? 0 : (u & 63), row0 = samp ? MP + 64 * b : b * LP + 64 * n;
    LAS unsigned char* DF = C.lds; LAS float* ssq = (LAS float*)(C.lds + 64 * ROWP); LAS float* rstd_l = ssq + 512;
    { const int gi = wave >> 1, th = wave & 1;
      if (gi == 0) pool_diff<2>(C, l, samp, b, n, row0, 0, th, lane, DF); else if (gi == 1) pool_diff<4>(C, l, samp, b, n, row0, 1, th, lane, DF);
      else if (gi == 2) pool_diff<8>(C, l, samp, b, n, row0, 2, th, lane, DF); else pool_diff<16>(C, l, samp, b, n, row0, 3, th, lane, DF); }
    __syncthreads();
    const int hi5 = lane >> 5, r32 = lane & 31, gi = wave >> 1;
    f32x16 acc[2][2];
#pragma unroll
    for (int c = 0; c < 2; ++c) { acc[c][0] = f32x16{}; acc[c][1] = f32x16{}; }
    const bf16x8* WP = (const bf16x8*)(C.ws + WS_WPOOL) + (size_t)((l * 4 + gi) * 32) * 64 + lane;
#pragma unroll
    for (int kap = 0; kap < 8; ++kap) { bf16x8 af[2], bt[2];
#pragma unroll
        for (int c = 0; c < 2; ++c) af[c] = WP[(size_t)((2 * (wave & 1) + c) * 8 + kap) * 64];
#pragma unroll
        for (int tt = 0; tt < 2; ++tt) bt[tt] = *(const LAS bf16x8*)(DF + (32 * tt + r32) * ROWP + (128 * gi + 16 * kap + 8 * hi5) * 2);
#pragma unroll
        for (int c = 0; c < 2; ++c)
#pragma unroll
            for (int tt = 0; tt < 2; ++tt) acc[c][tt] = mfma32(af[c], bt[tt], acc[c][tt]); }
    const float* ps = C.in[I_PSCALE] + (size_t)l * 512;
    float sq[2] = {0.f, 0.f};
#pragma unroll
    for (int c = 0; c < 2; ++c)
#pragma unroll
        for (int rr = 0; rr < 4; ++rr) { const int d0 = 128 * gi + 32 * (2 * (wave & 1) + c) + 8 * rr + 4 * hi5; const f32x4 sc = *(const f32x4*)(ps + d0);
#pragma unroll
            for (int tt = 0; tt < 2; ++tt)
#pragma unroll
                for (int e = 0; e < 4; ++e) { const float o = acc[c][tt][4 * rr + e] * sc[e]; acc[c][tt][4 * rr + e] = o; sq[tt] += o * o; } }
#pragma unroll
    for (int tt = 0; tt < 2; ++tt) { const float t = xh_sum(sq[tt]); if (hi5 == 0) ssq[wave * 64 + 32 * tt + r32] = t; }
    __syncthreads();
#pragma unroll
    for (int c = 0; c < 2; ++c)
#pragma unroll
        for (int rr = 0; rr < 4; ++rr) { const int d0 = 128 * gi + 32 * (2 * (wave & 1) + c) + 8 * rr + 4 * hi5;
#pragma unroll
            for (int tt = 0; tt < 2; ++tt) { v2u o; o.x = pk2(acc[c][tt][4 * rr], acc[c][tt][4 * rr + 1]); o.y = pk2(acc[c][tt][4 * rr + 2], acc[c][tt][4 * rr + 3]);
                *(LAS v2u*)(DF + (32 * tt + r32) * ROWP + d0 * 2) = o; } }
    __syncthreads();
    branch_tail(C, l, row0, DF, ssq, rstd_l, COL_ZP, 1536);
}

constexpr int AT_STG = 65536, AT_TAB = 2 * AT_STG, AT_SSQ = AT_TAB + 2 * 4 * 384 * 4, AT_RSTD = AT_SSQ + 8 * 32 * 4;
DI void attn_unit(const Ctx& C0, int l, int u) {
    Ctx C = C0; fresh(C);
    const int lane = C.lane, wave = C.wave, r32 = lane & 31, hi = lane >> 5, hd = wave >> 1, qh = wave & 1; const bool samp = u < 32;
    const int b = samp ? u : ((u - 32) & 7), n = samp ? 16 : 63 - ((u - 32) >> 3), rq0 = samp ? MP + 64 * b : b * LP + 64 * n;
    const int jstart = samp ? 0 : (n >= 8 ? 0 : 8 - n), nt = 9 - jstart, nsteps = 4 * nt;
    LAS unsigned char* KV = C.lds + hd * 16384;
    LAS float* TAB = (LAS float*)(C.lds + AT_TAB) + hd * 384;
    LAS float* ssq = (LAS float*)(C.lds + AT_SSQ); LAS float* rstd_l = (LAS float*)(C.lds + AT_RSTD);
    const float c1 = 0.125f * LOG2E;
    const int qi = 32 * qh + r32, sw = (r32 >> 1) & 7;
    auto issue = [&](int h, int j, auto STC) {
        constexpr int st = decltype(STC)::value;
        const bf16* src; int pitch;
        if (samp && j < 8) { src = (qh ? C.VC : C.KC) + ((size_t)(l * NBS + b) * 512 + 64 * j) * 1024 + h * 64; pitch = 1024; }
        else { const size_t row = samp ? (size_t)rq0 : (size_t)(b * LP + 64 * (n - 8 + j)); src = C.PROJ + row * NIN + (qh ? COL_V : COL_K) + h * 64; pitch = NIN; }
        LAS unsigned char* dst = KV + st * AT_STG + qh * 8192;
        if (qh == 0) {
#pragma unroll
            for (int pc = 0; pc < 8; ++pc) { const int row = 8 * pc + (lane >> 3), ch = (lane & 7) ^ ((row >> 1) & 7);
                __builtin_amdgcn_global_load_lds((const unsigned*)(src + (size_t)row * pitch + ch * 8), (LAS unsigned*)(dst + pc * 1024), 16, 0, 0); }
        } else {
#pragma unroll
            for (int pc = 0; pc < 8; ++pc)
                __builtin_amdgcn_global_load_lds((const unsigned*)(src + (size_t)(16 * (pc & 3) + (lane >> 2)) * pitch + (pc >> 2) * 32 + (lane & 3) * 8), (LAS unsigned*)(dst + pc * 1024), 16, 0, 0);
        }
    };
    float tv[3];
    auto tab_load = [&](int h) { const float* rb = C.in[I_RELB] + (size_t)(l * 16 + h) * 513;
#pragma unroll
        for (int k = 0; k < 3; ++k) { const int y = 192 * qh + lane + 64 * k; tv[k] = rb[y < 64 ? 512 : 576 - y]; } };
    auto tab_store = [&](int buf) {
#pragma unroll
        for (int k = 0; k < 3; ++k) TAB[buf * 1536 + 192 * qh + lane + 64 * k] = tv[k] * LOG2E; };
    bf16x8 qf[4], qn[4];
    auto q_load = [&](int h, bf16x8 (&q)[4]) { const bf16* qp = C.PROJ + (size_t)(rq0 + qi) * NIN + COL_Q + h * 64 + 8 * hi;
#pragma unroll
        for (int k = 0; k < 4; ++k) q[k] = ld8(qp + 16 * k); };
    tab_load(hd); tab_store(0); q_load(hd, qf); issue(hd, jstart, std::integral_constant<int, 0>{});
    f32x16 O[2]; float mrun = -1e30f, lrun = 0.f, ssq_acc = 0.f;
    O[0] = f32x16{}; O[1] = f32x16{};
    int hg = 0, j = jstart;
    auto step = [&](int s, auto CURC) {
        constexpr int cur = decltype(CURC)::value;
        const int h = 4 * hg + hd;
        __builtin_amdgcn_s_waitcnt(0); asm volatile("s_barrier" ::: "memory");
        if (s + 1 < nsteps) { if (j < 8) issue(h, j + 1, std::integral_constant<int, (cur ^ 1)>{}); else issue(h + 4, jstart, std::integral_constant<int, (cur ^ 1)>{}); }
        const bool lastt = (j == 8), more = lastt && hg < 3;
        if (more) { tab_load(h + 4); q_load(h + 4, qn); }
        LAS const unsigned char* Kst = KV + cur * AT_STG; LAS const unsigned char* Vst = Kst + 8192; LAS const float* T = TAB + (hg & 1) * 1536;
        f32x16 S[2];
#pragma unroll
        for (int kb = 0; kb < 2; ++kb) { S[kb] = f32x16{};
#pragma unroll
            for (int k = 0; k < 4; ++k) { const bf16x8 kf = *(const LAS bf16x8*)(Kst + (32 * kb + r32) * 128 + (((2 * k + hi) ^ sw) << 4)); S[kb] = mfma32(kf, qf[k], S[kb]); } }
        float mx = -1e30f;
        if (j <= 3) { const float bconst = T[0];
#pragma unroll
            for (int kb = 0; kb < 2; ++kb)
#pragma unroll
                for (int r = 0; r < 16; ++r) { const float sv = S[kb][r] * c1 + bconst; S[kb][r] = sv; mx = fmaxf(mx, sv); }
        } else { const int ybase = 320 - 64 * (8 - j) - qi + 4 * hi;
#pragma unroll
            for (int kb = 0; kb < 2; ++kb)
#pragma unroll
                for (int r = 0; r < 16; ++r) { const float sv = S[kb][r] * c1 + T[ybase + 32 * kb + 8 * (r >> 2) + (r & 3)]; S[kb][r] = sv; mx = fmaxf(mx, sv); }
        }
        mx = xh_max(mx);
        const float mnew = fmaxf(mrun, mx), alpha = ex2(mrun - mnew); mrun = mnew;
        float rs = 0.f;
#pragma unroll
        for (int kb = 0; kb < 2; ++kb)
#pragma unroll
            for (int r = 0; r < 16; ++r) { const float p = ex2(S[kb][r] - mnew); S[kb][r] = p; rs += p; }
        lrun = lrun * alpha + rs;
#pragma unroll
        for (int db = 0; db < 2; ++db)
#pragma unroll
            for (int r = 0; r < 16; ++r) O[db][r] *= alpha;
        bf16x8 pf[4];
#pragma unroll
        for (int ks = 0; ks < 4; ++ks) { const int kb = ks >> 1, s8 = 8 * (ks & 1); v4u w;
            w.x = pk2(S[kb][s8], S[kb][s8 + 1]); w.y = pk2(S[kb][s8 + 2], S[kb][s8 + 3]); w.z = pk2(S[kb][s8 + 4], S[kb][s8 + 5]); w.w = pk2(S[kb][s8 + 6], S[kb][s8 + 7]);
            pf[ks] = __builtin_bit_cast(bf16x8, w); }
        LAS const unsigned char* vb = Vst + (4 * hi + ((lane & 15) >> 2)) * 64 + ((lane >> 4) & 1) * 32 + (lane & 3) * 8;
        const unsigned vba = (unsigned)(uintptr_t)vb;
#pragma unroll
        for (int kh = 0; kh < 2; ++kh) { s16x4 lo[2][2], up[2][2];
#pragma unroll
            for (int k2 = 0; k2 < 2; ++k2)
#pragma unroll
                for (int db = 0; db < 2; ++db) { const int ks = 2 * kh + k2;
                    asm volatile("ds_read_b64_tr_b16 %0, %1 offset:%2" : "=v"(lo[k2][db]) : "v"(vba), "i"(db * 4096 + ks * 1024));
                    asm volatile("ds_read_b64_tr_b16 %0, %1 offset:%2" : "=v"(up[k2][db]) : "v"(vba), "i"(db * 4096 + ks * 1024 + 512)); }
            asm volatile("s_waitcnt lgkmcnt(0)" : "+v"(lo[0][0]), "+v"(lo[0][1]), "+v"(lo[1][0]), "+v"(lo[1][1]), "+v"(up[0][0]), "+v"(up[0][1]), "+v"(up[1][0]), "+v"(up[1][1]));
#pragma unroll
            for (int k2 = 0; k2 < 2; ++k2)
#pragma unroll
                for (int db = 0; db < 2; ++db) { const bf16x8 vf = {lo[k2][db][0], lo[k2][db][1], lo[k2][db][2], lo[k2][db][3], up[k2][db][0], up[k2][db][1], up[k2][db][2], up[k2][db][3]};
                    O[db] = mfma32(vf, pf[2 * kh + k2], O[db]); } }
        if (lastt) {
            const float inv = 1.f / xh_sum(lrun); float sq = 0.f;
            bf16* yp = C.HY + (size_t)(rq0 + qi) * DM + h * 64 + 4 * hi;
#pragma unroll
            for (int db = 0; db < 2; ++db)
#pragma unroll
                for (int rr = 0; rr < 4; ++rr) { float o[4];
#pragma unroll
                    for (int e = 0; e < 4; ++e) { o[e] = O[db][4 * rr + e] * inv; sq += o[e] * o[e]; }
                    v2u w; w.x = pk2(o[0], o[1]); w.y = pk2(o[2], o[3]); *(v2u*)(yp + 32 * db + 8 * rr) = w; }
            ssq_acc += xh_sum(sq);
            O[0] = f32x16{}; O[1] = f32x16{}; mrun = -1e30f; lrun = 0.f;
            if (more) { tab_store((hg + 1) & 1);
#pragma unroll
                for (int k = 0; k < 4; ++k) qf[k] = qn[k]; }
            ++hg; j = jstart;
        } else ++j;
    };
    for (int s = 0; s < nsteps; s += 2) { step(s, std::integral_constant<int, 0>{}); step(s + 1, std::integral_constant<int, 1>{}); }
    if (hi == 0) ssq[wave * 32 + r32] = ssq_acc;
    asm volatile("s_waitcnt vmcnt(0)" ::: "memory");
    __syncthreads();
    if (C.tid < 64) { const int q2 = C.tid >> 5, rr = C.tid & 31; float t = 0.f;
#pragma unroll
        for (int w = 0; w < 4; ++w) t += ssq[(2 * w + q2) * 32 + rr];
        rstd_l[C.tid] = rsqrtf(t * (1.f / 1024.f) + EPSN); }
    __syncthreads();
    const float* gb = C.in[I_BNG] + (size_t)l * DM;
#pragma unroll 2
    for (int it = 0; it < 16; ++it) { const int idx = C.tid + 512 * it, row = idx >> 7, ch = idx & 127;
        bf16* yp = C.HY + (size_t)(rq0 + row) * DM + ch * 8;
        const v4u raw = *(const v4u*)yp; const v4u zz = *(const v4u*)(C.PROJ + (size_t)(rq0 + row) * NIN + COL_ZA + ch * 8);
        const f32x4 g0 = *(const f32x4*)(gb + ch * 8), g1 = *(const f32x4*)(gb + ch * 8 + 4);
        float r[8], z[8]; unpack8(raw, r); unpack8(zz, z); const float rs = rstd_l[row];
        const float gg[8] = {g0.x, g0.y, g0.z, g0.w, g1.x, g1.y, g1.z, g1.w}; float o[8];
#pragma unroll
        for (int e = 0; e < 8; ++e) o[e] = r[e] * rs * gg[e] * silu_f(z[e]);
        v4u w; w.x = pk2(o[0], o[1]); w.y = pk2(o[2], o[3]); w.z = pk2(o[4], o[5]); w.w = pk2(o[6], o[7]);
        *(v4u*)yp = w; }
    __syncthreads();
}

DI int q_next(const Ctx& C0, unsigned* ctr) {
    Ctx C = C0; fresh(C);
    LAS volatile int* slot = (LAS volatile int*)(C.lds + MISC_OFF + 32);
    if (C.tid == 0) *slot = (int)__hip_atomic_fetch_add(ctr, 1u, __ATOMIC_RELAXED, __HIP_MEMORY_SCOPE_AGENT);
    __syncthreads();
    const int v = *slot;
    __syncthreads();
    return v;
}

__global__ void __launch_bounds__(512, 2) hymba_fwd(Args args) {
    extern __shared__ __attribute__((aligned(16))) unsigned char lds_raw[];
    Ctx C; C.in = args.in; C.out = args.out; C.ws = args.ws; C.lds = (LAS unsigned char*)lds_raw;
    C.tid = threadIdx.x; C.lane = C.tid & 63; C.wave = __builtin_amdgcn_readfirstlane(C.tid >> 6); C.G = gridDim.x; C.bid = blockIdx.x;
    C.HY = (bf16*)(args.ws + WS_HY); C.PROJ = (bf16*)(args.ws + WS_PROJ); C.KC = (bf16*)(args.ws + WS_KC); C.VC = (bf16*)(args.ws + WS_VC);
    C.WIN = (bf16*)(args.ws + WS_WIN); C.WOUT = (bf16*)(args.ws + WS_WOUT); C.MOD = (float*)(args.ws + WS_MOD); C.ctl = (unsigned*)(args.ws + WS_CTL);
    if (C.tid < 16) ((LAS unsigned*)(C.lds + MISC_OFF))[C.tid] = 0u;
    __syncthreads();
    const int lo = args.ph_lo, hi = args.ph_hi;
    const bool multi = (hi - lo) > 1;
    XcdBarrier bar; bar.bar = C.ctl + CW_BAR; bar.x = 0; bar.st = nullptr;
    if (multi) bar = xcd_barrier_post(C.ctl + CW_BAR, (volatile LAS unsigned*)(C.lds + MISC_OFF));
#define IN(k) (lo <= (k) && (k) < hi)
#define SEAM(k) do { if (IN(k) && IN((k) + 1)) xcd_barrier(bar); } while (0)
    int ph = 0;
#ifndef PHM
#define PHM 0xff
#endif
    if ((PHM & 1) && IN(ph)) { p0_prologue(C, true); if (REP & 16) p0_prologue(C, false); }
    SEAM(ph); ++ph;
    if ((PHM & 2) && IN(ph)) norm_phase(C, 0);
    SEAM(ph); ++ph;
    for (int l = 0; l < DEPTH; ++l) {
        if ((PHM & 4) && IN(ph)) {
            pg8::Gemm g{C.HY, C.WIN + (size_t)l * NIN * DM, MT, NIN, DM}; pg8::StaticOrder S; S.init(MT, NIN, C.G, C.bid);
            pg8::EpiProj E{C.PROJ, C.out + O_KP + (size_t)l * NBP * 512 * 1024, C.out + O_VP + (size_t)l * NBP * 512 * 1024, C.out + O_KS + (size_t)l * NBS * 64 * 1024, C.out + O_VS + (size_t)l * NBS * 64 * 1024};
            pg8::gemm_phase<pg8::EpiProj, pg8::StaticOrder, true, true>(C.lds, g, S, E);
            if (REP & 4) { __syncthreads(); pg8::gemm_phase<pg8::EpiProj, pg8::StaticOrder, true, true>(C.lds, g, S, E); }
        }
        SEAM(ph); ++ph;
        if ((PHM & 8) && IN(ph)) { for (int u = C.bid; u < 512; u += C.G) ssm_local_unit(C, l, u);
            if (REP & 2) for (int u = C.bid; u < 512; u += C.G) ssm_local_unit(C, l, u); }
        SEAM(ph); ++ph;
        if ((PHM & 8) && IN(ph)) ssm_carry_phase(C, l);
        SEAM(ph); ++ph;
        if ((PHM & 0x70) && IN(ph)) {
            unsigned* ctr = C.ctl + CW_Q + 64 * 3 * l;
            if (PHM & 0x10) for (;;) { const int u = q_next(C, ctr); if (u >= 544) break; attn_unit(C, l, u); }
            if (PHM & 0x20) for (;;) { const int u = q_next(C, ctr + 64); if (u >= 544) break; ssm_main_unit(C, l, u); }
            if (PHM & 0x40) for (;;) { const int u = q_next(C, ctr + 128); if (u >= 544) break; pool_unit(C, l, u); }
            if (REP & 1) for (;;) { const int u = q_next(C, ctr + 64 * 12); if (u >= 544) break; attn_unit(C, l, u); }
            if (REP & 2) { for (;;) { const int u = q_next(C, ctr + 64 * 13); if (u >= 544) break; ssm_main_unit(C, l, u); }
                           for (;;) { const int u = q_next(C, ctr + 64 * 14); if (u >= 544) break; pool_unit(C, l, u); } }
        }
        SEAM(ph); ++ph;
        if ((PHM & 0x80) && IN(ph)) {
            pg8::Gemm g{C.HY, C.WOUT + (size_t)l * DM * DM, MT, DM, DM}; pg8::StaticOrder S; S.init(MT, DM, C.G, C.bid);
            pg8::EpiRes E{l == 0 ? C.in[I_XP] : C.out, l == 0 ? C.in[I_XS] : C.out + (size_t)MP * DM, C.out, C.MOD + (size_t)l * 40 * NIN + 2 * DM};
            pg8::gemm_phase<pg8::EpiRes, pg8::StaticOrder, true, true>(C.lds, g, S, E);
            if ((REP & 32) && l == 0) { __syncthreads(); pg8::gemm_phase<pg8::EpiRes, pg8::StaticOrder, true, true>(C.lds, g, S, E); }
        }
        SEAM(ph); ++ph;
        if ((PHM & 2) && IN(ph)) { norm_phase(C, l + 1); if ((REP & 8) && l + 1 < DEPTH) norm_phase(C, l + 1); }
        SEAM(ph); ++ph;
    }
#undef IN
#undef SEAM
}

#ifndef N_LAUNCH_MODE
#define N_LAUNCH_MODE 1
#endif
extern "C" void kernel_launch(void* const* d_in, const int* in_sizes, int n_in, void* d_out, int out_size, void* d_ws, size_t ws_size, hipStream_t stream) {
    static int grid = 0;
    if (grid == 0) {
        if (n_in != N_IN || (size_t)out_size != O_END || ws_size < WS_END) { fprintf(stderr, "kernel_launch: unexpected sizes n_in %d out %d ws %zu (need %zu)\n", n_in, out_size, ws_size, (size_t)WS_END); grid = -1; return; }
        int dev = 0, cus = 0, per_cu = 0;
        if (hipGetDevice(&dev) != hipSuccess || hipDeviceGetAttribute(&cus, hipDeviceAttributeMultiprocessorCount, dev) != hipSuccess) { grid = -1; return; }
        if (hipFuncSetAttribute((const void*)hymba_fwd, hipFuncAttributeMaxDynamicSharedMemorySize, LDS_BYTES) != hipSuccess) { fprintf(stderr, "kernel_launch: hipFuncSetAttribute failed\n"); grid = -1; return; }
        if (hipOccupancyMaxActiveBlocksPerMultiprocessor(&per_cu, (const void*)hymba_fwd, 512, LDS_BYTES) != hipSuccess || per_cu < 1) fprintf(stderr, "kernel_launch: occupancy query says %d\n", per_cu);
        (void)hipGetLastError();
        grid = cus;
    }
    if (grid < 0) return;
    (void)in_sizes;
    if (hipMemsetAsync((char*)d_ws + WS_CTL, 0, ZERO_BYTES, stream) != hipSuccess) return;
    Args a{};
    for (int i = 0; i < N_IN; ++i) a.in[i] = (const float*)d_in[i];
    a.out = (float*)d_out; a.ws = (unsigned char*)d_ws;
#if N_LAUNCH_MODE == 1
    a.ph_lo = 0; a.ph_hi = NPH;
    hipLaunchKernelGGL(hymba_fwd, dim3(grid), dim3(512), LDS_BYTES, stream, a);
#else
    for (int p = 0; p < NPH; ++p) { a.ph_lo = p; a.ph_hi = p + 1; hipLaunchKernelGGL(hymba_fwd, dim3(grid), dim3(512), LDS_BYTES, stream, a); }
#endif
}
```

```cpp
#include <hip/hip_runtime.h>
#include <cstdio>
#include <cstdint>
#include <type_traits>
namespace pg8 {
#define PG8_LAS __attribute__((address_space(3)))
typedef unsigned short bf16_t;
typedef short bf16x8 __attribute__((ext_vector_type(8)));
typedef float f32x4 __attribute__((ext_vector_type(4)));
typedef unsigned u32x4 __attribute__((ext_vector_type(4)));
constexpr int BM = 256, BK = 64, HALF = 128, HTB = HALF * BK * 2  , STAGE_BYTES = 8 * HTB, NXCD = 8, WGM = 8;

__host__ __device__ __forceinline__ int lds_byte(int r, int c) { const int st = (r >> 4) * 2 + (c >> 5), rr = r & 15, cc = c & 31, ob = rr * 64 + cc * 2; return st * 1024 + (ob ^ (((ob >> 9) & 1) << 5)); }
__host__ __device__ __forceinline__ void stage_rc(int b, int& R, int& C) { const int st = b / 1024, sb = b % 1024, swz = sb ^ (((sb >> 9) & 1) << 5); R = (st >> 1) * 16 + swz / 64; C = (st & 1) * 32 + (swz % 64) / 2; }
__host__ __device__ __forceinline__ int perm32(int rho) { const int n = rho >> 4, i = rho & 15; return 8 * (i >> 2) + 4 * n + (i & 3); }

struct Unit { int pm, pn; };
struct Gemm { const bf16_t* A; const bf16_t* Bt; int M, N, K; };

struct StaticOrder {
    int nM, nN, nwg, G, c;
    __host__ __device__ void init(int M, int N, int G_, int c_) { nM = M / BM; nN = N / BM; nwg = nM * nN; G = G_; c = c_; }
    __host__ __device__ bool next(int i, Unit& u) const {
        const long L = (long)i * G + c; if (L >= nwg) return false;
        int wgid = (int)L; { const int q = nwg / NXCD, r = nwg % NXCD, xcd = wgid % NXCD, off = wgid / NXCD; wgid = (xcd < r ? xcd * (q + 1) : r * (q + 1) + (xcd - r) * q) + off; }
        const int nig = WGM * nN, gid = wgid / nig, fm = gid * WGM, gsz = (nM - fm) < WGM ? (nM - fm) : WGM;
        u.pm = fm + ((wgid % nig) % gsz); u.pn = (wgid % nig) / gsz; return true;
    }
    __device__ __forceinline__ void a_ready(const Unit&) const {}
    __device__ __forceinline__ void done(const Unit&) const {}
};

__device__ __forceinline__ unsigned cvt_pk_bf16(float lo, float hi) { unsigned r; asm volatile("v_cvt_pk_bf16_f32 %0, %1, %2" : "=v"(r) : "v"(lo), "v"(hi)); return r; }
typedef float f32x2 __attribute__((ext_vector_type(2)));
struct EpiProj {
    static constexpr bool PERM = true, AFTER_DRAIN = false;
    bf16_t* O; float* kp; float* vp; float* ks; float* vs; const float* ssq; const float* sb;
    __device__ __forceinline__ void operator()(const f32x4 (&acc)[2][2][4][2], const Unit& u, int wr, int wc, int fr, int fq) const {
        const int lrow0 = wr * 64 + fr, col0 = u.pn * BM + wc * 32 + 8 * fq;
#if defined(TPROBE) && TPROBE == 15
        if (blockIdx.x == 0 && threadIdx.x == 0) *(volatile PG8_LAS unsigned long long*)(147456 - 64 + 40) = __builtin_amdgcn_s_memrealtime();
#endif
        float* fo = nullptr;
        const bool isk = (u.pn >= 4 && u.pn < 8), isv = (u.pn >= 8 && u.pn < 12);
        if (isk || isv) {
            if (u.pm >= 128) fo = (isk ? ks : vs) + (size_t)(u.pm - 128) * 256 * 1024;
            else if ((u.pm & 15) >= 14) fo = (isk ? kp : vp) + ((size_t)(u.pm >> 4) * 512 + (size_t)((u.pm & 15) - 14) * 256) * 1024;
        }
        const int fcol0 = (u.pn & 3) * 256 + wc * 32 + 8 * fq;
#pragma unroll
        for (int ai = 0; ai < 2; ++ai) {
            const int brow = (u.pm < 128) ? (u.pm >> 4) : (8 + (u.pm - 128) * 4 + 2 * ai + wr);
            const float* sbp = sb + (size_t)brow * 6144 + col0;
            const f32x4 s00 = *(const f32x4*)sbp, s01 = *(const f32x4*)(sbp + 4), s10 = *(const f32x4*)(sbp + HALF), s11 = *(const f32x4*)(sbp + HALF + 4);
#pragma unroll
            for (int m = 0; m < 4; ++m) { const int lr = lrow0 + ai * HALF + m * 16; const int row = u.pm * BM + lr; bf16_t* rowp = O + (size_t)row * 6144 + col0;
                const float rs = rsqrtf(ssq[row] * (1.0f / 2048.0f) + 1e-6f);
                { const f32x4 v0 = acc[ai][0][m][0] * rs + s00, v1 = acc[ai][0][m][1] * rs + s01;
                  u32x4 w; w.x = cvt_pk_bf16(v0[0], v0[1]); w.y = cvt_pk_bf16(v0[2], v0[3]); w.z = cvt_pk_bf16(v1[0], v1[1]); w.w = cvt_pk_bf16(v1[2], v1[3]); *(u32x4*)rowp = w;
                  if (fo) { float* fp = fo + (size_t)lr * 1024 + fcol0; *(f32x4*)fp = v0; *(f32x4*)(fp + 4) = v1; } }
                { const f32x4 v0 = acc[ai][1][m][0] * rs + s10, v1 = acc[ai][1][m][1] * rs + s11;
                  u32x4 w; w.x = cvt_pk_bf16(v0[0], v0[1]); w.y = cvt_pk_bf16(v0[2], v0[3]); w.z = cvt_pk_bf16(v1[0], v1[1]); w.w = cvt_pk_bf16(v1[2], v1[3]); *(u32x4*)(rowp + HALF) = w;
                  if (fo) { float* fp = fo + (size_t)lr * 1024 + fcol0 + HALF; *(f32x4*)fp = v0; *(f32x4*)(fp + 4) = v1; } } }
        }
#if defined(TPROBE) && TPROBE == 15
        if (blockIdx.x == 0 && threadIdx.x == 0) { asm volatile("s_waitcnt vmcnt(0)" ::: "memory"); *(volatile PG8_LAS unsigned long long*)(147456 - 64 + 48) += __builtin_amdgcn_s_memrealtime() - *(volatile PG8_LAS unsigned long long*)(147456 - 64 + 40); }
#endif
    }
};
struct EpiRes {
    static constexpr bool PERM = false, AFTER_DRAIN = false;
    const float* xin_p; const float* xin_s; float* xout; const float* gate; const float* gs; bf16_t* hout; float* ssqn;
    __device__ __forceinline__ void operator()(const f32x4 (&acc)[2][2][4][2], const Unit& u, int wr, int wc, int fr, int fq) const {
        typedef unsigned u32x2 __attribute__((ext_vector_type(2)));
#if defined(TPROBE) && TPROBE == 14
        if (blockIdx.x == 0 && threadIdx.x == 0) *(volatile PG8_LAS unsigned long long*)(147456 - 64 + 40) = __builtin_amdgcn_s_memrealtime();
#endif
        const int col0 = u.pn * BM + wc * 32 + 4 * fq;
        const int r0 = u.pm * BM + wr * 64 + fr;
        const float* xbase = (u.pm < 128) ? (xin_p + (size_t)r0 * 2048 + col0) : (xin_s + (size_t)(r0 - 32768) * 2048 + col0);
        f32x4 xr[3][2][2];
#define EPR_LOAD(i) do { const int _ro = ((i) >> 2) * HALF + ((i) & 3) * 16; _Pragma("unroll") for (int bj = 0; bj < 2; ++bj) _Pragma("unroll") for (int n = 0; n < 2; ++n) xr[(i) % 3][bj][n] = *(const f32x4*)(xbase + (size_t)_ro * 2048 + bj * HALF + n * 16); } while (0)
        EPR_LOAD(0); EPR_LOAD(1);
#pragma unroll
        for (int ai = 0; ai < 2; ++ai) {
            const int brow = (u.pm < 128) ? (u.pm >> 4) : (8 + (u.pm - 128) * 4 + 2 * ai + wr);
            f32x4 gv[2][2], gsv[2][2];
#pragma unroll
            for (int bj = 0; bj < 2; ++bj)
#pragma unroll
                for (int n = 0; n < 2; ++n) { gv[bj][n] = *(const f32x4*)(gate + (size_t)brow * 6144 + col0 + bj * HALF + n * 16);
                    gsv[bj][n] = gs ? *(const f32x4*)(gs + (size_t)brow * 2048 + col0 + bj * HALF + n * 16) : (f32x4){0.f, 0.f, 0.f, 0.f}; }
#pragma unroll
            for (int m = 0; m < 4; ++m) { const int i = ai * 4 + m, roff = ai * HALF + m * 16, r = r0 + roff;
                if (i + 2 < 8) EPR_LOAD(i + 2);
                float* xo = xout + (size_t)r * 2048 + col0; bf16_t* ho = hout + (size_t)r * 2048 + col0;
                float part = 0.f;
#pragma unroll
                for (int bj = 0; bj < 2; ++bj)
#pragma unroll
                    for (int n = 0; n < 2; ++n) { const int c = bj * HALF + n * 16; const f32x4 xn = xr[i % 3][bj][n] + gv[bj][n] * acc[ai][bj][m][n];
                        *(f32x4*)(xo + c) = xn; part += (xn[0] * xn[0] + xn[1] * xn[1]) + (xn[2] * xn[2] + xn[3] * xn[3]);
                        if (gs) { const f32x4 h = xn * gsv[bj][n]; u32x2 w; w.x = cvt_pk_bf16(h[0], h[1]); w.y = cvt_pk_bf16(h[2], h[3]); *(u32x2*)(ho + c) = w; } }
                { auto r16 = __builtin_amdgcn_permlane16_swap(__float_as_uint(part), __float_as_uint(part), false, false); part = __uint_as_float(r16[0]) + __uint_as_float(r16[1]);
                  auto r32 = __builtin_amdgcn_permlane32_swap(__float_as_uint(part), __float_as_uint(part), false, false); part = __uint_as_float(r32[0]) + __uint_as_float(r32[1]); }
                if (fq == 0) unsafeAtomicAdd(ssqn + r, part);
                asm volatile("" ::: "memory"); }
        }
#undef EPR_LOAD
#if defined(TPROBE) && TPROBE == 14
        if (blockIdx.x == 0 && threadIdx.x == 0) { asm volatile("s_waitcnt vmcnt(0)" ::: "memory"); *(volatile PG8_LAS unsigned long long*)(147456 - 64 + 48) += __builtin_amdgcn_s_memrealtime() - *(volatile PG8_LAS unsigned long long*)(147456 - 64 + 40); }
#endif
    }
};

struct XcdRoundOrder : StaticOrder {
    unsigned* cnt; unsigned nloc; int nfull; mutable int r;
    __device__ __forceinline__ void a_ready(const Unit&) const {
        const int i = r++;
        if (i >= 1 && i < nfull) {
            if (threadIdx.x < 64) { if (threadIdx.x == 0) __hip_atomic_fetch_add(cnt, 1u, __ATOMIC_RELAXED, __HIP_MEMORY_SCOPE_AGENT);
                const unsigned want = nloc * (unsigned)i; unsigned polls = 0;
                while ((unsigned)__builtin_amdgcn_readfirstlane(__hip_atomic_load(cnt, __ATOMIC_RELAXED, __HIP_MEMORY_SCOPE_AGENT)) < want) { __builtin_amdgcn_s_sleep(2); if (++polls > 3000u) break; } }
            asm volatile("" ::: "memory"); __builtin_amdgcn_s_barrier(); asm volatile("" ::: "memory");
        }
    }
};
template <class Epi, class Sched, bool ALIGN_EPI = false, bool SP2 = false>
__device__ __forceinline__ void gemm_phase(PG8_LAS unsigned char* lds, const Gemm g, const Sched& S, const Epi& E) {
    int tid_ = threadIdx.x; asm volatile("" : "+v"(tid_));
    const int tid = tid_, wid = __builtin_amdgcn_readfirstlane(tid >> 6), lane = tid & 63, wr = wid >> 2, wc = wid & 3, fr = lane & 15, fq = lane >> 4;
    const int K = g.K, nt = K / BK;
    unsigned voffA[2], voffB[2];
#pragma unroll
    for (int i = 0; i < 2; ++i) { int R, C; stage_rc(tid * 16 + i * 8192, R, C); const int Rb = Epi::PERM ? ((R & ~31) + perm32(R & 31)) : R;
        voffA[i] = (unsigned)(R * K + C) * 2u; voffB[i] = (unsigned)(Rb * K + C) * 2u; }
    const size_t kstep = (size_t)(BK * 2);
    const size_t hstep = (size_t)HALF * K * 2;
    const size_t tstep = 2 * hstep;
    const unsigned ldsw = (unsigned)wid * 1024u;
    const int aoff = lds_byte(wr * 64 + fr, fq * 8), boff = lds_byte(wc * 32 + fr, fq * 8);
#define PG8_SA(b, h) (((b) * 2 + (h)) * HTB)
#define PG8_SB(b, h) ((4 + (b) * 2 + (h)) * HTB)
#define PG8_STAGE(bufoff, gbase, voff) do { _Pragma("unroll") for (int _i = 0; _i < 2; ++_i) \
        __builtin_amdgcn_global_load_lds((const unsigned*)((const char*)(gbase) + (voff)[_i]), (PG8_LAS unsigned*)(lds + (bufoff) + ldsw + _i * 8192), 16, 0, 0); } while (0)
#define PG8_LDA(dst, b, h) do { _Pragma("unroll") for (int m = 0; m < 4; ++m) _Pragma("unroll") for (int k = 0; k < 2; ++k) dst[m][k] = *(const PG8_LAS bf16x8*)(lds + PG8_SA(b, h) + aoff + m * 2048 + k * 1024); } while (0)
#define PG8_LDB(dst, b, h) do { _Pragma("unroll") for (int n = 0; n < 2; ++n) _Pragma("unroll") for (int k = 0; k < 2; ++k) dst[n][k] = *(const PG8_LAS bf16x8*)(lds + PG8_SB(b, h) + boff + n * 2048 + k * 1024); } while (0)
#define PG8_MMA(ai, bj, At, Bt) do { __builtin_amdgcn_s_setprio(1); _Pragma("unroll") for (int m = 0; m < 4; ++m) _Pragma("unroll") for (int n = 0; n < 2; ++n) _Pragma("unroll") for (int k = 0; k < 2; ++k) \
        acc[ai][bj][m][n] = __builtin_amdgcn_mfma_f32_16x16x32_bf16(Bt[n][k], At[m][k], acc[ai][bj][m][n], 0, 0, 0); __builtin_amdgcn_s_setprio(0); } while (0)
#define PG8_WAIT_V(n) asm volatile("s_waitcnt vmcnt(" #n ")" ::: "memory")
#define PG8_WAIT_L(n) asm volatile("s_waitcnt lgkmcnt(" #n ")" ::: "memory")
#define PG8_BAR __builtin_amdgcn_s_barrier()
#define PG8_SCHED __builtin_amdgcn_sched_barrier(0)
    Unit cur, nxt; int ui = 0;
    if (!S.next(0, cur)) return;
    f32x4 acc[2][2][4][2];
#pragma unroll
    for (int a = 0; a < 2; ++a)
#pragma unroll
        for (int b = 0; b < 2; ++b)
#pragma unroll
            for (int m = 0; m < 4; ++m)
#pragma unroll
                for (int n = 0; n < 2; ++n) acc[a][b][m][n] = (f32x4){0.f, 0.f, 0.f, 0.f};
    bf16x8 At[4][2], B0[2][2], B1[2][2];
    const char* cA = (const char*)g.A + (size_t)cur.pm * tstep; const char* cB = (const char*)g.Bt + (size_t)cur.pn * tstep;
    S.a_ready(cur);
    if constexpr (SP2) {
        PG8_STAGE(PG8_SB(0, 0), cB, voffB); PG8_STAGE(PG8_SB(0, 1), cB + hstep, voffB); PG8_STAGE(PG8_SA(0, 0), cA, voffA); PG8_STAGE(PG8_SA(0, 1), cA + hstep, voffA);
        if (wr == 1) PG8_BAR;
        PG8_WAIT_V(2); PG8_BAR;
        PG8_STAGE(PG8_SB(1, 0), cB + kstep, voffB); PG8_STAGE(PG8_SA(1, 0), cA + kstep, voffA); PG8_STAGE(PG8_SB(1, 1), cB + hstep + kstep, voffB);
        PG8_WAIT_V(6); PG8_BAR;
    } else {
        PG8_STAGE(PG8_SB(0, 0), cB, voffB); PG8_STAGE(PG8_SA(0, 0), cA, voffA); PG8_STAGE(PG8_SB(0, 1), cB + hstep, voffB); PG8_STAGE(PG8_SA(0, 1), cA + hstep, voffA);
        if (wr == 1) PG8_BAR;
        PG8_WAIT_V(4); PG8_BAR;
        PG8_STAGE(PG8_SB(1, 0), cB + kstep, voffB); PG8_STAGE(PG8_SA(1, 0), cA + kstep, voffA); PG8_STAGE(PG8_SB(1, 1), cB + hstep + kstep, voffB);
        PG8_WAIT_V(6); PG8_BAR;
    }
    for (;;) {
        const bool has_next = S.next(ui + 1, nxt);
        const char* nA = has_next ? (const char*)g.A + (size_t)nxt.pm * tstep : cA; const char* nB = has_next ? (const char*)g.Bt + (size_t)nxt.pn * tstep : cB;
        for (int t = 0; t < nt; t += 2) {
            const bool last = (t == nt - 2);
            const char* a1 = cA + (size_t)(t + 1) * kstep;
            const char* a2 = last ? nA : cA + (size_t)(t + 2) * kstep; const char* b2 = last ? nB : cB + (size_t)(t + 2) * kstep;
            const char* a3 = a2 + kstep; const char* b3 = b2 + kstep;
            if (last && has_next) S.a_ready(nxt);
            if constexpr (SP2) {
            PG8_LDB(B0, 0, 0); PG8_LDB(B1, 0, 1); PG8_SCHED; PG8_LDA(At, 0, 0); PG8_STAGE(PG8_SA(1, 1), a1 + hstep, voffA);
            PG8_WAIT_V(8); PG8_WAIT_L(0); PG8_BAR; PG8_MMA(0, 0, At, B0); PG8_MMA(0, 1, At, B1); PG8_BAR; PG8_SCHED;
            PG8_LDA(At, 0, 1); PG8_STAGE(PG8_SB(0, 0), b2, voffB); PG8_STAGE(PG8_SB(0, 1), b2 + hstep, voffB); PG8_STAGE(PG8_SA(0, 0), a2, voffA);
            PG8_WAIT_V(8); PG8_WAIT_L(0); PG8_BAR; PG8_MMA(1, 0, At, B0); PG8_MMA(1, 1, At, B1); PG8_BAR; PG8_SCHED;
            PG8_LDB(B0, 1, 0); PG8_LDB(B1, 1, 1); PG8_SCHED; PG8_LDA(At, 1, 0); PG8_STAGE(PG8_SA(0, 1), a2 + hstep, voffA);
            PG8_WAIT_V(8); PG8_WAIT_L(0); PG8_BAR; PG8_MMA(0, 0, At, B0); PG8_MMA(0, 1, At, B1); PG8_BAR; PG8_SCHED;
            PG8_LDA(At, 1, 1); PG8_STAGE(PG8_SB(1, 0), b3, voffB); PG8_STAGE(PG8_SB(1, 1), b3 + hstep, voffB); PG8_STAGE(PG8_SA(1, 0), a3, voffA);
            PG8_WAIT_V(8); PG8_WAIT_L(0); PG8_BAR; PG8_MMA(1, 0, At, B0); PG8_MMA(1, 1, At, B1); PG8_BAR; PG8_SCHED;
            } else {
            PG8_LDB(B0, 0, 0); PG8_SCHED; PG8_LDA(At, 0, 0); PG8_STAGE(PG8_SA(1, 1), a1 + hstep, voffA);
            PG8_WAIT_L(8); PG8_BAR; PG8_WAIT_L(0); PG8_MMA(0, 0, At, B0); PG8_BAR; PG8_SCHED;
            PG8_LDB(B1, 0, 1); PG8_STAGE(PG8_SB(0, 0), b2, voffB);
            PG8_BAR; PG8_WAIT_L(0); PG8_MMA(0, 1, At, B1); PG8_BAR;
            PG8_LDA(At, 0, 1); PG8_STAGE(PG8_SA(0, 0), a2, voffA);
            PG8_BAR; PG8_WAIT_L(0); PG8_MMA(1, 0, At, B0); PG8_BAR; PG8_SCHED;
            PG8_STAGE(PG8_SB(0, 1), b2 + hstep, voffB);
            PG8_WAIT_V(6); PG8_BAR; PG8_MMA(1, 1, At, B1); PG8_BAR;
            PG8_LDB(B0, 1, 0); PG8_SCHED; PG8_LDA(At, 1, 0); PG8_STAGE(PG8_SA(0, 1), a2 + hstep, voffA);
            PG8_WAIT_L(8); PG8_BAR; PG8_WAIT_L(0); PG8_MMA(0, 0, At, B0); PG8_BAR; PG8_SCHED;
            PG8_LDB(B1, 1, 1); PG8_STAGE(PG8_SB(1, 0), b3, voffB);
            PG8_BAR; PG8_WAIT_L(0); PG8_MMA(0, 1, At, B1); PG8_BAR;
            PG8_LDA(At, 1, 1); PG8_STAGE(PG8_SA(1, 0), a3, voffA);
            PG8_BAR; PG8_WAIT_L(0); PG8_MMA(1, 0, At, B0); PG8_BAR; PG8_SCHED;
            PG8_STAGE(PG8_SB(1, 1), b3 + hstep, voffB);
            PG8_WAIT_V(6); PG8_BAR; PG8_MMA(1, 1, At, B1); PG8_BAR;
            }
        }
        if constexpr (ALIGN_EPI) { if (wr == 0) PG8_BAR; }
        if constexpr (!Epi::AFTER_DRAIN) { E(acc, cur, wr, wc, fr, fq); S.done(cur); }
        if (!has_next) break;
#pragma unroll
        for (int a = 0; a < 2; ++a)
#pragma unroll
            for (int b = 0; b < 2; ++b)
#pragma unroll
                for (int m = 0; m < 4; ++m)
#pragma unroll
                    for (int n = 0; n < 2; ++n) acc[a][b][m][n] = (f32x4){0.f, 0.f, 0.f, 0.f};
        cur = nxt; cA = nA; cB = nB; ++ui;
        if constexpr (ALIGN_EPI) { if (wr == 1) PG8_BAR; }
    }
    PG8_WAIT_V(0);
    if constexpr (!ALIGN_EPI) { if (wr == 0) PG8_BAR; }
    PG8_BAR;
    if constexpr (Epi::AFTER_DRAIN) { E.fused(acc, cur, wr, wc, fr, fq, lds, wid, lane); S.done(cur); }
#undef PG8_SA
#undef PG8_SB
#undef PG8_STAGE
#undef PG8_LDA
#undef PG8_LDB
#undef PG8_MMA
#undef PG8_WAIT_V
#undef PG8_WAIT_L
#undef PG8_BAR
#undef PG8_SCHED
}
}
#define LAS __attribute__((address_space(3)))
#define XB_TMO      128
#define XB_XCNT(j)  (256  + 64 * (j))
#define XB_XSUB(j)  (1280 + 64 * (j))
#define XB_XGEN(j)  (2304 + 64 * (j))
#define XB_TOP      3328
#define XB_TOPGEN   3392
#define XCD_BAR_WORDS 3456
#define XB_SPIN_CAP (1u << 18)
#define LAS __attribute__((address_space(3)))

__device__ __forceinline__ unsigned xb_ld(unsigned* p)              { return __hip_atomic_load(p, __ATOMIC_RELAXED, __HIP_MEMORY_SCOPE_AGENT); }
__device__ __forceinline__ unsigned xb_add(unsigned* p, unsigned v) { return __hip_atomic_fetch_add(p, v, __ATOMIC_RELAXED, __HIP_MEMORY_SCOPE_AGENT); }
__device__ __forceinline__ unsigned xb_xcc_id() { return (unsigned)__builtin_amdgcn_s_getreg((3 << 11) | 20) & 0xFu; }
#define XB_SPIN(cond, bar) do { unsigned _sp = 0; while (cond) { __builtin_amdgcn_s_sleep(1); \
    if ((++_sp & 255u) == 0u) { if (xb_ld(&(bar)[XB_TMO])) break; if (_sp > XB_SPIN_CAP) { atomicAdd(&(bar)[XB_TMO], 1u); break; } } } } while (0)

struct XcdBarrier {
    unsigned* bar; unsigned x;
    volatile LAS unsigned* st;
};

__device__ __forceinline__ XcdBarrier xcd_barrier_post(unsigned* bar, volatile LAS unsigned* st) {
    XcdBarrier b; b.bar = bar; b.x = xb_xcc_id(); b.st = st;
    if (threadIdx.x == 0) (void)xb_add(&bar[XB_XCNT(b.x)], 1u);
    return b;
}
__device__ __forceinline__ void xcd_barrier_complete(unsigned* bar, unsigned x, unsigned& nloc, unsigned& nx) {
    const unsigned G = gridDim.x * gridDim.y * gridDim.z;
    unsigned sum, cnt, mine, sp = 0u;
    for (;;) {
        sum = 0u; cnt = 0u; mine = 0u;
#pragma unroll
        for (unsigned j = 0; j < 16; ++j) { const unsigned c = xb_ld(&bar[XB_XCNT(j)]); sum += c; cnt += (c > 0u) ? 1u : 0u; mine = (j == x) ? c : mine; }
        if (sum == G) break;
        __builtin_amdgcn_s_sleep(1);
        if ((++sp & 255u) == 0u) { if (xb_ld(&bar[XB_TMO])) break; if (sp > XB_SPIN_CAP) { atomicAdd(&bar[XB_TMO], 1u); break; } }
    }
    nloc = mine > 0u ? mine : 1u; nx = cnt > 0u ? cnt : 1u;
}

__device__ __forceinline__ void xcd_barrier(const XcdBarrier& b) {
    asm volatile("s_waitcnt vmcnt(0)" ::: "memory");
    __syncthreads();
    if (threadIdx.x == 0) {
        unsigned* bar = b.bar;
        __builtin_amdgcn_s_waitcnt(0);
        unsigned nloc = b.st[0], nx = b.st[1];
        if (nloc == 0u) { xcd_barrier_complete(bar, b.x, nloc, nx); b.st[0] = nloc; b.st[1] = nx; }
        const unsigned old = xb_add(&bar[XB_XSUB(b.x)], 1u);
        const unsigned gen = old / nloc;
        if (old + 1u == (gen + 1u) * nloc) {
            __builtin_amdgcn_fence(__ATOMIC_RELEASE, "agent");
            asm volatile("s_waitcnt vmcnt(0)" ::: "memory");
            const unsigned og = xb_add(&bar[XB_TOP], 1u);
            const unsigned tg = og / nx;
            if (og + 1u == (tg + 1u) * nx) xb_add(&bar[XB_TOPGEN], 1u);
            else XB_SPIN(xb_ld(&bar[XB_TOPGEN]) == tg, bar);
            __builtin_amdgcn_fence(__ATOMIC_ACQUIRE, "agent");
            xb_add(&bar[XB_XGEN(b.x)], 1u);
            asm volatile("s_waitcnt vmcnt(0)" ::: "memory");
        } else {
            XB_SPIN(xb_ld(&bar[XB_XGEN(b.x)]) == gen, bar);
            __builtin_amdgcn_fence(__ATOMIC_ACQUIRE, "agent");
            asm volatile("s_waitcnt vmcnt(0)" ::: "memory");
        }
    }
    __syncthreads();
}


#ifndef REP
#define REP 0
#endif
#ifndef TPROBE
#define TPROBE 0
#endif
#ifndef AVAR
#define AVAR 0
#endif
constexpr int DM = 2048, NIN = 6144, MP = 32768, MS = 2048, MT = MP + MS, DEPTH = 4;
constexpr int NBP = 8, LP = 4096, NBS = 32, LSQ = 64;
constexpr int COL_Q = 0, COL_K = 1024, COL_V = 2048, COL_ZA = 3072, COL_US = 4096, COL_ZS = 4608, COL_UP = 5120, COL_ZP = 5632;
constexpr float EPSN = 1e-6f, LOG2E = 1.4426950408889634f;
constexpr size_t O_YP = 0, O_YS = O_YP + (size_t)MP * DM, O_KP = O_YS + (size_t)MS * DM, O_VP = O_KP + (size_t)DEPTH * NBP * 512 * 1024,
    O_SRP = O_VP + (size_t)DEPTH * NBP * 512 * 1024, O_SIP = O_SRP + (size_t)DEPTH * NBP * 2048, O_PP = O_SIP + (size_t)DEPTH * NBP * 2048,
    O_KS = O_PP + (size_t)DEPTH * NBP * 15 * 512, O_VS = O_KS + (size_t)DEPTH * NBS * 64 * 1024, O_SRS = O_VS + (size_t)DEPTH * NBS * 64 * 1024,
    O_SIS = O_SRS + (size_t)DEPTH * NBS * 2048, O_PS = O_SIS + (size_t)DEPTH * NBS * 2048, O_END = O_PS + (size_t)DEPTH * NBS * 15 * 512;
enum { I_XP = 0, I_XS, I_CP, I_CS, I_CK, I_CV, I_SRE, I_SIM, I_SPOOL, I_NORMG, I_WADA, I_BADA, I_WIN, I_RELB, I_AR, I_AI, I_LDT, I_BR, I_BI, I_CR, I_CI, I_SD, I_WGLU, I_BGLU,
       I_WPOOL, I_PSCALE, I_BNG, I_WOUT, I_FNG, N_IN };
constexpr size_t MiB = 1u << 20;
constexpr size_t WS_CTL = 0, WS_MOD = 1 * MiB, WS_SSQ = 5 * MiB, WS_SB = 6 * MiB, ZERO_BYTES = 10 * MiB, WS_GS = 10 * MiB, WS_SSMP = 12 * MiB, SSMP_LAYER = 512 * 1024, WS_WGLU = 14 * MiB, WS_WPOOL = 18 * MiB,
    WS_SLOC = 19 * MiB, WS_WOUT = 28 * MiB, WS_WIN = 60 * MiB, WS_HY = 156 * MiB, WS_PROJ = 292 * MiB, WS_KC = 700 * MiB, WS_VC = 828 * MiB, WS_HB = 956 * MiB, WS_END = 1092 * MiB;
constexpr size_t SSMP_ABAR = 0, SSMP_ABAR64 = 16384, SSMP_BF = 32768, SSMP_CF = 32768 + 131072;
constexpr int CW_BAR = 4096, CW_Q = 16384;
constexpr int LDS_BYTES = 147456, MISC_OFF = LDS_BYTES - 64;
constexpr int NPH = 3 + 5 * DEPTH;

#define GAS __attribute__((address_space(1)))
typedef unsigned short bf16;
typedef unsigned v4u __attribute__((ext_vector_type(4)));
typedef unsigned v2u __attribute__((ext_vector_type(2)));
typedef float f32x4 __attribute__((ext_vector_type(4)));
typedef float f32x16 __attribute__((ext_vector_type(16)));
typedef short bf16x8 __attribute__((ext_vector_type(8)));
typedef short s16x4 __attribute__((ext_vector_type(4)));
typedef float f32x2_t __attribute__((ext_vector_type(2)));
typedef __bf16 bf16x2_t __attribute__((ext_vector_type(2)));
#define DI __device__ __forceinline__
DI unsigned pk2(float lo, float hi) { f32x2_t v = {lo, hi}; bf16x2_t b = __builtin_convertvector(v, bf16x2_t); return __builtin_bit_cast(unsigned, b); }
DI float bflo(unsigned u) { return __uint_as_float(u << 16); }
DI float bfhi(unsigned u) { return __uint_as_float(u & 0xffff0000u); }
DI float ex2(float x) { return __builtin_amdgcn_exp2f(x); }
DI float rcpf_(float x) { return __builtin_amdgcn_rcpf(x); }
DI float silu_f(float z) { return z * rcpf_(1.f + ex2(-LOG2E * z)); }
DI float sigm_f(float z) { return rcpf_(1.f + ex2(-LOG2E * z)); }
DI float gelu_tanh_f(float x) { const float t = x + 0.044715f * x * x * x; return x * rcpf_(1.f + ex2(-(1.5957691216057308f * LOG2E) * t)); }
DI float xh_max(float v) { auto rr = __builtin_amdgcn_permlane32_swap(__float_as_uint(v), __float_as_uint(v), false, false); return fmaxf(__uint_as_float(rr[0]), __uint_as_float(rr[1])); }
DI float xh_sum(float v) { auto rr = __builtin_amdgcn_permlane32_swap(__float_as_uint(v), __float_as_uint(v), false, false); return __uint_as_float(rr[0]) + __uint_as_float(rr[1]); }
#define SWZ_XOR(v, k) __uint_as_float((unsigned)__builtin_amdgcn_ds_swizzle((int)__float_as_uint(v), ((k) << 10) | 0x1f))
DI float wave_sum(float v) { v += SWZ_XOR(v, 1); v += SWZ_XOR(v, 2); v += SWZ_XOR(v, 4); v += SWZ_XOR(v, 8); v += SWZ_XOR(v, 16); return xh_sum(v); }
DI f32x16 mfma32(bf16x8 a, bf16x8 b, f32x16 c) { return __builtin_amdgcn_mfma_f32_32x32x16_bf16(a, b, c, 0, 0, 0); }
DI f32x4 mfma16(bf16x8 a, bf16x8 b, f32x4 c) { return __builtin_amdgcn_mfma_f32_16x16x32_bf16(a, b, c, 0, 0, 0); }
typedef short v4i16_t __attribute__((ext_vector_type(4)));
DI s16x4 lds_tr(LAS const unsigned char* p) { return __builtin_bit_cast(s16x4, __builtin_amdgcn_ds_read_tr16_b64_v4i16((LAS v4i16_t*)p)); }
DI bf16x8 zero8() { return (bf16x8){0, 0, 0, 0, 0, 0, 0, 0}; }
DI bf16x8 ld8(const bf16* p) { return *(const bf16x8*)p; }
DI void unpack8(v4u w, float (&f)[8]) { f[0] = bflo(w.x); f[1] = bfhi(w.x); f[2] = bflo(w.y); f[3] = bfhi(w.y); f[4] = bflo(w.z); f[5] = bfhi(w.z); f[6] = bflo(w.w); f[7] = bfhi(w.w); }

struct Args { const float* in[N_IN]; float* out; unsigned char* ws; int ph_lo, ph_hi; };
static_assert(sizeof(Args) == (N_IN + 2) * 8 + 8, "Args has no padding");

DI int otid() { int t = threadIdx.x; asm volatile("" : "+v"(t)); return t; }
struct Ctx {
    const float* const* in; float* out; unsigned char* ws; LAS unsigned char* lds;
    int tid, lane, wave, G, bid;
    bf16* HY; bf16* HB; bf16* PROJ; bf16* KC; bf16* VC; bf16* WIN; bf16* WOUT; float* MOD; float* SSQ; float* SB; float* GS; unsigned* ctl;
};

DI void fresh(Ctx& C) { C.tid = otid(); C.lane = C.tid & 63; C.wave = __builtin_amdgcn_readfirstlane(C.tid >> 6); }
template <bool SILU> DI void p0_mod_unit(const Ctx& C0, int task) {
    Ctx C = C0; fresh(C);
    const int l = task / 192, rem = task % 192, ke = rem / 24, cb = rem % 24, k0 = ke * 256;
    LAS float* sc = (LAS float*)C.lds;
    for (int idx = C.tid; idx < 64 * 256; idx += 512) { const int r = idx >> 8, kk = idx & 255; float v = 0.f;
        if (r < 40) { if (SILU) { const float cv = (r < 8) ? C.in[I_CP][r * DM + k0 + kk] : C.in[I_CS][(r - 8) * DM + k0 + kk]; v = silu_f(cv); } else v = C.MOD[((size_t)l * 40 + r) * NIN + k0 + kk]; }
        sc[r * 257 + kk] = v; }
    __syncthreads();
    const int jl = C.lane & 31, kh = C.lane >> 5, j = cb * 256 + C.wave * 32 + jl;
    const float* Wp = C.in[SILU ? I_WADA : I_WIN] + (size_t)l * DM * NIN + (size_t)(k0 + kh) * NIN + j;
    f32x16 d0 = {}, d1 = {};
    float wv[16];
#pragma unroll
    for (int i = 0; i < 16; ++i) wv[i] = Wp[(size_t)i * 2 * NIN];
#pragma unroll 1
    for (int kp0 = 0; kp0 < 128; kp0 += 16) {
#pragma unroll
        for (int i = 0; i < 16; ++i) { const int kp = kp0 + i;
            const float a0 = sc[jl * 257 + 2 * kp + kh], a1 = sc[(32 + jl) * 257 + 2 * kp + kh];
            d0 = __builtin_amdgcn_mfma_f32_32x32x2f32(a0, wv[i], d0, 0, 0, 0); d1 = __builtin_amdgcn_mfma_f32_32x32x2f32(a1, wv[i], d1, 0, 0, 0);
            if (kp + 16 < 128) wv[i] = Wp[(size_t)(kp + 16) * 2 * NIN]; } }
    float* M = (SILU ? C.MOD : C.SB) + (size_t)l * 40 * NIN + j;
    const float bias = (SILU && ke == 0) ? C.in[I_BADA][l * NIN + j] : 0.f;
#pragma unroll
    for (int reg = 0; reg < 16; ++reg) unsafeAtomicAdd(M + (size_t)(8 * (reg >> 2) + 4 * kh + (reg & 3)) * NIN, d0[reg] + bias);
#pragma unroll
    for (int reg = 0; reg < 4; ++reg) unsafeAtomicAdd(M + (size_t)(32 + 4 * kh + reg) * NIN, d1[reg] + bias);
    __syncthreads();
}
DI void p0_transpose_item(const float* W, int K, int N, bf16* WT, LAS float* scr, int item, int lane) {
    const int nblk = N / 32, kb = item / nblk, nb = item % nblk, k0 = 64 * kb, n0 = 32 * nb;
#pragma unroll 8
    for (int i = 0; i < 32; ++i) { const int kk = 2 * i + (lane >> 5); scr[kk * 33 + (lane & 31)] = W[(size_t)(k0 + kk) * N + n0 + (lane & 31)]; }
    asm volatile("s_waitcnt lgkmcnt(0)" ::: "memory");
    const int c = lane & 7;
#pragma unroll
    for (int j = 0; j < 4; ++j) { const int n = (lane >> 3) + 8 * j; const LAS float* s = scr + (8 * c) * 33 + n;
        v4u o; o.x = pk2(s[0 * 33], s[1 * 33]); o.y = pk2(s[2 * 33], s[3 * 33]); o.z = pk2(s[4 * 33], s[5 * 33]); o.w = pk2(s[6 * 33], s[7 * 33]);
        *(v4u*)(WT + (size_t)(n0 + n) * K + k0 + 8 * c) = o; }
    asm volatile("s_waitcnt lgkmcnt(0)" ::: "memory");
}
DI void p0_ssm_params(const Ctx& C, int l, int g, int lane) {
    unsigned char* blk = C.ws + WS_SSMP + (size_t)l * SSMP_LAYER;
    const int gp = (l * 32 + g) * 64 + lane;
    const float dt = expf(C.in[I_LDT][l * 32 + g]);
    const float ar = C.in[I_AR][gp], ai = C.in[I_AI][gp];
    const float x = ar * dt, ang = ai * dt;
    float sn, cs; sincosf(ang, &sn, &cs);
    const float mag = expf(x), em1 = expm1f(x);
    const float abr = mag * cs, abi = mag * sn;
    float sh, ch; sincosf(0.5f * ang, &sh, &ch); (void)ch;
    const float nr = em1 * cs - 2.f * sh * sh, ni = abi;
    const float den = ar * ar + ai * ai;
    const float cr = (nr * ar + ni * ai) / den, ci = (ni * ar - nr * ai) / den;
    float* AB = (float*)(blk + SSMP_ABAR) + g * 128; AB[lane] = abr; AB[64 + lane] = abi;
    { float s64, c64; sincosf(64.f * ang, &s64, &c64); const float m64 = expf(64.f * x); float* A6 = (float*)(blk + SSMP_ABAR64) + g * 128; A6[lane] = m64 * c64; A6[64 + lane] = m64 * s64; }
    const float* br = C.in[I_BR] + (size_t)gp * 16; const float* bi = C.in[I_BI] + (size_t)gp * 16;
    float bbr[16], bbi[16];
#pragma unroll
    for (int c = 0; c < 16; ++c) { const float b_r = br[c], b_i = bi[c]; bbr[c] = cr * b_r - ci * b_i; bbi[c] = cr * b_i + ci * b_r; }
    v4u* BF = (v4u*)(blk + SSMP_BF) + (size_t)g * 4 * 64;
#pragma unroll
    for (int half = 0; half < 2; ++half) {
        v4u o; o.x = pk2(bbr[8 * half], bbr[8 * half + 1]); o.y = pk2(bbr[8 * half + 2], bbr[8 * half + 3]); o.z = pk2(bbr[8 * half + 4], bbr[8 * half + 5]); o.w = pk2(bbr[8 * half + 6], bbr[8 * half + 7]);
        BF[(0 + half) * 64 + lane] = o;
        o.x = pk2(bbi[8 * half], bbi[8 * half + 1]); o.y = pk2(bbi[8 * half + 2], bbi[8 * half + 3]); o.z = pk2(bbi[8 * half + 4], bbi[8 * half + 5]); o.w = pk2(bbi[8 * half + 6], bbi[8 * half + 7]);
        BF[(2 + half) * 64 + lane] = o; }
    v4u* CF = (v4u*)(blk + SSMP_CF) + (size_t)g * 4 * 64;
    const int c = lane & 15, kq = lane >> 4;
    const float* crp = C.in[I_CR] + ((size_t)(l * 32 + g) * 16 + c) * 64; const float* cip = C.in[I_CI] + ((size_t)(l * 32 + g) * 16 + c) * 64;
#pragma unroll
    for (int kap = 0; kap < 4; ++kap) { const int p0 = 16 * kap + 4 * kq;
        v4u o; o.x = pk2(crp[p0], -cip[p0]); o.y = pk2(crp[p0 + 1], -cip[p0 + 1]); o.z = pk2(crp[p0 + 2], -cip[p0 + 2]); o.w = pk2(crp[p0 + 3], -cip[p0 + 3]);
        CF[kap * 64 + lane] = o; }
}
DI void cache_convert(const Ctx& C, int l, int part, int nparts) {
    const size_t n8 = (size_t)NBS * 512 * 1024 / 8, base = (size_t)l * NBS * 512 * 1024;
    for (size_t i = (size_t)part * 64 + C.lane; i < 2 * n8; i += (size_t)nparts * 64) { const bool isv = i >= n8; const size_t e = base + (isv ? i - n8 : i) * 8;
        const float* s = (isv ? C.in[I_CV] : C.in[I_CK]) + e; const f32x4 a = *(const f32x4*)s, b = *(const f32x4*)(s + 4);
        v4u o; o.x = pk2(a.x, a.y); o.y = pk2(a.z, a.w); o.z = pk2(b.x, b.y); o.w = pk2(b.z, b.w); *(v4u*)((isv ? C.VC : C.KC) + e) = o; }
}
DI void cache_item(const Ctx& C0, int l, int it) {
    Ctx C = C0; fresh(C);
    const size_t n8 = (size_t)NBS * 512 * 1024 / 8, base = (size_t)l * NBS * 512 * 1024, i0 = (size_t)it * (2 * n8 / 256);
#pragma unroll 4
    for (int k = 0; k < (int)(2 * n8 / 256 / 512); ++k) { const size_t i = i0 + (size_t)k * 512 + C.tid; const bool isv = i >= n8; const size_t e = base + (isv ? i - n8 : i) * 8;
        const float* s = (isv ? C.in[I_CV] : C.in[I_CK]) + e; const f32x4 a = *(const f32x4*)s, b = *(const f32x4*)(s + 4);
        v4u o; o.x = pk2(a.x, a.y); o.y = pk2(a.z, a.w); o.z = pk2(b.x, b.y); o.w = pk2(b.z, b.w); *(v4u*)((isv ? C.VC : C.KC) + e) = o; }
}
DI void p0_convert(const Ctx& C0);
DI void p0_prologue(const Ctx& C0, bool with_mod) {
    if (C0.bid & 1) { if (with_mod) for (int u = C0.bid; u < 768; u += C0.G) p0_mod_unit<true>(C0, u); __syncthreads(); p0_convert(C0); }
    else { p0_convert(C0); __syncthreads(); if (with_mod) for (int u = C0.bid; u < 768; u += C0.G) p0_mod_unit<true>(C0, u); }
}
DI void p0_convert(const Ctx& C0) {
    Ctx C = C0; fresh(C);
    const int gw = C.bid * 8 + C.wave, NGW = C.G * 8, lane = C.lane;
    LAS float* scr = (LAS float*)(C.lds + C.wave * 16384);
    constexpr int I_IN = (DM / 64) * (NIN / 32), I_OUT = (DM / 64) * (DM / 32);
    for (int it = gw; it < DEPTH * (I_IN + I_OUT); it += NGW) {
        const int l = it / (I_IN + I_OUT), r = it % (I_IN + I_OUT);
        if (r < I_IN) p0_transpose_item(C.in[I_WIN] + (size_t)l * DM * NIN, DM, NIN, C.WIN + (size_t)l * NIN * DM, scr, r, lane);
        else p0_transpose_item(C.in[I_WOUT] + (size_t)l * DM * DM, DM, DM, C.WOUT + (size_t)l * DM * DM, scr, r - I_IN, lane);
    }
    for (int it = gw; it < DEPTH * 1024; it += NGW) { const int l = it >> 10, ct = (it >> 5) & 31, kap = it & 31;
        const float* w = C.in[I_WGLU] + (size_t)l * 512 * 1024 + (size_t)(16 * kap + 8 * (lane >> 5)) * 1024 + 32 * ct + (lane & 31);
        v4u o; o.x = pk2(w[0], w[1024]); o.y = pk2(w[2048], w[3072]); o.z = pk2(w[4096], w[5120]); o.w = pk2(w[6144], w[7168]);
        ((v4u*)(C.ws + WS_WGLU))[(size_t)it * 64 + lane] = o; }
    for (int it = gw; it < DEPTH * 128; it += NGW) { const int lg = it >> 5, ct = (it >> 3) & 3, kap = it & 7;
        const float* w = C.in[I_WPOOL] + (size_t)lg * 128 * 128 + (size_t)(16 * kap + 8 * (lane >> 5)) * 128 + 32 * ct + (lane & 31);
        v4u o; o.x = pk2(w[0], w[128]); o.y = pk2(w[256], w[384]); o.z = pk2(w[512], w[640]); o.w = pk2(w[768], w[896]);
        ((v4u*)(C.ws + WS_WPOOL))[(size_t)it * 64 + lane] = o; }
    for (int it = gw; it < DEPTH * 32; it += NGW) p0_ssm_params(C, it >> 5, it & 31, lane);
}

DI void p0b_rows(const Ctx& C0);
DI void p0b_phase(const Ctx& C0) {
    if (C0.bid & 1) { for (int u = C0.bid; u < 768; u += C0.G) p0_mod_unit<false>(C0, u); p0b_rows(C0); }
    else { p0b_rows(C0); __syncthreads(); for (int u = C0.bid; u < 768; u += C0.G) p0_mod_unit<false>(C0, u); }
}
DI void p0b_rows(const Ctx& C0) {
    Ctx C = C0; fresh(C);
    for (int i = C.bid * 512 + C.tid; i < DEPTH * 40 * DM; i += C.G * 512) { const int l = i / (40 * DM), r = (i / DM) % 40, k = i % DM;
        C.GS[i] = C.in[I_NORMG][l * DM + k] * (1.f + C.MOD[((size_t)l * 40 + r) * NIN + DM + k]); }
    const int gw = C.bid * 8 + C.wave, NGW = C.G * 8, lane = C.lane, rpw = (MT + NGW - 1) / NGW;
    f32x4 gs[8]; int cur_b = -1;
    f32x4 v[8], vn[8];
    auto ldrow = [&](int m, f32x4 (&d)[8]) { const float* xr = (m < MP) ? C.in[I_XP] + (size_t)m * DM : C.in[I_XS] + (size_t)(m - MP) * DM;
#pragma unroll
        for (int j = 0; j < 8; ++j) d[j] = ((const f32x4*)xr)[lane + 64 * j]; };
    const int m0 = gw * rpw; if (m0 < MT) ldrow(m0, v);
    for (int i = 0; i < rpw; ++i) { const int m = m0 + i; if (m >= MT) break;
        if (i + 1 < rpw && m + 1 < MT) ldrow(m + 1, vn);
        const int brow = (m < MP) ? (m >> 12) : 8 + ((m - MP) >> 6);
        if (brow != cur_b) { cur_b = brow; const float* md = C.MOD + (size_t)brow * NIN + DM;
#pragma unroll
            for (int j = 0; j < 8; ++j) gs[j] = ((const f32x4*)C.in[I_NORMG])[lane + 64 * j] * (((const f32x4*)md)[lane + 64 * j] + 1.f); }
        float sq = 0.f; v2u* o8 = (v2u*)(C.HB + (size_t)m * DM) + lane;
#pragma unroll
        for (int j = 0; j < 8; ++j) { sq += (v[j].x * v[j].x + v[j].y * v[j].y) + (v[j].z * v[j].z + v[j].w * v[j].w); const f32x4 h = v[j] * gs[j]; v2u o; o.x = pk2(h.x, h.y); o.y = pk2(h.z, h.w); o8[64 * j] = o; }
        sq = wave_sum(sq); if (lane == 0) C.SSQ[m] = sq;
#pragma unroll
        for (int j = 0; j < 8; ++j) v[j] = vn[j]; }
}
DI void final_norm_phase(const Ctx& C0) {
    Ctx C = C0; fresh(C);
    const int gw = C.bid * 8 + C.wave, NGW = C.G * 8, lane = C.lane, rpw = (MT + NGW - 1) / NGW;
    f32x4 g[8];
#pragma unroll
    for (int j = 0; j < 8; ++j) g[j] = ((const f32x4*)C.in[I_FNG])[lane + 64 * j];
    f32x4 v[8], vn[8];
    auto ldrow = [&](int m, f32x4 (&d)[8]) {
#pragma unroll
        for (int j = 0; j < 8; ++j) d[j] = ((const f32x4*)(C.out + (size_t)m * DM))[lane + 64 * j]; };
    const int m0 = gw * rpw; if (m0 < MT) ldrow(m0, v);
    for (int i = 0; i < rpw; ++i) { const int m = m0 + i; if (m >= MT) break;
        if (i + 1 < rpw && m + 1 < MT) ldrow(m + 1, vn);
        const float rstd = rsqrtf(C.SSQ[(size_t)DEPTH * MT + m] * (1.f / DM) + EPSN);
        f32x4* o4 = (f32x4*)(C.out + (size_t)m * DM) + lane;
#pragma unroll
        for (int j = 0; j < 8; ++j) o4[64 * j] = v[j] * rstd * g[j];
#pragma unroll
        for (int j = 0; j < 8; ++j) v[j] = vn[j]; }
}

constexpr int ROWP = 1040;
struct TailPre { v4u zz[8]; };
DI void tail_prefetch(const Ctx& C, int row0, int zcol, TailPre& P) {
#pragma unroll
    for (int it = 0; it < 8; ++it) { const int idx = C.tid + 512 * it, row = idx >> 6, ch = idx & 63; P.zz[it] = *(const v4u*)(C.PROJ + (size_t)(row0 + row) * NIN + zcol + ch * 8); }
}
DI void branch_tail(const Ctx& C, int l, int row0, LAS unsigned char* ST, LAS float* ssq, LAS float* rstd_l, const TailPre& P, int ycol) {
    if (C.tid < 64) { float t = 0.f;
#pragma unroll
        for (int w = 0; w < 8; ++w) t += ssq[w * 64 + C.tid];
        rstd_l[C.tid] = rsqrtf(t * (1.f / 512.f) + EPSN); }
    __syncthreads();
    const float* gb = C.in[I_BNG] + (size_t)l * DM + ycol;
    const f32x4 g0 = *(const f32x4*)(gb + (C.tid & 63) * 8), g1 = *(const f32x4*)(gb + (C.tid & 63) * 8 + 4);
#pragma unroll
    for (int it = 0; it < 8; ++it) { const int idx = C.tid + 512 * it, row = idx >> 6, ch = idx & 63;
        const v4u raw = *(const LAS v4u*)(ST + row * ROWP + ch * 16);
        const v4u zz = P.zz[it];
        float r[8], z[8]; unpack8(raw, r); unpack8(zz, z); const float rs = rstd_l[row];
        const float gg[8] = {g0.x, g0.y, g0.z, g0.w, g1.x, g1.y, g1.z, g1.w}; float o[8];
#pragma unroll
        for (int e = 0; e < 8; ++e) o[e] = r[e] * rs * gg[e] * silu_f(z[e]);
        v4u w; w.x = pk2(o[0], o[1]); w.y = pk2(o[2], o[3]); w.z = pk2(o[4], o[5]); w.w = pk2(o[6], o[7]);
        *(v4u*)(C.HY + (size_t)(row0 + row) * DM + ycol + ch * 8) = w; }
    __syncthreads();
}

struct SsmGroup { float ar, ai; bf16x8 bf[4]; };
DI void ssm_load_group(const Ctx& C, int l, int g, int lane, SsmGroup& S) {
    const unsigned char* blk = C.ws + WS_SSMP + (size_t)l * SSMP_LAYER;
    const float* AB = (const float*)(blk + SSMP_ABAR) + g * 128; S.ar = AB[lane]; S.ai = AB[64 + lane];
    const bf16x8* BF = (const bf16x8*)(blk + SSMP_BF) + (size_t)g * 4 * 64;
#pragma unroll
    for (int f = 0; f < 4; ++f) S.bf[f] = BF[f * 64 + lane];
}
struct SsmA { bf16x8 a0[4], a1[4]; };
DI void ssm_load_a(const Ctx& C, int row0, int g, int lane, SsmA& A) {
    const int i = lane & 31, kh = lane >> 5, ti = 4 * (i >> 3) + (i & 3); const bool act = ((i >> 2) & 1) == kh;
    const bf16* src = C.PROJ + (size_t)(row0 + ti) * NIN + COL_US + 16 * g;
#pragma unroll
    for (int blk = 0; blk < 4; ++blk) { A.a0[blk] = ld8(src + (size_t)blk * 16 * NIN); A.a1[blk] = ld8(src + (size_t)blk * 16 * NIN + 8);
        if (!act) { A.a0[blk] = zero8(); A.a1[blk] = zero8(); } }
}
DI void ssm_bu(const SsmGroup& S, const bf16x8 a0, const bf16x8 a1, f32x16& dre, f32x16& dim) {
    const f32x16 z = {};
    dre = mfma32(a0, S.bf[0], z); dre = mfma32(a1, S.bf[1], dre);
    dim = mfma32(a0, S.bf[2], z); dim = mfma32(a1, S.bf[3], dim);
}
DI void ssm_local_unit(const Ctx& C0, int l, int u) {
    Ctx C = C0; fresh(C);
    const int lane = C.lane, row0 = (u >> 6) * LP + (u & 63) * 64;
    float* SL = (float*)(C.ws + WS_SLOC) + (size_t)u * 4096;
    SsmGroup S; SsmA A; ssm_load_group(C, l, C.wave * 4, lane, S); ssm_load_a(C, row0, C.wave * 4, lane, A);
#pragma unroll 1
    for (int gi = 0; gi < 4; ++gi) { const int g = C.wave * 4 + gi;
        SsmGroup Sn; SsmA An; if (gi < 3) { ssm_load_group(C, l, g + 1, lane, Sn); ssm_load_a(C, row0, g + 1, lane, An); }
        float hr = 0.f, hi = 0.f;
#pragma unroll
        for (int blk = 0; blk < 4; ++blk) { f32x16 dre, dim; ssm_bu(S, A.a0[blk], A.a1[blk], dre, dim);
#pragma unroll
            for (int r = 0; r < 16; ++r) { const float nr = S.ar * hr - S.ai * hi + dre[r], ni = S.ar * hi + S.ai * hr + dim[r]; hr = nr; hi = ni; } }
        SL[g * 64 + lane] = hr; SL[2048 + g * 64 + lane] = hi;
        if (gi < 3) { S = Sn; A = An; } }
}
DI void ssm_carry_phase(const Ctx& C0, int l) {
    Ctx C = C0; fresh(C);
    const int t = C.wave * C.G + C.bid, NW = C.G * 8;
    if (t >= 256) { if (l == 0) cache_convert(C, l, t - 256, NW - 256); return; }
    const int b = t >> 5, g = t & 31, lane = C.lane;
    const float* A6 = (const float*)(C.ws + WS_SSMP + (size_t)l * SSMP_LAYER + SSMP_ABAR64) + g * 128; const float a6r = A6[lane], a6i = A6[64 + lane];
    float* SL = (float*)(C.ws + WS_SLOC) + (size_t)(b * 64) * 4096 + g * 64 + lane;
    float hr = 0.f, hi = 0.f;
#pragma unroll 1
    for (int nb = 0; nb < 4; ++nb) { float sr[16], si[16];
#pragma unroll
        for (int i = 0; i < 16; ++i) { sr[i] = SL[(size_t)(16 * nb + i) * 4096]; si[i] = SL[(size_t)(16 * nb + i) * 4096 + 2048]; }
#pragma unroll
        for (int i = 0; i < 16; ++i) { SL[(size_t)(16 * nb + i) * 4096] = hr; SL[(size_t)(16 * nb + i) * 4096 + 2048] = hi;
            const float nr = a6r * hr - a6i * hi + sr[i], ni = a6r * hi + a6i * hr + si[i]; hr = nr; hi = ni; } }
}
struct SsmPre { SsmGroup S; SsmA A; bf16x8 cf[4]; f32x4 dsk; v2u uu[4]; float hr, hi; };
DI void ssm_prefetch(const Ctx& C, int l, int g, int row0, bool samp, int b, int n, int lane, SsmPre& P) {
    const unsigned char* blk_p = C.ws + WS_SSMP + (size_t)l * SSMP_LAYER;
    ssm_load_group(C, l, g, lane, P.S); ssm_load_a(C, row0, g, lane, P.A);
    const bf16x8* CF = (const bf16x8*)(blk_p + SSMP_CF) + (size_t)g * 4 * 64;
#pragma unroll
    for (int k = 0; k < 4; ++k) P.cf[k] = CF[k * 64 + lane];
    const int t16 = lane & 15, kq = lane >> 4;
    P.dsk = *(const f32x4*)(C.in[I_SD] + (size_t)(l * 32 + g) * 16 + 4 * kq);
#pragma unroll
    for (int blk = 0; blk < 4; ++blk) P.uu[blk] = *(const v2u*)(C.PROJ + (size_t)(row0 + 16 * blk + t16) * NIN + COL_US + 16 * g + 4 * kq);
    if (samp) { P.hr = C.in[I_SRE][((size_t)(l * NBS + b) * 32 + g) * 64 + lane]; P.hi = C.in[I_SIM][((size_t)(l * NBS + b) * 32 + g) * 64 + lane]; }
    else { const float* SL = (const float*)(C.ws + WS_SLOC) + (size_t)(b * 64 + n) * 4096 + g * 64 + lane; P.hr = SL[0]; P.hi = SL[2048]; }
}
DI void ssm_main_unit(const Ctx& C0, int l, int u) {
    Ctx C = C0; fresh(C);
    const int lane = C.lane, wave = C.wave; const bool samp = u >= 512;
    const int b = samp ? u - 512 : (u >> 6), n = samp ? 0 : (u & 63), row0 = samp ? MP + 64 * b : b * LP + 64 * n;
    LAS unsigned char* GG = C.lds; LAS unsigned char* HT = C.lds + 64 * ROWP + wave * 4352;
    LAS float* ssq = (LAS float*)(C.lds + 64 * ROWP + 8 * 4352); LAS float* rstd_l = ssq + 512;
    { SsmPre P; ssm_prefetch(C, l, wave * 4, row0, samp, b, n, lane, P);
#pragma unroll 1
      for (int gi = 0; gi < 4; ++gi) { const int g = wave * 4 + gi;
        SsmPre Pn; if (gi < 3) ssm_prefetch(C, l, g + 1, row0, samp, b, n, lane, Pn);
        const int t16 = lane & 15, kq = lane >> 4;
        float hr = P.hr, hi = P.hi;
#pragma unroll
        for (int blk = 0; blk < 4; ++blk) { f32x16 dre, dim; ssm_bu(P.S, P.A.a0[blk], P.A.a1[blk], dre, dim);
#pragma unroll
            for (int r = 0; r < 16; ++r) { const float nr = P.S.ar * hr - P.S.ai * hi + dre[r], ni = P.S.ar * hi + P.S.ai * hr + dim[r]; hr = nr; hi = ni;
                *(LAS unsigned*)(HT + r * 272 + lane * 4) = pk2(nr, ni); }
            f32x4 yt = {0.f, 0.f, 0.f, 0.f};
#pragma unroll
            for (int k = 0; k < 4; ++k) { const bf16x8 hb = *(const LAS bf16x8*)(HT + t16 * 272 + (32 * k + 8 * kq) * 2); yt = mfma16(P.cf[k], hb, yt); }
            const v2u uu = P.uu[blk];
            const float y0 = gelu_tanh_f(yt[0] + P.dsk[0] * bflo(uu.x)), y1 = gelu_tanh_f(yt[1] + P.dsk[1] * bfhi(uu.x)), y2 = gelu_tanh_f(yt[2] + P.dsk[2] * bflo(uu.y)), y3 = gelu_tanh_f(yt[3] + P.dsk[3] * bfhi(uu.y));
            v2u o; o.x = pk2(y0, y1); o.y = pk2(y2, y3);
            *(LAS v2u*)(GG + (16 * blk + t16) * ROWP + (16 * g + 4 * kq) * 2) = o; }
        if (samp || n == 63) { float* ore = C.out + (samp ? O_SRS + ((size_t)(l * NBS + b) * 2048) : O_SRP + ((size_t)(l * NBP + b) * 2048)) + g * 64 + lane;
            float* oim = C.out + (samp ? O_SIS + ((size_t)(l * NBS + b) * 2048) : O_SIP + ((size_t)(l * NBP + b) * 2048)) + g * 64 + lane; *ore = hr; *oim = hi; }
        if (gi < 3) P = Pn; } }
    __syncthreads();
    const int hi5 = lane >> 5, r32 = lane & 31;
    const bf16x8* WG = (const bf16x8*)(C.ws + WS_WGLU) + (size_t)l * 1024 * 64 + lane;
    const float* bg = C.in[I_BGLU] + (size_t)l * 1024;
    float sq[2] = {0.f, 0.f}; v2u ost[2][4][2];
#pragma unroll
    for (int c = 0; c < 2; ++c) {
        const bf16x8* Wv = WG + (size_t)((2 * wave + c) * 32) * 64; const bf16x8* Wt = WG + (size_t)((16 + 2 * wave + c) * 32) * 64;
        f32x16 av[2], ag[2]; av[0] = f32x16{}; av[1] = f32x16{}; ag[0] = f32x16{}; ag[1] = f32x16{};
        bf16x8 rv[8], rg[8];
#pragma unroll
        for (int i = 0; i < 8; ++i) { rv[i] = Wv[(size_t)i * 64]; rg[i] = Wt[(size_t)i * 64]; }
#pragma unroll 1
        for (int k0 = 0; k0 < 32; k0 += 8) {
#pragma unroll
            for (int i = 0; i < 8; ++i) { const int kap = k0 + i;
                const bf16x8 b0 = *(const LAS bf16x8*)(GG + r32 * ROWP + (16 * kap + 8 * hi5) * 2), b1 = *(const LAS bf16x8*)(GG + (32 + r32) * ROWP + (16 * kap + 8 * hi5) * 2);
                av[0] = mfma32(rv[i], b0, av[0]); av[1] = mfma32(rv[i], b1, av[1]); ag[0] = mfma32(rg[i], b0, ag[0]); ag[1] = mfma32(rg[i], b1, ag[1]);
                if (kap + 8 < 32) { rv[i] = Wv[(size_t)(kap + 8) * 64]; rg[i] = Wt[(size_t)(kap + 8) * 64]; } } }
#pragma unroll
        for (int rr = 0; rr < 4; ++rr) { const int ch0 = 64 * wave + 32 * c + 8 * rr + 4 * hi5; const f32x4 bv = *(const f32x4*)(bg + ch0), bgt = *(const f32x4*)(bg + 512 + ch0);
#pragma unroll
            for (int tt = 0; tt < 2; ++tt) { float o[4];
#pragma unroll
                for (int e = 0; e < 4; ++e) { o[e] = (av[tt][4 * rr + e] + bv[e]) * sigm_f(ag[tt][4 * rr + e] + bgt[e]); sq[tt] += o[e] * o[e]; }
                ost[c][rr][tt].x = pk2(o[0], o[1]); ost[c][rr][tt].y = pk2(o[2], o[3]); } }
    }
    TailPre TP; tail_prefetch(C, row0, COL_ZS, TP);
#pragma unroll
    for (int tt = 0; tt < 2; ++tt) { const float t = xh_sum(sq[tt]); if (hi5 == 0) ssq[wave * 64 + 32 * tt + r32] = t; }
    __syncthreads();
#pragma unroll
    for (int c = 0; c < 2; ++c)
#pragma unroll
        for (int rr = 0; rr < 4; ++rr) { const int ch0 = 64 * wave + 32 * c + 8 * rr + 4 * hi5;
#pragma unroll
            for (int tt = 0; tt < 2; ++tt) *(LAS v2u*)(GG + (32 * tt + r32) * ROWP + ch0 * 2) = ost[c][rr][tt]; }
    __syncthreads();
    branch_tail(C, l, row0, GG, ssq, rstd_l, TP, 1024);
}

template <int W> DI void pool_diff(const Ctx& C, int l, bool samp, int b, int n, int row0, int gi, int th, int lane, LAS unsigned char* DF) {
    const int t0 = 32 * th + 8 * (lane >> 4), ch0 = 128 * gi + 8 * (lane & 15);
    const float* sp = C.in[I_SPOOL] + (size_t)(l * NBS + b) * 15 * 512;
    float x[W + 7][8];
#pragma unroll
    for (int i = 0; i < W + 7; ++i) { const int rel = t0 - (W - 1) + i;
        if (rel >= 0 || (!samp && n > 0)) unpack8(*(const v4u*)(C.PROJ + (size_t)(row0 + rel) * NIN + COL_UP + ch0), x[i]);
        else if (samp) { const float* s = sp + (size_t)(15 + rel) * 512 + ch0; const f32x4 a = *(const f32x4*)s, c4 = *(const f32x4*)(s + 4); x[i][0] = a.x; x[i][1] = a.y; x[i][2] = a.z; x[i][3] = a.w; x[i][4] = c4.x; x[i][5] = c4.y; x[i][6] = c4.z; x[i][7] = c4.w; }
        else {
#pragma unroll
            for (int e = 0; e < 8; ++e) x[i][e] = 0.f; } }
    const bool last = samp || n == 63;
    float* po = C.out + (samp ? O_PS + (size_t)(l * NBS + b) * 15 * 512 : O_PP + (size_t)(l * NBP + b) * 15 * 512);
#pragma unroll
    for (int tt = 0; tt < 8; ++tt) { const int t = t0 + tt, pos = 64 * n + t; float d[8];
        const float cnt = samp ? (float)W : (float)((pos + 1 < W) ? pos + 1 : W), ic = 1.f / cnt;
#pragma unroll
        for (int e = 0; e < 8; ++e) { float s = 0.f;
#pragma unroll
            for (int j = 0; j < W; ++j) s += x[tt + j][e];
            d[e] = s * ic - x[tt + W - 1][e]; }
        v4u o; o.x = pk2(d[0], d[1]); o.y = pk2(d[2], d[3]); o.z = pk2(d[4], d[5]); o.w = pk2(d[6], d[7]);
        *(LAS v4u*)(DF + t * ROWP + ch0 * 2) = o;
        if (last && t >= 49) { float* p = po + (size_t)(t - 49) * 512 + ch0; *(f32x4*)p = (f32x4){x[tt + W - 1][0], x[tt + W - 1][1], x[tt + W - 1][2], x[tt + W - 1][3]}; *(f32x4*)(p + 4) = (f32x4){x[tt + W - 1][4], x[tt + W - 1][5], x[tt + W - 1][6], x[tt + W - 1][7]}; } }
}
DI void pool_unit(const Ctx& C0, int l, int u) {
    Ctx C = C0; fresh(C);
    const int lane = C.lane, wave = C.wave; const bool samp = u >= 512;
    const int b = samp ? u - 512 : (u >> 6), n = samp ? 0 : (u & 63), row0 = samp ? MP + 64 * b : b * LP + 64 * n;
    LAS unsigned char* DF = C.lds; LAS float* ssq = (LAS float*)(C.lds + 64 * ROWP); LAS float* rstd_l = ssq + 512;
    { const int gi = wave >> 1, th = wave & 1;
      if (gi == 0) pool_diff<2>(C, l, samp, b, n, row0, 0, th, lane, DF); else if (gi == 1) pool_diff<4>(C, l, samp, b, n, row0, 1, th, lane, DF);
      else if (gi == 2) pool_diff<8>(C, l, samp, b, n, row0, 2, th, lane, DF); else pool_diff<16>(C, l, samp, b, n, row0, 3, th, lane, DF); }
    TailPre TP; tail_prefetch(C, row0, COL_ZP, TP);
    __syncthreads();
    const int hi5 = lane >> 5, r32 = lane & 31, gi = wave >> 1;
    f32x16 acc[2][2];
#pragma unroll
    for (int c = 0; c < 2; ++c) { acc[c][0] = f32x16{}; acc[c][1] = f32x16{}; }
    const bf16x8* WP = (const bf16x8*)(C.ws + WS_WPOOL) + (size_t)((l * 4 + gi) * 32) * 64 + lane;
#pragma unroll
    for (int kap = 0; kap < 8; ++kap) { bf16x8 af[2], bt[2];
#pragma unroll
        for (int c = 0; c < 2; ++c) af[c] = WP[(size_t)((2 * (wave & 1) + c) * 8 + kap) * 64];
#pragma unroll
        for (int tt = 0; tt < 2; ++tt) bt[tt] = *(const LAS bf16x8*)(DF + (32 * tt + r32) * ROWP + (128 * gi + 16 * kap + 8 * hi5) * 2);
#pragma unroll
        for (int c = 0; c < 2; ++c)
#pragma unroll
            for (int tt = 0; tt < 2; ++tt) acc[c][tt] = mfma32(af[c], bt[tt], acc[c][tt]); }
    const float* ps = C.in[I_PSCALE] + (size_t)l * 512;
    float sq[2] = {0.f, 0.f};
#pragma unroll
    for (int c = 0; c < 2; ++c)
#pragma unroll
        for (int rr = 0; rr < 4; ++rr) { const int d0 = 128 * gi + 32 * (2 * (wave & 1) + c) + 8 * rr + 4 * hi5; const f32x4 sc = *(const f32x4*)(ps + d0);
#pragma unroll
            for (int tt = 0; tt < 2; ++tt)
#pragma unroll
                for (int e = 0; e < 4; ++e) { const float o = acc[c][tt][4 * rr + e] * sc[e]; acc[c][tt][4 * rr + e] = o; sq[tt] += o * o; } }
#pragma unroll
    for (int tt = 0; tt < 2; ++tt) { const float t = xh_sum(sq[tt]); if (hi5 == 0) ssq[wave * 64 + 32 * tt + r32] = t; }
    __syncthreads();
#pragma unroll
    for (int c = 0; c < 2; ++c)
#pragma unroll
        for (int rr = 0; rr < 4; ++rr) { const int d0 = 128 * gi + 32 * (2 * (wave & 1) + c) + 8 * rr + 4 * hi5;
#pragma unroll
            for (int tt = 0; tt < 2; ++tt) { v2u o; o.x = pk2(acc[c][tt][4 * rr], acc[c][tt][4 * rr + 1]); o.y = pk2(acc[c][tt][4 * rr + 2], acc[c][tt][4 * rr + 3]);
                *(LAS v2u*)(DF + (32 * tt + r32) * ROWP + d0 * 2) = o; } }
    __syncthreads();
    branch_tail(C, l, row0, DF, ssq, rstd_l, TP, 1536);
}

constexpr int AT_STG = 65536, AT_TAB = 2 * AT_STG, AT_SSQ = AT_TAB + 2 * 4 * 384 * 4, AT_RSTD = AT_SSQ + 8 * 32 * 4, AT_FLAG = AT_RSTD + 256;
DI void attn_unit(const Ctx& C0, int l, int ucode) {
    Ctx C = C0; fresh(C);
    const int lane = C.lane, wave = C.wave, r32 = lane & 31, hi = lane >> 5, hd = wave >> 1, qh = wave & 1; const bool samp = (ucode >> 16) & 1;
    const int b = (ucode >> 8) & 255, n = samp ? 16 : (ucode & 255), rq0 = samp ? MP + 64 * b : b * LP + 64 * n;
    const int jstart = samp ? 0 : (n >= 8 ? 0 : 8 - n), nt = 9 - jstart, nsteps = 4 * nt;
    unsigned long long jseq = 0ull; { int cnt = 0; for (int k = 0; k < 9; ++k) { const int jj = samp ? k : (((k - (n - 8)) % 9) + 9) % 9; if (jj >= jstart) { jseq |= (unsigned long long)jj << (4 * cnt); ++cnt; } } }
    auto jof = [&](int ti) { return (int)((jseq >> (4 * ti)) & 15ull); };
    LAS unsigned char* KV = C.lds + hd * 16384;
    LAS float* TAB = (LAS float*)(C.lds + AT_TAB) + hd * 384;
    LAS float* ssq = (LAS float*)(C.lds + AT_SSQ); LAS float* rstd_l = (LAS float*)(C.lds + AT_RSTD); LAS volatile int* flag = (LAS volatile int*)(C.lds + AT_FLAG);
    if (C.tid < 8) flag[C.tid] = 0;
    __syncthreads();
    const float c1 = 0.125f * LOG2E;
    const int qi = 32 * qh + r32, sw = (r32 >> 1) & 7;
    auto issue = [&](int h, int j, auto STC) {
        constexpr int st = decltype(STC)::value;
        const char* src; unsigned pitchB;
        if (samp && j < 8) { src = (const char*)((qh ? C.VC : C.KC) + ((size_t)(l * NBS + b) * 512 + 64 * j) * 1024 + h * 64); pitchB = 2048u; }
        else { const size_t row = samp ? (size_t)rq0 : (size_t)(b * LP + 64 * (n - 8 + j)); src = (const char*)(C.PROJ + row * NIN + (qh ? COL_V : COL_K) + h * 64); pitchB = (unsigned)NIN * 2u; }
        LAS unsigned char* dst = KV + st * AT_STG + qh * 8192;
        if (qh == 0) { const unsigned rl = (unsigned)lane >> 3, cl = (unsigned)lane & 7u, sw0 = (rl >> 1) & 3u;
            const unsigned vo0 = rl * pitchB + ((cl ^ sw0) << 4), vo1 = rl * pitchB + ((cl ^ (sw0 | 4u)) << 4);
#pragma unroll
            for (int pc = 0; pc < 8; ++pc) __builtin_amdgcn_global_load_lds((const unsigned*)(src + (size_t)(8u * pc * pitchB) + ((pc & 1) ? vo1 : vo0)), (LAS unsigned*)(dst + pc * 1024), 16, 0, 0);
        } else { const unsigned vo = ((unsigned)lane >> 2) * pitchB + (((unsigned)lane & 3u) << 4);
#pragma unroll
            for (int pc = 0; pc < 8; ++pc) __builtin_amdgcn_global_load_lds((const unsigned*)(src + (size_t)(16u * (pc & 3) * pitchB + (pc >> 2) * 64u) + vo), (LAS unsigned*)(dst + pc * 1024), 16, 0, 0);
        }
    };
    float tv[3];
    auto tab_load = [&](int h) { const float* rb = C.in[I_RELB] + (size_t)(l * 16 + h) * 513;
#pragma unroll
        for (int k = 0; k < 3; ++k) { const int y = 192 * qh + lane + 64 * k; tv[k] = rb[y < 64 ? 512 : 576 - y]; } };
    auto tab_store = [&](int buf) {
#pragma unroll
        for (int k = 0; k < 3; ++k) TAB[buf * 1536 + 192 * qh + lane + 64 * k] = tv[k] * LOG2E; };
    bf16x8 qf[4], qn[4];
    auto q_load = [&](int h, bf16x8 (&q)[4]) { const bf16* qp = C.PROJ + (size_t)(rq0 + qi) * NIN + COL_Q + h * 64 + 8 * hi;
#pragma unroll
        for (int k = 0; k < 4; ++k) q[k] = ld8(qp + 16 * k); };
    tab_load(hd); tab_store(0); q_load(hd, qf);
    if (qh == 0) issue(hd, jof(0), std::integral_constant<int, 0>{});
    f32x16 O[2], negm, SA[2], SB[2]; float mref = 0.f, lrun = 0.f, ssq_acc = 0.f;
    O[0] = f32x16{}; O[1] = f32x16{}; negm = f32x16{};
    int hg = 0, ti = 0, hprev = 0; bool plast = false;
    auto handshake = [&](int v) {
        __builtin_amdgcn_s_waitcnt(0);
        if (lane == 0) flag[wave] = v;
        while (__builtin_amdgcn_readfirstlane(flag[wave ^ 1]) < v) { }
        asm volatile("" ::: "memory"); };
    auto qk = [&](f32x16 (&SN)[2], LAS const unsigned char* Kst) {
        bf16x8 kf[2][4];
        const unsigned ka = (unsigned)(uintptr_t)(Kst + r32 * 128);
#pragma unroll
        for (int k = 0; k < 4; ++k) { const unsigned ko = ka + (unsigned)(((2 * k + hi) ^ sw) << 4);
            asm volatile("ds_read_b128 %0, %1" : "=v"(kf[0][k]) : "v"(ko));
            asm volatile("ds_read_b128 %0, %1 offset:4096" : "=v"(kf[1][k]) : "v"(ko)); }
        asm volatile("s_waitcnt lgkmcnt(0)" : "+v"(kf[0][0]), "+v"(kf[0][1]), "+v"(kf[0][2]), "+v"(kf[0][3]), "+v"(kf[1][0]), "+v"(kf[1][1]), "+v"(kf[1][2]), "+v"(kf[1][3]));
#pragma unroll
        for (int k = 0; k < 4; ++k) { SN[0] = mfma32(kf[0][k], qf[k], k == 0 ? negm : SN[0]); SN[1] = mfma32(kf[1][k], qf[k], k == 0 ? negm : SN[1]); } };
    auto finish = [&](f32x16 (&SO)[2], LAS const unsigned char* Vst, bool wlast, int hp) {
        float rs = 0.f;
#pragma unroll
        for (int kb = 0; kb < 2; ++kb)
#pragma unroll
            for (int r = 0; r < 16; ++r) { const float pv = ex2(SO[kb][r]); SO[kb][r] = pv; rs += pv; }
        lrun += rs;
        bf16x8 pf[4];
#pragma unroll
        for (int ks = 0; ks < 4; ++ks) { const int kb = ks >> 1, s8 = 8 * (ks & 1); v4u w;
            w.x = pk2(SO[kb][s8], SO[kb][s8 + 1]); w.y = pk2(SO[kb][s8 + 2], SO[kb][s8 + 3]); w.z = pk2(SO[kb][s8 + 4], SO[kb][s8 + 5]); w.w = pk2(SO[kb][s8 + 6], SO[kb][s8 + 7]);
            pf[ks] = __builtin_bit_cast(bf16x8, w); }
        const unsigned vba = (unsigned)(uintptr_t)(Vst + (4 * hi + ((lane & 15) >> 2)) * 64 + ((lane >> 4) & 1) * 32 + (lane & 3) * 8);
#pragma unroll
        for (int kh = 0; kh < 2; ++kh) { s16x4 lo[2][2], up[2][2];
#pragma unroll
            for (int k2 = 0; k2 < 2; ++k2)
#pragma unroll
                for (int db = 0; db < 2; ++db) { const int ks = 2 * kh + k2;
                    asm volatile("ds_read_b64_tr_b16 %0, %1 offset:%2" : "=v"(lo[k2][db]) : "v"(vba), "i"(db * 4096 + ks * 1024));
                    asm volatile("ds_read_b64_tr_b16 %0, %1 offset:%2" : "=v"(up[k2][db]) : "v"(vba), "i"(db * 4096 + ks * 1024 + 512)); }
            asm volatile("s_waitcnt lgkmcnt(0)" : "+v"(lo[0][0]), "+v"(lo[0][1]), "+v"(lo[1][0]), "+v"(lo[1][1]), "+v"(up[0][0]), "+v"(up[0][1]), "+v"(up[1][0]), "+v"(up[1][1]));
#pragma unroll
            for (int k2 = 0; k2 < 2; ++k2)
#pragma unroll
                for (int db = 0; db < 2; ++db) { const bf16x8 vf = {lo[k2][db][0], lo[k2][db][1], lo[k2][db][2], lo[k2][db][3], up[k2][db][0], up[k2][db][1], up[k2][db][2], up[k2][db][3]};
                    O[db] = mfma32(vf, pf[2 * kh + k2], O[db]); } }
        if (wlast) {
            const float inv = 1.f / xh_sum(lrun); float sq = 0.f;
            bf16* yp = C.HY + (size_t)(rq0 + qi) * DM + hp * 64 + 4 * hi;
#pragma unroll
            for (int db = 0; db < 2; ++db)
#pragma unroll
                for (int rr = 0; rr < 4; ++rr) { float o[4];
#pragma unroll
                    for (int e = 0; e < 4; ++e) { o[e] = O[db][4 * rr + e] * inv; sq += o[e] * o[e]; }
                    v2u w; w.x = pk2(o[0], o[1]); w.y = pk2(o[2], o[3]); *(v2u*)(yp + 32 * db + 8 * rr) = w; }
            ssq_acc += xh_sum(sq);
            O[0] = f32x16{}; O[1] = f32x16{}; lrun = 0.f;
        } };
    auto scores = [&](f32x16 (&SN)[2], int j, LAS const float* T) {
        float mx = -1e30f;
        if (j <= 3) { const float bconst = T[0];
#pragma unroll
            for (int kb = 0; kb < 2; ++kb)
#pragma unroll
                for (int r = 0; r < 16; ++r) { const float sv = SN[kb][r] * c1 + bconst; SN[kb][r] = sv; mx = fmaxf(mx, sv); }
        } else { const int ybase = 320 - 64 * (8 - j) - qi + 4 * hi;
#pragma unroll
            for (int kb = 0; kb < 2; ++kb)
#pragma unroll
                for (int r = 0; r < 16; ++r) { const float sv = SN[kb][r] * c1 + T[ybase + 32 * kb + 8 * (r >> 2) + (r & 3)]; SN[kb][r] = sv; mx = fmaxf(mx, sv); }
        }
        mx = xh_max(mx);
        if (__any(fabsf(mx) > 8.0f)) {
            mref += mx;
#pragma unroll
            for (int kb = 0; kb < 2; ++kb)
#pragma unroll
                for (int r = 0; r < 16; ++r) SN[kb][r] -= mx;
            const float f = ex2(-mx), nm = -mref * (1.0f / c1); lrun *= f;
#pragma unroll
            for (int r = 0; r < 16; ++r) { negm[r] = nm; O[0][r] *= f; O[1][r] *= f; }
        } };
    auto step = [&](int s, auto CURC) {
        constexpr int cur = decltype(CURC)::value;
        f32x16 (&SN)[2] = cur ? SB : SA; f32x16 (&SO)[2] = cur ? SA : SB;
        const int h = 4 * hg + hd, j = jof(ti);
        handshake(s + 1);
        const bool lastt = (ti == nt - 1), more = lastt && hg < 3;
        if (qh == 0) { if (s + 1 < nsteps) { if (!lastt) issue(h, jof(ti + 1), std::integral_constant<int, (cur ^ 1)>{}); else issue(h + 4, jof(0), std::integral_constant<int, (cur ^ 1)>{}); } }
        else issue(h, j, std::integral_constant<int, cur>{});
        if (more) { tab_load(h + 4); q_load(h + 4, qn); }
        qk(SN, KV + cur * AT_STG);
        if (s > 0) finish(SO, KV + (cur ^ 1) * AT_STG + 8192, plast, hprev);
        scores(SN, j, TAB + (hg & 1) * 1536);
        plast = lastt; hprev = h;
        if (lastt) {
            negm = f32x16{}; mref = 0.f;
            if (more) { tab_store((hg + 1) & 1);
#pragma unroll
                for (int k = 0; k < 4; ++k) qf[k] = qn[k]; }
            ++hg; ti = 0;
        } else ++ti;
    };
    for (int s = 0; s < nsteps; s += 2) { step(s, std::integral_constant<int, 0>{}); step(s + 1, std::integral_constant<int, 1>{}); }
    handshake(nsteps + 1);
    finish(SB, KV + AT_STG + 8192, true, hprev);
    if (hi == 0) ssq[wave * 32 + r32] = ssq_acc;
    asm volatile("s_waitcnt vmcnt(0)" ::: "memory");
    __syncthreads();
    if (C.tid < 64) { const int q2 = C.tid >> 5, rr = C.tid & 31; float t = 0.f;
#pragma unroll
        for (int w = 0; w < 4; ++w) t += ssq[(2 * w + q2) * 32 + rr];
        rstd_l[C.tid] = rsqrtf(t * (1.f / 1024.f) + EPSN); }
    __syncthreads();
    const float* gb = C.in[I_BNG] + (size_t)l * DM;
    const f32x4 g0 = *(const f32x4*)(gb + (C.tid & 127) * 8), g1 = *(const f32x4*)(gb + (C.tid & 127) * 8 + 4);
#pragma unroll 2
    for (int it = 0; it < 16; ++it) { const int idx = C.tid + 512 * it, row = idx >> 7, ch = idx & 127;
        bf16* yp = C.HY + (size_t)(rq0 + row) * DM + ch * 8;
        const v4u raw = *(const v4u*)yp; const v4u zz = *(const v4u*)(C.PROJ + (size_t)(rq0 + row) * NIN + COL_ZA + ch * 8);
        float r[8], z[8]; unpack8(raw, r); unpack8(zz, z); const float rs = rstd_l[row];
        const float gg[8] = {g0.x, g0.y, g0.z, g0.w, g1.x, g1.y, g1.z, g1.w}; float o[8];
#pragma unroll
        for (int e = 0; e < 8; ++e) o[e] = r[e] * rs * gg[e] * silu_f(z[e]);
        v4u w; w.x = pk2(o[0], o[1]); w.y = pk2(o[2], o[3]); w.z = pk2(o[4], o[5]); w.w = pk2(o[6], o[7]);
        *(v4u*)yp = w; }
    __syncthreads();
}

DI int q_issue(const Ctx& C0, unsigned* ctr) {
    Ctx C = C0; fresh(C);
    int v = 0; if (C.tid == 0) v = (int)__hip_atomic_fetch_add(ctr, 1u, __ATOMIC_RELAXED, __HIP_MEMORY_SCOPE_AGENT);
    return v;
}
DI int q_bcast(const Ctx& C0, int v) {
    Ctx C = C0; fresh(C);
    LAS volatile int* slot = (LAS volatile int*)(C.lds + MISC_OFF + 32);
    if (C.tid == 0) *slot = v;
    __syncthreads();
    const int r = *slot;
    __syncthreads();
    return r;
}
DI int attn_code(unsigned xx, unsigned v) { return (v < 64u) ? (int)((xx << 8) | (63u - v)) : (int)((1u << 16) | ((4u * xx + (v - 64u)) << 8)); }
DI int q_issue_attn(const Ctx& C0, unsigned* ctr8) {
    Ctx C = C0; fresh(C);
    int v = 0; if (C.tid == 0) v = (int)__hip_atomic_fetch_add(ctr8 + 64 * (xb_xcc_id() & 7u), 1u, __ATOMIC_RELAXED, __HIP_MEMORY_SCOPE_AGENT);
    return v;
}
DI int q_bcast_attn(const Ctx& C0, unsigned* ctr8, int v) {
    Ctx C = C0; fresh(C);
    LAS volatile int* slot = (LAS volatile int*)(C.lds + MISC_OFF + 32);
    if (C.tid == 0) { const unsigned x = xb_xcc_id() & 7u; int code = -1;
        if ((unsigned)v < 68u) code = attn_code(x, (unsigned)v);
        else for (unsigned k = 1; k < 8; ++k) { const unsigned xx = (x + k) & 7u; const unsigned w = __hip_atomic_fetch_add(ctr8 + 64 * xx, 1u, __ATOMIC_RELAXED, __HIP_MEMORY_SCOPE_AGENT);
            if (w < 68u) { code = attn_code(xx, w); break; } }
        *slot = code; }
    __syncthreads();
    const int r = *slot;
    __syncthreads();
    return r;
}
__global__ void __launch_bounds__(512, 2) hymba_fwd(Args args) {
    extern __shared__ __attribute__((aligned(16))) unsigned char lds_raw[];
    Ctx C; C.in = args.in; C.out = args.out; C.ws = args.ws; C.lds = (LAS unsigned char*)lds_raw;
    C.tid = threadIdx.x; C.lane = C.tid & 63; C.wave = __builtin_amdgcn_readfirstlane(C.tid >> 6); C.G = gridDim.x; C.bid = blockIdx.x;
    C.HY = (bf16*)(args.ws + WS_HY); C.HB = (bf16*)(args.ws + WS_HB); C.PROJ = (bf16*)(args.ws + WS_PROJ); C.KC = (bf16*)(args.ws + WS_KC); C.VC = (bf16*)(args.ws + WS_VC);
    C.WIN = (bf16*)(args.ws + WS_WIN); C.WOUT = (bf16*)(args.ws + WS_WOUT); C.MOD = (float*)(args.ws + WS_MOD); C.SSQ = (float*)(args.ws + WS_SSQ); C.SB = (float*)(args.ws + WS_SB); C.GS = (float*)(args.ws + WS_GS); C.ctl = (unsigned*)(args.ws + WS_CTL);
    if (C.tid < 16) ((LAS unsigned*)(C.lds + MISC_OFF))[C.tid] = 0u;
    __syncthreads();
    const int lo = args.ph_lo, hi = args.ph_hi;
    const bool multi = (hi - lo) > 1;
    XcdBarrier bar; bar.bar = C.ctl + CW_BAR; bar.x = 0; bar.st = nullptr;
    if (multi) bar = xcd_barrier_post(C.ctl + CW_BAR, (volatile LAS unsigned*)(C.lds + MISC_OFF));
#define IN(k) (lo <= (k) && (k) < hi)
#define SEAM(k) do { if (IN(k) && IN((k) + 1)) xcd_barrier(bar); } while (0)
    int ph = 0;
#define TP_B(k) do { if (TPROBE == (k) && blockIdx.x == 0 && threadIdx.x == 0) *(LAS volatile unsigned long long*)(C.lds + MISC_OFF + 40) = __builtin_amdgcn_s_memrealtime(); } while (0)
#define TP_E(k) do { if (TPROBE == (k) && blockIdx.x == 0 && threadIdx.x == 0) *(LAS volatile unsigned long long*)(C.lds + MISC_OFF + 48) += __builtin_amdgcn_s_memrealtime() - *(LAS volatile unsigned long long*)(C.lds + MISC_OFF + 40); } while (0)
#ifndef PHM
#define PHM 0xff
#endif
    TP_B(1); if ((PHM & 1) && IN(ph)) { p0_prologue(C, true); if (REP & 16) p0_prologue(C, false); }
    SEAM(ph); ++ph; TP_E(1);
    TP_B(2); if ((PHM & 2) && IN(ph)) p0b_phase(C);
    SEAM(ph); ++ph; TP_E(2);
    for (int l = 0; l < DEPTH; ++l) {
        TP_B(3); if ((PHM & 4) && IN(ph)) {
            pg8::Gemm g{C.HB, C.WIN + (size_t)l * NIN * DM, MT, NIN, DM}; pg8::StaticOrder S; S.init(MT, NIN, C.G, C.bid);
            pg8::EpiProj E{C.PROJ, C.out + O_KP + (size_t)l * NBP * 512 * 1024, C.out + O_VP + (size_t)l * NBP * 512 * 1024, C.out + O_KS + (size_t)l * NBS * 64 * 1024, C.out + O_VS + (size_t)l * NBS * 64 * 1024,
                           C.SSQ + (size_t)l * MT, C.SB + (size_t)l * 40 * NIN};
            pg8::gemm_phase<pg8::EpiProj, pg8::StaticOrder, true, true>(C.lds, g, S, E);
        }
        SEAM(ph); ++ph; TP_E(3); TP_B(4);
        if ((PHM & 8) && IN(ph)) { for (int u = C.bid; u < 512; u += C.G) ssm_local_unit(C, l, u); }
        SEAM(ph); ++ph;
        if ((PHM & 8) && IN(ph)) ssm_carry_phase(C, l);
        SEAM(ph); ++ph; TP_E(4); TP_B(5);
        if ((PHM & 0x70) && IN(ph)) {
            unsigned* ctr = C.ctl + CW_Q + 64 * 16 * l;
            TP_B(8); if (PHM & 0x10) { int tk = q_issue_attn(C, ctr); for (;;) { const int u = q_bcast_attn(C, ctr, tk); if (u < 0) break; tk = q_issue_attn(C, ctr); attn_unit(C, l, u); } } TP_E(8);
            TP_B(9); if (PHM & 0x20) { int tk = q_issue(C, ctr + 64 * 8); for (;;) { const int u = q_bcast(C, tk); if (u >= 544) break; tk = q_issue(C, ctr + 64 * 8); ssm_main_unit(C, l, u); } } TP_E(9);
            TP_B(10); if (PHM & 0x40) { int tk = q_issue(C, ctr + 64 * 9); for (;;) { const int u = q_bcast(C, tk); if (u >= 544) break; tk = q_issue(C, ctr + 64 * 9); pool_unit(C, l, u); } } TP_E(10);
        }
        SEAM(ph); ++ph; TP_E(5); TP_B(6);
        if ((PHM & 0x80) && IN(ph)) {
            pg8::Gemm g{C.HY, C.WOUT + (size_t)l * DM * DM, MT, DM, DM}; pg8::StaticOrder S; S.init(MT, DM, C.G, C.bid);
            pg8::EpiRes E{l == 0 ? C.in[I_XP] : C.out, l == 0 ? C.in[I_XS] : C.out + (size_t)MP * DM, C.out, C.MOD + (size_t)l * 40 * NIN + 2 * DM,
                          (l + 1 < DEPTH) ? C.GS + (size_t)(l + 1) * 40 * DM : nullptr, C.HB, C.SSQ + (size_t)(l + 1) * MT};
            pg8::gemm_phase<pg8::EpiRes, pg8::StaticOrder, true, true>(C.lds, g, S, E);
            if (l + 1 < DEPTH && C.bid >= 64) { __syncthreads(); for (int it = C.bid - 64; it < 256; it += C.G - 64) cache_item(C, l + 1, it); }
        }
        SEAM(ph); ++ph; TP_E(6);
    }
    TP_B(7); TP_B(11); if ((PHM & 2) && IN(ph)) final_norm_phase(C); TP_E(7);
    if (TPROBE == 11) { xcd_barrier(bar); TP_E(11); }
    if (TPROBE && blockIdx.x == 0 && threadIdx.x == 0) { const unsigned long long d = *(LAS volatile unsigned long long*)(C.lds + MISC_OFF + 48), t0 = __builtin_amdgcn_s_memrealtime();
        while (__builtin_amdgcn_s_memrealtime() - t0 < d) __builtin_amdgcn_s_sleep(8); }
#undef IN
#undef SEAM
}

#ifndef N_LAUNCH_MODE
#define N_LAUNCH_MODE 1
#endif
extern "C" void kernel_launch(void* const* d_in, const int* in_sizes, int n_in, void* d_out, int out_size, void* d_ws, size_t ws_size, hipStream_t stream) {
    static int grid = 0;
    if (grid == 0) {
        if (n_in != N_IN || (size_t)out_size != O_END || ws_size < WS_END) { fprintf(stderr, "kernel_launch: unexpected sizes n_in %d out %d ws %zu (need %zu)\n", n_in, out_size, ws_size, (size_t)WS_END); grid = -1; return; }
        int dev = 0, cus = 0, per_cu = 0;
        if (hipGetDevice(&dev) != hipSuccess || hipDeviceGetAttribute(&cus, hipDeviceAttributeMultiprocessorCount, dev) != hipSuccess) { grid = -1; return; }
        if (hipFuncSetAttribute((const void*)hymba_fwd, hipFuncAttributeMaxDynamicSharedMemorySize, LDS_BYTES) != hipSuccess) { fprintf(stderr, "kernel_launch: hipFuncSetAttribute failed\n"); grid = -1; return; }
        if (hipOccupancyMaxActiveBlocksPerMultiprocessor(&per_cu, (const void*)hymba_fwd, 512, LDS_BYTES) != hipSuccess || per_cu < 1) fprintf(stderr, "kernel_launch: occupancy query says %d\n", per_cu);
        (void)hipGetLastError();
        grid = cus;
    }
    if (grid < 0) return;
    (void)in_sizes;
    if (hipMemsetAsync((char*)d_ws + WS_CTL, 0, ZERO_BYTES, stream) != hipSuccess) return;
    Args a{};
    for (int i = 0; i < N_IN; ++i) a.in[i] = (const float*)d_in[i];
    a.out = (float*)d_out; a.ws = (unsigned char*)d_ws;
#if N_LAUNCH_MODE == 1
    a.ph_lo = 0; a.ph_hi = NPH;
    hipLaunchKernelGGL(hymba_fwd, dim3(grid), dim3(512), LDS_BYTES, stream, a);
#else
    for (int p = 0; p < NPH; ++p) { a.ph_lo = p; a.ph_hi = p + 1; hipLaunchKernelGGL(hymba_fwd, dim3(grid), dim3(512), LDS_BYTES, stream, a); }
#endif
}
```

```cpp
#include <hip/hip_runtime.h>
#include <cstdio>
#include <cstdint>
#include <type_traits>
namespace pg8 {
#define PG8_LAS __attribute__((address_space(3)))
typedef unsigned short bf16_t;
typedef short bf16x8 __attribute__((ext_vector_type(8)));
typedef float f32x4 __attribute__((ext_vector_type(4)));
typedef unsigned u32x4 __attribute__((ext_vector_type(4)));
constexpr int BM = 256, BK = 64, HALF = 128, HTB = HALF * BK * 2  , STAGE_BYTES = 8 * HTB, NXCD = 8, WGM = 8;

__host__ __device__ __forceinline__ int lds_byte(int r, int c) { const int st = (r >> 4) * 2 + (c >> 5), rr = r & 15, cc = c & 31, ob = rr * 64 + cc * 2; return st * 1024 + (ob ^ (((ob >> 9) & 1) << 5)); }
__host__ __device__ __forceinline__ void stage_rc(int b, int& R, int& C) { const int st = b / 1024, sb = b % 1024, swz = sb ^ (((sb >> 9) & 1) << 5); R = (st >> 1) * 16 + swz / 64; C = (st & 1) * 32 + (swz % 64) / 2; }
__host__ __device__ __forceinline__ int perm32(int rho) { const int n = rho >> 4, i = rho & 15; return 8 * (i >> 2) + 4 * n + (i & 3); }

struct Unit { int pm, pn; };
struct Gemm { const bf16_t* A; const bf16_t* Bt; int M, N, K; };

struct StaticOrder {
    int nM, nN, nwg, G, c;
    __host__ __device__ void init(int M, int N, int G_, int c_) { nM = M / BM; nN = N / BM; nwg = nM * nN; G = G_; c = c_; }
    __host__ __device__ bool next(int i, Unit& u) const {
        const long L = (long)i * G + c; if (L >= nwg) return false;
        int wgid = (int)L; { const int q = nwg / NXCD, r = nwg % NXCD, xcd = wgid % NXCD, off = wgid / NXCD; wgid = (xcd < r ? xcd * (q + 1) : r * (q + 1) + (xcd - r) * q) + off; }
        const int nig = WGM * nN, gid = wgid / nig, fm = gid * WGM, gsz = (nM - fm) < WGM ? (nM - fm) : WGM;
        u.pm = fm + ((wgid % nig) % gsz); u.pn = (wgid % nig) / gsz; return true;
    }
    __device__ __forceinline__ void a_ready(const Unit&) const {}
    __device__ __forceinline__ void done(const Unit&) const {}
};

__device__ __forceinline__ unsigned cvt_pk_bf16(float lo, float hi) { unsigned r; asm volatile("v_cvt_pk_bf16_f32 %0, %1, %2" : "=v"(r) : "v"(lo), "v"(hi)); return r; }
typedef float f32x2 __attribute__((ext_vector_type(2)));
struct EpiProj {
    static constexpr bool PERM = true, AFTER_DRAIN = false;
    bf16_t* O; float* kp; float* vp; float* ks; float* vs; const float* ssq; const float* sb;
    __device__ __forceinline__ void operator()(const f32x4 (&acc)[2][2][4][2], const Unit& u, int wr, int wc, int fr, int fq) const {
        const int lrow0 = wr * 64 + fr, col0 = u.pn * BM + wc * 32 + 8 * fq;
#if defined(TPROBE) && TPROBE == 15
        if (blockIdx.x == 0 && threadIdx.x == 0) *(volatile PG8_LAS unsigned long long*)(147456 - 64 + 40) = __builtin_amdgcn_s_memrealtime();
#endif
        float* fo = nullptr;
        const bool isk = (u.pn >= 4 && u.pn < 8), isv = (u.pn >= 8 && u.pn < 12);
        if (isk || isv) {
            if (u.pm >= 128) fo = (isk ? ks : vs) + (size_t)(u.pm - 128) * 256 * 1024;
            else if ((u.pm & 15) >= 14) fo = (isk ? kp : vp) + ((size_t)(u.pm >> 4) * 512 + (size_t)((u.pm & 15) - 14) * 256) * 1024;
        }
        const int fcol0 = (u.pn & 3) * 256 + wc * 32 + 8 * fq;
#pragma unroll
        for (int ai = 0; ai < 2; ++ai) {
            const int brow = (u.pm < 128) ? (u.pm >> 4) : (8 + (u.pm - 128) * 4 + 2 * ai + wr);
            const float* sbp = sb + (size_t)brow * 6144 + col0;
            const f32x4 s00 = *(const f32x4*)sbp, s01 = *(const f32x4*)(sbp + 4), s10 = *(const f32x4*)(sbp + HALF), s11 = *(const f32x4*)(sbp + HALF + 4);
#pragma unroll
            for (int m = 0; m < 4; ++m) { const int lr = lrow0 + ai * HALF + m * 16; const int row = u.pm * BM + lr; bf16_t* rowp = O + (size_t)row * 6144 + col0;
                const float rs = rsqrtf(ssq[row] * (1.0f / 2048.0f) + 1e-6f);
                { const f32x4 v0 = acc[ai][0][m][0] * rs + s00, v1 = acc[ai][0][m][1] * rs + s01;
                  u32x4 w; w.x = cvt_pk_bf16(v0[0], v0[1]); w.y = cvt_pk_bf16(v0[2], v0[3]); w.z = cvt_pk_bf16(v1[0], v1[1]); w.w = cvt_pk_bf16(v1[2], v1[3]); *(u32x4*)rowp = w;
                  if (fo) { float* fp = fo + (size_t)lr * 1024 + fcol0; *(f32x4*)fp = v0; *(f32x4*)(fp + 4) = v1; } }
                { const f32x4 v0 = acc[ai][1][m][0] * rs + s10, v1 = acc[ai][1][m][1] * rs + s11;
                  u32x4 w; w.x = cvt_pk_bf16(v0[0], v0[1]); w.y = cvt_pk_bf16(v0[2], v0[3]); w.z = cvt_pk_bf16(v1[0], v1[1]); w.w = cvt_pk_bf16(v1[2], v1[3]); *(u32x4*)(rowp + HALF) = w;
                  if (fo) { float* fp = fo + (size_t)lr * 1024 + fcol0 + HALF; *(f32x4*)fp = v0; *(f32x4*)(fp + 4) = v1; } } }
        }
#if defined(TPROBE) && TPROBE == 15
        if (blockIdx.x == 0 && threadIdx.x == 0) { asm volatile("s_waitcnt vmcnt(0)" ::: "memory"); *(volatile PG8_LAS unsigned long long*)(147456 - 64 + 48) += __builtin_amdgcn_s_memrealtime() - *(volatile PG8_LAS unsigned long long*)(147456 - 64 + 40); }
#endif
    }
};
struct EpiRes {
    static constexpr bool PERM = false, AFTER_DRAIN = false;
    const float* xin_p; const float* xin_s; float* xout; const float* gate; const float* gs; bf16_t* hout; float* ssqn;
    __device__ __forceinline__ void operator()(const f32x4 (&acc)[2][2][4][2], const Unit& u, int wr, int wc, int fr, int fq) const {
        typedef unsigned u32x2 __attribute__((ext_vector_type(2)));
#if defined(TPROBE) && TPROBE == 14
        if (blockIdx.x == 0 && threadIdx.x == 0) *(volatile PG8_LAS unsigned long long*)(147456 - 64 + 40) = __builtin_amdgcn_s_memrealtime();
#endif
        const int col0 = u.pn * BM + wc * 32 + 4 * fq;
        const int r0 = u.pm * BM + wr * 64 + fr;
        const float* xbase = (u.pm < 128) ? (xin_p + (size_t)r0 * 2048 + col0) : (xin_s + (size_t)(r0 - 32768) * 2048 + col0);
        f32x4 xr[3][2][2];
#define EPR_LOAD(i) do { const int _ro = ((i) >> 2) * HALF + ((i) & 3) * 16; _Pragma("unroll") for (int bj = 0; bj < 2; ++bj) _Pragma("unroll") for (int n = 0; n < 2; ++n) xr[(i) % 3][bj][n] = *(const f32x4*)(xbase + (size_t)_ro * 2048 + bj * HALF + n * 16); } while (0)
        EPR_LOAD(0); EPR_LOAD(1);
#pragma unroll
        for (int ai = 0; ai < 2; ++ai) {
            const int brow = (u.pm < 128) ? (u.pm >> 4) : (8 + (u.pm - 128) * 4 + 2 * ai + wr);
            f32x4 gv[2][2], gsv[2][2];
#pragma unroll
            for (int bj = 0; bj < 2; ++bj)
#pragma unroll
                for (int n = 0; n < 2; ++n) { gv[bj][n] = *(const f32x4*)(gate + (size_t)brow * 6144 + col0 + bj * HALF + n * 16);
                    gsv[bj][n] = gs ? *(const f32x4*)(gs + (size_t)brow * 2048 + col0 + bj * HALF + n * 16) : (f32x4){0.f, 0.f, 0.f, 0.f}; }
#pragma unroll
            for (int m = 0; m < 4; ++m) { const int i = ai * 4 + m, roff = ai * HALF + m * 16, r = r0 + roff;
                if (i + 2 < 8) EPR_LOAD(i + 2);
                float* xo = xout + (size_t)r * 2048 + col0; bf16_t* ho = hout + (size_t)r * 2048 + col0;
                float part = 0.f;
#pragma unroll
                for (int bj = 0; bj < 2; ++bj)
#pragma unroll
                    for (int n = 0; n < 2; ++n) { const int c = bj * HALF + n * 16; const f32x4 xn = xr[i % 3][bj][n] + gv[bj][n] * acc[ai][bj][m][n];
                        *(f32x4*)(xo + c) = xn; part += (xn[0] * xn[0] + xn[1] * xn[1]) + (xn[2] * xn[2] + xn[3] * xn[3]);
                        if (gs) { const f32x4 h = xn * gsv[bj][n]; u32x2 w; w.x = cvt_pk_bf16(h[0], h[1]); w.y = cvt_pk_bf16(h[2], h[3]); *(u32x2*)(ho + c) = w; } }
                { auto r16 = __builtin_amdgcn_permlane16_swap(__float_as_uint(part), __float_as_uint(part), false, false); part = __uint_as_float(r16[0]) + __uint_as_float(r16[1]);
                  auto r32 = __builtin_amdgcn_permlane32_swap(__float_as_uint(part), __float_as_uint(part), false, false); part = __uint_as_float(r32[0]) + __uint_as_float(r32[1]); }
                if (fq == 0) unsafeAtomicAdd(ssqn + r, part);
                asm volatile("" ::: "memory"); }
        }
#undef EPR_LOAD
#if defined(TPROBE) && TPROBE == 14
        if (blockIdx.x == 0 && threadIdx.x == 0) { asm volatile("s_waitcnt vmcnt(0)" ::: "memory"); *(volatile PG8_LAS unsigned long long*)(147456 - 64 + 48) += __builtin_amdgcn_s_memrealtime() - *(volatile PG8_LAS unsigned long long*)(147456 - 64 + 40); }
#endif
    }
};

struct G2Order : StaticOrder {
    unsigned* sig;
    __device__ __forceinline__ void done(const Unit& u) const {
        if (sig && u.pm < 8) { asm volatile("s_waitcnt vmcnt(0)" ::: "memory"); __syncthreads();
            if (threadIdx.x == 0) { __builtin_amdgcn_fence(__ATOMIC_RELEASE, "agent"); asm volatile("s_waitcnt vmcnt(0)" ::: "memory"); __hip_atomic_fetch_add(sig, 1u, __ATOMIC_RELAXED, __HIP_MEMORY_SCOPE_AGENT); } }
    }
};
struct G1Order {
    StaticOrder so; int mode; const unsigned* sig;
    __device__ void init(int M, int N, int G_, int c_, int mode_, const unsigned* sig_) { mode = mode_; sig = sig_; so.init(mode_ == 1 ? M - 8 * BM : M, N, G_, c_); }
    __device__ bool next(int i, Unit& u) const {
        if (mode == 2) { if (i > 0) return false; const int e = so.c - 64, x = e & 7, t = e >> 3; u.pn = 3 * x + t % 3; u.pm = t / 3; return true; }
        if (!so.next(i, u)) return false;
        if (mode == 1) u.pm += 8;
        return true;
    }
    __device__ __forceinline__ void a_ready(const Unit&) const {
        if (mode == 2) { if (threadIdx.x == 0) { while (__hip_atomic_load(sig, __ATOMIC_RELAXED, __HIP_MEMORY_SCOPE_AGENT) < 64u) __builtin_amdgcn_s_sleep(8);
                __builtin_amdgcn_fence(__ATOMIC_ACQUIRE, "agent"); asm volatile("s_waitcnt vmcnt(0)" ::: "memory"); }
            __syncthreads(); }
    }
    __device__ __forceinline__ void done(const Unit&) const {}
};
template <class Epi, class Sched, bool ALIGN_EPI = false, bool SP2 = false>
__device__ __forceinline__ void gemm_phase(PG8_LAS unsigned char* lds, const Gemm g, const Sched& S, const Epi& E) {
    int tid_ = threadIdx.x; asm volatile("" : "+v"(tid_));
    const int tid = tid_, wid = __builtin_amdgcn_readfirstlane(tid >> 6), lane = tid & 63, wr = wid >> 2, wc = wid & 3, fr = lane & 15, fq = lane >> 4;
    const int K = g.K, nt = K / BK;
    unsigned voffA[2], voffB[2];
#pragma unroll
    for (int i = 0; i < 2; ++i) { int R, C; stage_rc(tid * 16 + i * 8192, R, C); const int Rb = Epi::PERM ? ((R & ~31) + perm32(R & 31)) : R;
        voffA[i] = (unsigned)(R * K + C) * 2u; voffB[i] = (unsigned)(Rb * K + C) * 2u; }
    const size_t kstep = (size_t)(BK * 2);
    const size_t hstep = (size_t)HALF * K * 2;
    const size_t tstep = 2 * hstep;
    const unsigned ldsw = (unsigned)wid * 1024u;
    const int aoff = lds_byte(wr * 64 + fr, fq * 8), boff = lds_byte(wc * 32 + fr, fq * 8);
#define PG8_SA(b, h) (((b) * 2 + (h)) * HTB)
#define PG8_SB(b, h) ((4 + (b) * 2 + (h)) * HTB)
#define PG8_STAGE(bufoff, gbase, voff) do { _Pragma("unroll") for (int _i = 0; _i < 2; ++_i) \
        __builtin_amdgcn_global_load_lds((const unsigned*)((const char*)(gbase) + (voff)[_i]), (PG8_LAS unsigned*)(lds + (bufoff) + ldsw + _i * 8192), 16, 0, 0); } while (0)
#define PG8_LDA(dst, b, h) do { _Pragma("unroll") for (int m = 0; m < 4; ++m) _Pragma("unroll") for (int k = 0; k < 2; ++k) dst[m][k] = *(const PG8_LAS bf16x8*)(lds + PG8_SA(b, h) + aoff + m * 2048 + k * 1024); } while (0)
#define PG8_LDB(dst, b, h) do { _Pragma("unroll") for (int n = 0; n < 2; ++n) _Pragma("unroll") for (int k = 0; k < 2; ++k) dst[n][k] = *(const PG8_LAS bf16x8*)(lds + PG8_SB(b, h) + boff + n * 2048 + k * 1024); } while (0)
#define PG8_MMA(ai, bj, At, Bt) do { __builtin_amdgcn_s_setprio(1); _Pragma("unroll") for (int m = 0; m < 4; ++m) _Pragma("unroll") for (int n = 0; n < 2; ++n) _Pragma("unroll") for (int k = 0; k < 2; ++k) \
        acc[ai][bj][m][n] = __builtin_amdgcn_mfma_f32_16x16x32_bf16(Bt[n][k], At[m][k], acc[ai][bj][m][n], 0, 0, 0); __builtin_amdgcn_s_setprio(0); } while (0)
#define PG8_WAIT_V(n) asm volatile("s_waitcnt vmcnt(" #n ")" ::: "memory")
#define PG8_WAIT_L(n) asm volatile("s_waitcnt lgkmcnt(" #n ")" ::: "memory")
#define PG8_BAR __builtin_amdgcn_s_barrier()
#define PG8_SCHED __builtin_amdgcn_sched_barrier(0)
    Unit cur, nxt; int ui = 0;
    if (!S.next(0, cur)) return;
    f32x4 acc[2][2][4][2];
#pragma unroll
    for (int a = 0; a < 2; ++a)
#pragma unroll
        for (int b = 0; b < 2; ++b)
#pragma unroll
            for (int m = 0; m < 4; ++m)
#pragma unroll
                for (int n = 0; n < 2; ++n) acc[a][b][m][n] = (f32x4){0.f, 0.f, 0.f, 0.f};
    bf16x8 At[4][2], B0[2][2], B1[2][2];
    const char* cA = (const char*)g.A + (size_t)cur.pm * tstep; const char* cB = (const char*)g.Bt + (size_t)cur.pn * tstep;
    S.a_ready(cur);
    if constexpr (SP2) {
        PG8_STAGE(PG8_SB(0, 0), cB, voffB); PG8_STAGE(PG8_SB(0, 1), cB + hstep, voffB); PG8_STAGE(PG8_SA(0, 0), cA, voffA); PG8_STAGE(PG8_SA(0, 1), cA + hstep, voffA);
        if (wr == 1) PG8_BAR;
        PG8_WAIT_V(2); PG8_BAR;
        PG8_STAGE(PG8_SB(1, 0), cB + kstep, voffB); PG8_STAGE(PG8_SA(1, 0), cA + kstep, voffA); PG8_STAGE(PG8_SB(1, 1), cB + hstep + kstep, voffB);
        PG8_WAIT_V(6); PG8_BAR;
    } else {
        PG8_STAGE(PG8_SB(0, 0), cB, voffB); PG8_STAGE(PG8_SA(0, 0), cA, voffA); PG8_STAGE(PG8_SB(0, 1), cB + hstep, voffB); PG8_STAGE(PG8_SA(0, 1), cA + hstep, voffA);
        if (wr == 1) PG8_BAR;
        PG8_WAIT_V(4); PG8_BAR;
        PG8_STAGE(PG8_SB(1, 0), cB + kstep, voffB); PG8_STAGE(PG8_SA(1, 0), cA + kstep, voffA); PG8_STAGE(PG8_SB(1, 1), cB + hstep + kstep, voffB);
        PG8_WAIT_V(6); PG8_BAR;
    }
    for (;;) {
        const bool has_next = S.next(ui + 1, nxt);
        const char* nA = has_next ? (const char*)g.A + (size_t)nxt.pm * tstep : cA; const char* nB = has_next ? (const char*)g.Bt + (size_t)nxt.pn * tstep : cB;
        for (int t = 0; t < nt; t += 2) {
            const bool last = (t == nt - 2);
            const char* a1 = cA + (size_t)(t + 1) * kstep;
            const char* a2 = last ? nA : cA + (size_t)(t + 2) * kstep; const char* b2 = last ? nB : cB + (size_t)(t + 2) * kstep;
            const char* a3 = a2 + kstep; const char* b3 = b2 + kstep;
            if (last && has_next) S.a_ready(nxt);
            if constexpr (SP2) {
            PG8_LDB(B0, 0, 0); PG8_LDB(B1, 0, 1); PG8_SCHED; PG8_LDA(At, 0, 0); PG8_STAGE(PG8_SA(1, 1), a1 + hstep, voffA);
            PG8_WAIT_V(8); PG8_WAIT_L(0); PG8_BAR; PG8_MMA(0, 0, At, B0); PG8_MMA(0, 1, At, B1); PG8_BAR; PG8_SCHED;
            PG8_LDA(At, 0, 1); PG8_STAGE(PG8_SB(0, 0), b2, voffB); PG8_STAGE(PG8_SB(0, 1), b2 + hstep, voffB); PG8_STAGE(PG8_SA(0, 0), a2, voffA);
            PG8_WAIT_V(8); PG8_WAIT_L(0); PG8_BAR; PG8_MMA(1, 0, At, B0); PG8_MMA(1, 1, At, B1); PG8_BAR; PG8_SCHED;
            PG8_LDB(B0, 1, 0); PG8_LDB(B1, 1, 1); PG8_SCHED; PG8_LDA(At, 1, 0); PG8_STAGE(PG8_SA(0, 1), a2 + hstep, voffA);
            PG8_WAIT_V(8); PG8_WAIT_L(0); PG8_BAR; PG8_MMA(0, 0, At, B0); PG8_MMA(0, 1, At, B1); PG8_BAR; PG8_SCHED;
            PG8_LDA(At, 1, 1); PG8_STAGE(PG8_SB(1, 0), b3, voffB); PG8_STAGE(PG8_SB(1, 1), b3 + hstep, voffB); PG8_STAGE(PG8_SA(1, 0), a3, voffA);
            PG8_WAIT_V(8); PG8_WAIT_L(0); PG8_BAR; PG8_MMA(1, 0, At, B0); PG8_MMA(1, 1, At, B1); PG8_BAR; PG8_SCHED;
            } else {
            PG8_LDB(B0, 0, 0); PG8_SCHED; PG8_LDA(At, 0, 0); PG8_STAGE(PG8_SA(1, 1), a1 + hstep, voffA);
            PG8_WAIT_L(8); PG8_BAR; PG8_WAIT_L(0); PG8_MMA(0, 0, At, B0); PG8_BAR; PG8_SCHED;
            PG8_LDB(B1, 0, 1); PG8_STAGE(PG8_SB(0, 0), b2, voffB);
            PG8_BAR; PG8_WAIT_L(0); PG8_MMA(0, 1, At, B1); PG8_BAR;
            PG8_LDA(At, 0, 1); PG8_STAGE(PG8_SA(0, 0), a2, voffA);
            PG8_BAR; PG8_WAIT_L(0); PG8_MMA(1, 0, At, B0); PG8_BAR; PG8_SCHED;
            PG8_STAGE(PG8_SB(0, 1), b2 + hstep, voffB);
            PG8_WAIT_V(6); PG8_BAR; PG8_MMA(1, 1, At, B1); PG8_BAR;
            PG8_LDB(B0, 1, 0); PG8_SCHED; PG8_LDA(At, 1, 0); PG8_STAGE(PG8_SA(0, 1), a2 + hstep, voffA);
            PG8_WAIT_L(8); PG8_BAR; PG8_WAIT_L(0); PG8_MMA(0, 0, At, B0); PG8_BAR; PG8_SCHED;
            PG8_LDB(B1, 1, 1); PG8_STAGE(PG8_SB(1, 0), b3, voffB);
            PG8_BAR; PG8_WAIT_L(0); PG8_MMA(0, 1, At, B1); PG8_BAR;
            PG8_LDA(At, 1, 1); PG8_STAGE(PG8_SA(1, 0), a3, voffA);
            PG8_BAR; PG8_WAIT_L(0); PG8_MMA(1, 0, At, B0); PG8_BAR; PG8_SCHED;
            PG8_STAGE(PG8_SB(1, 1), b3 + hstep, voffB);
            PG8_WAIT_V(6); PG8_BAR; PG8_MMA(1, 1, At, B1); PG8_BAR;
            }
        }
        if constexpr (ALIGN_EPI) { if (wr == 0) PG8_BAR; }
        if constexpr (!Epi::AFTER_DRAIN) { E(acc, cur, wr, wc, fr, fq); S.done(cur); }
        if (!has_next) break;
#pragma unroll
        for (int a = 0; a < 2; ++a)
#pragma unroll
            for (int b = 0; b < 2; ++b)
#pragma unroll
                for (int m = 0; m < 4; ++m)
#pragma unroll
                    for (int n = 0; n < 2; ++n) acc[a][b][m][n] = (f32x4){0.f, 0.f, 0.f, 0.f};
        cur = nxt; cA = nA; cB = nB; ++ui;
        if constexpr (ALIGN_EPI) { if (wr == 1) PG8_BAR; }
    }
    PG8_WAIT_V(0);
    if constexpr (!ALIGN_EPI) { if (wr == 0) PG8_BAR; }
    PG8_BAR;
    if constexpr (Epi::AFTER_DRAIN) { E.fused(acc, cur, wr, wc, fr, fq, lds, wid, lane); S.done(cur); }
#undef PG8_SA
#undef PG8_SB
#undef PG8_STAGE
#undef PG8_LDA
#undef PG8_LDB
#undef PG8_MMA
#undef PG8_WAIT_V
#undef PG8_WAIT_L
#undef PG8_BAR
#undef PG8_SCHED
}
}
#define LAS __attribute__((address_space(3)))
#define XB_TMO      128
#define XB_XCNT(j)  (256  + 64 * (j))
#define XB_XSUB(j)  (1280 + 64 * (j))
#define XB_XGEN(j)  (2304 + 64 * (j))
#define XB_TOP      3328
#define XB_TOPGEN   3392
#define XCD_BAR_WORDS 3456
#define XB_SPIN_CAP (1u << 18)
#define LAS __attribute__((address_space(3)))

__device__ __forceinline__ unsigned xb_ld(unsigned* p)              { return __hip_atomic_load(p, __ATOMIC_RELAXED, __HIP_MEMORY_SCOPE_AGENT); }
__device__ __forceinline__ unsigned xb_add(unsigned* p, unsigned v) { return __hip_atomic_fetch_add(p, v, __ATOMIC_RELAXED, __HIP_MEMORY_SCOPE_AGENT); }
__device__ __forceinline__ unsigned xb_xcc_id() { return (unsigned)__builtin_amdgcn_s_getreg((3 << 11) | 20) & 0xFu; }
#define XB_SPIN(cond, bar) do { unsigned _sp = 0; while (cond) { __builtin_amdgcn_s_sleep(1); \
    if ((++_sp & 255u) == 0u) { if (xb_ld(&(bar)[XB_TMO])) break; if (_sp > XB_SPIN_CAP) { atomicAdd(&(bar)[XB_TMO], 1u); break; } } } } while (0)

struct XcdBarrier {
    unsigned* bar; unsigned x;
    volatile LAS unsigned* st;
};

__device__ __forceinline__ XcdBarrier xcd_barrier_post(unsigned* bar, volatile LAS unsigned* st) {
    XcdBarrier b; b.bar = bar; b.x = xb_xcc_id(); b.st = st;
    if (threadIdx.x == 0) (void)xb_add(&bar[XB_XCNT(b.x)], 1u);
    return b;
}
__device__ __forceinline__ void xcd_barrier_complete(unsigned* bar, unsigned x, unsigned& nloc, unsigned& nx) {
    const unsigned G = gridDim.x * gridDim.y * gridDim.z;
    unsigned sum, cnt, mine, sp = 0u;
    for (;;) {
        sum = 0u; cnt = 0u; mine = 0u;
#pragma unroll
        for (unsigned j = 0; j < 16; ++j) { const unsigned c = xb_ld(&bar[XB_XCNT(j)]); sum += c; cnt += (c > 0u) ? 1u : 0u; mine = (j == x) ? c : mine; }
        if (sum == G) break;
        __builtin_amdgcn_s_sleep(1);
        if ((++sp & 255u) == 0u) { if (xb_ld(&bar[XB_TMO])) break; if (sp > XB_SPIN_CAP) { atomicAdd(&bar[XB_TMO], 1u); break; } }
    }
    nloc = mine > 0u ? mine : 1u; nx = cnt > 0u ? cnt : 1u;
}

__device__ __forceinline__ void xcd_barrier(const XcdBarrier& b) {
    asm volatile("s_waitcnt vmcnt(0)" ::: "memory");
    __syncthreads();
    if (threadIdx.x == 0) {
        unsigned* bar = b.bar;
        __builtin_amdgcn_s_waitcnt(0);
        unsigned nloc = b.st[0], nx = b.st[1];
        if (nloc == 0u) { xcd_barrier_complete(bar, b.x, nloc, nx); b.st[0] = nloc; b.st[1] = nx; }
        const unsigned old = xb_add(&bar[XB_XSUB(b.x)], 1u);
        const unsigned gen = old / nloc;
        if (old + 1u == (gen + 1u) * nloc) {
            __builtin_amdgcn_fence(__ATOMIC_RELEASE, "agent");
            asm volatile("s_waitcnt vmcnt(0)" ::: "memory");
            const unsigned og = xb_add(&bar[XB_TOP], 1u);
            const unsigned tg = og / nx;
            if (og + 1u == (tg + 1u) * nx) xb_add(&bar[XB_TOPGEN], 1u);
            else XB_SPIN(xb_ld(&bar[XB_TOPGEN]) == tg, bar);
            __builtin_amdgcn_fence(__ATOMIC_ACQUIRE, "agent");
            xb_add(&bar[XB_XGEN(b.x)], 1u);
            asm volatile("s_waitcnt vmcnt(0)" ::: "memory");
        } else {
            XB_SPIN(xb_ld(&bar[XB_XGEN(b.x)]) == gen, bar);
            __builtin_amdgcn_fence(__ATOMIC_ACQUIRE, "agent");
            asm volatile("s_waitcnt vmcnt(0)" ::: "memory");
        }
    }
    __syncthreads();
}


#ifndef REP
#define REP 0
#endif
#ifndef TPROBE
#define TPROBE 0
#endif
#ifndef AVAR
#define AVAR 0
#endif
constexpr int DM = 2048, NIN = 6144, MP = 32768, MS = 2048, MT = MP + MS, DEPTH = 4;
constexpr int NBP = 8, LP = 4096, NBS = 32, LSQ = 64;
constexpr int COL_Q = 0, COL_K = 1024, COL_V = 2048, COL_ZA = 3072, COL_US = 4096, COL_ZS = 4608, COL_UP = 5120, COL_ZP = 5632;
constexpr float EPSN = 1e-6f, LOG2E = 1.4426950408889634f;
constexpr size_t O_YP = 0, O_YS = O_YP + (size_t)MP * DM, O_KP = O_YS + (size_t)MS * DM, O_VP = O_KP + (size_t)DEPTH * NBP * 512 * 1024,
    O_SRP = O_VP + (size_t)DEPTH * NBP * 512 * 1024, O_SIP = O_SRP + (size_t)DEPTH * NBP * 2048, O_PP = O_SIP + (size_t)DEPTH * NBP * 2048,
    O_KS = O_PP + (size_t)DEPTH * NBP * 15 * 512, O_VS = O_KS + (size_t)DEPTH * NBS * 64 * 1024, O_SRS = O_VS + (size_t)DEPTH * NBS * 64 * 1024,
    O_SIS = O_SRS + (size_t)DEPTH * NBS * 2048, O_PS = O_SIS + (size_t)DEPTH * NBS * 2048, O_END = O_PS + (size_t)DEPTH * NBS * 15 * 512;
enum { I_XP = 0, I_XS, I_CP, I_CS, I_CK, I_CV, I_SRE, I_SIM, I_SPOOL, I_NORMG, I_WADA, I_BADA, I_WIN, I_RELB, I_AR, I_AI, I_LDT, I_BR, I_BI, I_CR, I_CI, I_SD, I_WGLU, I_BGLU,
       I_WPOOL, I_PSCALE, I_BNG, I_WOUT, I_FNG, N_IN };
constexpr size_t MiB = 1u << 20;
constexpr size_t WS_CTL = 0, WS_MOD = 1 * MiB, WS_SSQ = 5 * MiB, WS_SB = 6 * MiB, ZERO_BYTES = 10 * MiB, WS_GS = 10 * MiB, WS_SSMP = 12 * MiB, SSMP_LAYER = 512 * 1024, WS_WGLU = 14 * MiB, WS_WPOOL = 18 * MiB,
    WS_SLOC = 19 * MiB, WS_WOUT = 28 * MiB, WS_WIN = 60 * MiB, WS_HY = 156 * MiB, WS_PROJ = 292 * MiB, WS_KC = 700 * MiB, WS_VC = 828 * MiB, WS_HB = 956 * MiB, WS_END = 1092 * MiB;
constexpr size_t SSMP_ABAR = 0, SSMP_ABAR64 = 16384, SSMP_BF = 32768, SSMP_CF = 32768 + 131072;
constexpr int CW_BAR = 4096, CW_Q = 16384, CW_RB = 12288;
constexpr int LDS_BYTES = 147456, MISC_OFF = LDS_BYTES - 64;
constexpr int NPH = 3 + 5 * DEPTH;

#define GAS __attribute__((address_space(1)))
typedef unsigned short bf16;
typedef unsigned v4u __attribute__((ext_vector_type(4)));
typedef unsigned v2u __attribute__((ext_vector_type(2)));
typedef float f32x4 __attribute__((ext_vector_type(4)));
typedef float f32x16 __attribute__((ext_vector_type(16)));
typedef short bf16x8 __attribute__((ext_vector_type(8)));
typedef short s16x4 __attribute__((ext_vector_type(4)));
typedef float f32x2_t __attribute__((ext_vector_type(2)));
typedef __bf16 bf16x2_t __attribute__((ext_vector_type(2)));
#define DI __device__ __forceinline__
DI unsigned pk2(float lo, float hi) { f32x2_t v = {lo, hi}; bf16x2_t b = __builtin_convertvector(v, bf16x2_t); return __builtin_bit_cast(unsigned, b); }
DI float bflo(unsigned u) { return __uint_as_float(u << 16); }
DI float bfhi(unsigned u) { return __uint_as_float(u & 0xffff0000u); }
DI float ex2(float x) { return __builtin_amdgcn_exp2f(x); }
DI float rcpf_(float x) { return __builtin_amdgcn_rcpf(x); }
DI float silu_f(float z) { return z * rcpf_(1.f + ex2(-LOG2E * z)); }
DI float sigm_f(float z) { return rcpf_(1.f + ex2(-LOG2E * z)); }
DI float gelu_tanh_f(float x) { const float t = x + 0.044715f * x * x * x; return x * rcpf_(1.f + ex2(-(1.5957691216057308f * LOG2E) * t)); }
DI float xh_max(float v) { auto rr = __builtin_amdgcn_permlane32_swap(__float_as_uint(v), __float_as_uint(v), false, false); return fmaxf(__uint_as_float(rr[0]), __uint_as_float(rr[1])); }
DI float xh_sum(float v) { auto rr = __builtin_amdgcn_permlane32_swap(__float_as_uint(v), __float_as_uint(v), false, false); return __uint_as_float(rr[0]) + __uint_as_float(rr[1]); }
#define SWZ_XOR(v, k) __uint_as_float((unsigned)__builtin_amdgcn_ds_swizzle((int)__float_as_uint(v), ((k) << 10) | 0x1f))
DI float wave_sum(float v) { v += SWZ_XOR(v, 1); v += SWZ_XOR(v, 2); v += SWZ_XOR(v, 4); v += SWZ_XOR(v, 8); v += SWZ_XOR(v, 16); return xh_sum(v); }
DI f32x16 mfma32(bf16x8 a, bf16x8 b, f32x16 c) { return __builtin_amdgcn_mfma_f32_32x32x16_bf16(a, b, c, 0, 0, 0); }
DI f32x4 mfma16(bf16x8 a, bf16x8 b, f32x4 c) { return __builtin_amdgcn_mfma_f32_16x16x32_bf16(a, b, c, 0, 0, 0); }
typedef short v4i16_t __attribute__((ext_vector_type(4)));
DI s16x4 lds_tr(LAS const unsigned char* p) { return __builtin_bit_cast(s16x4, __builtin_amdgcn_ds_read_tr16_b64_v4i16((LAS v4i16_t*)p)); }
DI bf16x8 zero8() { return (bf16x8){0, 0, 0, 0, 0, 0, 0, 0}; }
DI bf16x8 ld8(const bf16* p) { return *(const bf16x8*)p; }
DI void unpack8(v4u w, float (&f)[8]) { f[0] = bflo(w.x); f[1] = bfhi(w.x); f[2] = bflo(w.y); f[3] = bfhi(w.y); f[4] = bflo(w.z); f[5] = bfhi(w.z); f[6] = bflo(w.w); f[7] = bfhi(w.w); }

struct Args { const float* in[N_IN]; float* out; unsigned char* ws; int ph_lo, ph_hi; };
static_assert(sizeof(Args) == (N_IN + 2) * 8 + 8, "Args has no padding");

DI int otid() { int t = threadIdx.x; asm volatile("" : "+v"(t)); return t; }
struct Ctx {
    const float* const* in; float* out; unsigned char* ws; LAS unsigned char* lds;
    int tid, lane, wave, G, bid;
    bf16* HY; bf16* HB; bf16* PROJ; bf16* KC; bf16* VC; bf16* WIN; bf16* WOUT; float* MOD; float* SSQ; float* SB; float* GS; unsigned* ctl;
};

DI void fresh(Ctx& C) { C.tid = otid(); C.lane = C.tid & 63; C.wave = __builtin_amdgcn_readfirstlane(C.tid >> 6); }
template <bool SILU> DI void p0_mod_unit(const Ctx& C0, int task) {
    Ctx C = C0; fresh(C);
    const int l = task / 192, rem = task % 192, ke = rem / 24, cb = rem % 24, k0 = ke * 256;
    LAS float* sc = (LAS float*)C.lds;
    for (int idx = C.tid; idx < 64 * 256; idx += 512) { const int r = idx >> 8, kk = idx & 255; float v = 0.f;
        if (r < 40) { if (SILU) { const float cv = (r < 8) ? C.in[I_CP][r * DM + k0 + kk] : C.in[I_CS][(r - 8) * DM + k0 + kk]; v = silu_f(cv); } else v = C.MOD[((size_t)l * 40 + r) * NIN + k0 + kk]; }
        sc[r * 257 + kk] = v; }
    __syncthreads();
    const int jl = C.lane & 31, kh = C.lane >> 5, j = cb * 256 + C.wave * 32 + jl;
    const float* Wp = C.in[SILU ? I_WADA : I_WIN] + (size_t)l * DM * NIN + (size_t)(k0 + kh) * NIN + j;
    f32x16 d0 = {}, d1 = {};
    float wv[16];
#pragma unroll
    for (int i = 0; i < 16; ++i) wv[i] = Wp[(size_t)i * 2 * NIN];
#pragma unroll 1
    for (int kp0 = 0; kp0 < 128; kp0 += 16) {
#pragma unroll
        for (int i = 0; i < 16; ++i) { const int kp = kp0 + i;
            const float a0 = sc[jl * 257 + 2 * kp + kh], a1 = sc[(32 + jl) * 257 + 2 * kp + kh];
            d0 = __builtin_amdgcn_mfma_f32_32x32x2f32(a0, wv[i], d0, 0, 0, 0); d1 = __builtin_amdgcn_mfma_f32_32x32x2f32(a1, wv[i], d1, 0, 0, 0);
            if (kp + 16 < 128) wv[i] = Wp[(size_t)(kp + 16) * 2 * NIN]; } }
    float* M = (SILU ? C.MOD : C.SB) + (size_t)l * 40 * NIN + j;
    const float bias = (SILU && ke == 0) ? C.in[I_BADA][l * NIN + j] : 0.f;
#pragma unroll
    for (int reg = 0; reg < 16; ++reg) unsafeAtomicAdd(M + (size_t)(8 * (reg >> 2) + 4 * kh + (reg & 3)) * NIN, d0[reg] + bias);
#pragma unroll
    for (int reg = 0; reg < 4; ++reg) unsafeAtomicAdd(M + (size_t)(32 + 4 * kh + reg) * NIN, d1[reg] + bias);
    __syncthreads();
}
DI void p0_transpose_item(const float* W, int K, int N, bf16* WT, LAS float* scr, int item, int lane) {
    const int nblk = N / 32, kb = item / nblk, nb = item % nblk, k0 = 64 * kb, n0 = 32 * nb;
#pragma unroll 8
    for (int i = 0; i < 32; ++i) { const int kk = 2 * i + (lane >> 5); scr[kk * 33 + (lane & 31)] = W[(size_t)(k0 + kk) * N + n0 + (lane & 31)]; }
    asm volatile("s_waitcnt lgkmcnt(0)" ::: "memory");
    const int c = lane & 7;
#pragma unroll
    for (int j = 0; j < 4; ++j) { const int n = (lane >> 3) + 8 * j; const LAS float* s = scr + (8 * c) * 33 + n;
        v4u o; o.x = pk2(s[0 * 33], s[1 * 33]); o.y = pk2(s[2 * 33], s[3 * 33]); o.z = pk2(s[4 * 33], s[5 * 33]); o.w = pk2(s[6 * 33], s[7 * 33]);
        *(v4u*)(WT + (size_t)(n0 + n) * K + k0 + 8 * c) = o; }
    asm volatile("s_waitcnt lgkmcnt(0)" ::: "memory");
}
DI void p0_ssm_params(const Ctx& C, int l, int g, int lane) {
    unsigned char* blk = C.ws + WS_SSMP + (size_t)l * SSMP_LAYER;
    const int gp = (l * 32 + g) * 64 + lane;
    const float dt = expf(C.in[I_LDT][l * 32 + g]);
    const float ar = C.in[I_AR][gp], ai = C.in[I_AI][gp];
    const float x = ar * dt, ang = ai * dt;
    float sn, cs; sincosf(ang, &sn, &cs);
    const float mag = expf(x), em1 = expm1f(x);
    const float abr = mag * cs, abi = mag * sn;
    float sh, ch; sincosf(0.5f * ang, &sh, &ch); (void)ch;
    const float nr = em1 * cs - 2.f * sh * sh, ni = abi;
    const float den = ar * ar + ai * ai;
    const float cr = (nr * ar + ni * ai) / den, ci = (ni * ar - nr * ai) / den;
    float* AB = (float*)(blk + SSMP_ABAR) + g * 128; AB[lane] = abr; AB[64 + lane] = abi;
    { float s64, c64; sincosf(64.f * ang, &s64, &c64); const float m64 = expf(64.f * x); float* A6 = (float*)(blk + SSMP_ABAR64) + g * 128; A6[lane] = m64 * c64; A6[64 + lane] = m64 * s64; }
    const float* br = C.in[I_BR] + (size_t)gp * 16; const float* bi = C.in[I_BI] + (size_t)gp * 16;
    float bbr[16], bbi[16];
#pragma unroll
    for (int c = 0; c < 16; ++c) { const float b_r = br[c], b_i = bi[c]; bbr[c] = cr * b_r - ci * b_i; bbi[c] = cr * b_i + ci * b_r; }
    v4u* BF = (v4u*)(blk + SSMP_BF) + (size_t)g * 4 * 64;
#pragma unroll
    for (int half = 0; half < 2; ++half) {
        v4u o; o.x = pk2(bbr[8 * half], bbr[8 * half + 1]); o.y = pk2(bbr[8 * half + 2], bbr[8 * half + 3]); o.z = pk2(bbr[8 * half + 4], bbr[8 * half + 5]); o.w = pk2(bbr[8 * half + 6], bbr[8 * half + 7]);
        BF[(0 + half) * 64 + lane] = o;
        o.x = pk2(bbi[8 * half], bbi[8 * half + 1]); o.y = pk2(bbi[8 * half + 2], bbi[8 * half + 3]); o.z = pk2(bbi[8 * half + 4], bbi[8 * half + 5]); o.w = pk2(bbi[8 * half + 6], bbi[8 * half + 7]);
        BF[(2 + half) * 64 + lane] = o; }
    v4u* CF = (v4u*)(blk + SSMP_CF) + (size_t)g * 4 * 64;
    const int c = lane & 15, kq = lane >> 4;
    const float* crp = C.in[I_CR] + ((size_t)(l * 32 + g) * 16 + c) * 64; const float* cip = C.in[I_CI] + ((size_t)(l * 32 + g) * 16 + c) * 64;
#pragma unroll
    for (int kap = 0; kap < 4; ++kap) { const int p0 = 16 * kap + 4 * kq;
        v4u o; o.x = pk2(crp[p0], -cip[p0]); o.y = pk2(crp[p0 + 1], -cip[p0 + 1]); o.z = pk2(crp[p0 + 2], -cip[p0 + 2]); o.w = pk2(crp[p0 + 3], -cip[p0 + 3]);
        CF[kap * 64 + lane] = o; }
}
DI void cache_convert(const Ctx& C, int l, int part, int nparts) {
    const size_t n8 = (size_t)NBS * 512 * 1024 / 8, base = (size_t)l * NBS * 512 * 1024;
    for (size_t i = (size_t)part * 64 + C.lane; i < 2 * n8; i += (size_t)nparts * 64) { const bool isv = i >= n8; const size_t e = base + (isv ? i - n8 : i) * 8;
        const float* s = (isv ? C.in[I_CV] : C.in[I_CK]) + e; const f32x4 a = *(const f32x4*)s, b = *(const f32x4*)(s + 4);
        v4u o; o.x = pk2(a.x, a.y); o.y = pk2(a.z, a.w); o.z = pk2(b.x, b.y); o.w = pk2(b.z, b.w); *(v4u*)((isv ? C.VC : C.KC) + e) = o; }
}
DI void cache_item(const Ctx& C0, int l, int it) {
    Ctx C = C0; fresh(C);
    const size_t n8 = (size_t)NBS * 512 * 1024 / 8, base = (size_t)l * NBS * 512 * 1024, i0 = (size_t)it * (2 * n8 / 256);
#pragma unroll 4
    for (int k = 0; k < (int)(2 * n8 / 256 / 512); ++k) { const size_t i = i0 + (size_t)k * 512 + C.tid; const bool isv = i >= n8; const size_t e = base + (isv ? i - n8 : i) * 8;
        const float* s = (isv ? C.in[I_CV] : C.in[I_CK]) + e; const f32x4 a = *(const f32x4*)s, b = *(const f32x4*)(s + 4);
        v4u o; o.x = pk2(a.x, a.y); o.y = pk2(a.z, a.w); o.z = pk2(b.x, b.y); o.w = pk2(b.z, b.w); *(v4u*)((isv ? C.VC : C.KC) + e) = o; }
}
DI void p0_convert(const Ctx& C0);
DI void p0_prologue(const Ctx& C0, bool with_mod) {
    if (C0.bid & 1) { if (with_mod) for (int u = C0.bid; u < 768; u += C0.G) p0_mod_unit<true>(C0, u); __syncthreads(); p0_convert(C0); }
    else { p0_convert(C0); __syncthreads(); if (with_mod) for (int u = C0.bid; u < 768; u += C0.G) p0_mod_unit<true>(C0, u); }
}
DI void p0_convert(const Ctx& C0) {
    Ctx C = C0; fresh(C);
    const int gw = C.bid * 8 + C.wave, NGW = C.G * 8, lane = C.lane;
    LAS float* scr = (LAS float*)(C.lds + C.wave * 16384);
    constexpr int I_IN = (DM / 64) * (NIN / 32), I_OUT = (DM / 64) * (DM / 32);
    for (int it = gw; it < DEPTH * (I_IN + I_OUT); it += NGW) {
        const int l = it / (I_IN + I_OUT), r = it % (I_IN + I_OUT);
        if (r < I_IN) p0_transpose_item(C.in[I_WIN] + (size_t)l * DM * NIN, DM, NIN, C.WIN + (size_t)l * NIN * DM, scr, r, lane);
        else p0_transpose_item(C.in[I_WOUT] + (size_t)l * DM * DM, DM, DM, C.WOUT + (size_t)l * DM * DM, scr, r - I_IN, lane);
    }
    for (int it = gw; it < DEPTH * 1024; it += NGW) { const int l = it >> 10, ct = (it >> 5) & 31, kap = it & 31;
        const float* w = C.in[I_WGLU] + (size_t)l * 512 * 1024 + (size_t)(16 * kap + 8 * (lane >> 5)) * 1024 + 32 * ct + (lane & 31);
        v4u o; o.x = pk2(w[0], w[1024]); o.y = pk2(w[2048], w[3072]); o.z = pk2(w[4096], w[5120]); o.w = pk2(w[6144], w[7168]);
        ((v4u*)(C.ws + WS_WGLU))[(size_t)it * 64 + lane] = o; }
    for (int it = gw; it < DEPTH * 128; it += NGW) { const int lg = it >> 5, ct = (it >> 3) & 3, kap = it & 7;
        const float* w = C.in[I_WPOOL] + (size_t)lg * 128 * 128 + (size_t)(16 * kap + 8 * (lane >> 5)) * 128 + 32 * ct + (lane & 31);
        v4u o; o.x = pk2(w[0], w[128]); o.y = pk2(w[256], w[384]); o.z = pk2(w[512], w[640]); o.w = pk2(w[768], w[896]);
        ((v4u*)(C.ws + WS_WPOOL))[(size_t)it * 64 + lane] = o; }
    for (int it = gw; it < DEPTH * 32; it += NGW) p0_ssm_params(C, it >> 5, it & 31, lane);
}

DI void p0b_rows(const Ctx& C0);
DI void p0b_phase(const Ctx& C0) {
    if (C0.bid & 1) { for (int u = C0.bid; u < 768; u += C0.G) p0_mod_unit<false>(C0, u); p0b_rows(C0); }
    else { p0b_rows(C0); __syncthreads(); for (int u = C0.bid; u < 768; u += C0.G) p0_mod_unit<false>(C0, u); }
}
DI void p0b_rows(const Ctx& C0) {
    Ctx C = C0; fresh(C);
    for (int i = C.bid * 512 + C.tid; i < DEPTH * 40 * DM; i += C.G * 512) { const int l = i / (40 * DM), r = (i / DM) % 40, k = i % DM;
        C.GS[i] = C.in[I_NORMG][l * DM + k] * (1.f + C.MOD[((size_t)l * 40 + r) * NIN + DM + k]); }
    const int gw = C.bid * 8 + C.wave, NGW = C.G * 8, lane = C.lane, rpw = (MT + NGW - 1) / NGW;
    f32x4 gs[8]; int cur_b = -1;
    f32x4 v[8], vn[8];
    auto ldrow = [&](int m, f32x4 (&d)[8]) { const float* xr = (m < MP) ? C.in[I_XP] + (size_t)m * DM : C.in[I_XS] + (size_t)(m - MP) * DM;
#pragma unroll
        for (int j = 0; j < 8; ++j) d[j] = ((const f32x4*)xr)[lane + 64 * j]; };
    const int m0 = gw * rpw; if (m0 < MT) ldrow(m0, v);
    for (int i = 0; i < rpw; ++i) { const int m = m0 + i; if (m >= MT) break;
        if (i + 1 < rpw && m + 1 < MT) ldrow(m + 1, vn);
        const int brow = (m < MP) ? (m >> 12) : 8 + ((m - MP) >> 6);
        if (brow != cur_b) { cur_b = brow; const float* md = C.MOD + (size_t)brow * NIN + DM;
#pragma unroll
            for (int j = 0; j < 8; ++j) gs[j] = ((const f32x4*)C.in[I_NORMG])[lane + 64 * j] * (((const f32x4*)md)[lane + 64 * j] + 1.f); }
        float sq = 0.f; v2u* o8 = (v2u*)(C.HB + (size_t)m * DM) + lane;
#pragma unroll
        for (int j = 0; j < 8; ++j) { sq += (v[j].x * v[j].x + v[j].y * v[j].y) + (v[j].z * v[j].z + v[j].w * v[j].w); const f32x4 h = v[j] * gs[j]; v2u o; o.x = pk2(h.x, h.y); o.y = pk2(h.z, h.w); o8[64 * j] = o; }
        sq = wave_sum(sq); if (lane == 0) C.SSQ[m] = sq;
#pragma unroll
        for (int j = 0; j < 8; ++j) v[j] = vn[j]; }
}
DI void final_norm_phase(const Ctx& C0) {
    Ctx C = C0; fresh(C);
    const int gw = C.bid * 8 + C.wave, NGW = C.G * 8, lane = C.lane, rpw = (MT + NGW - 1) / NGW;
    f32x4 g[8];
#pragma unroll
    for (int j = 0; j < 8; ++j) g[j] = ((const f32x4*)C.in[I_FNG])[lane + 64 * j];
    f32x4 v[8], vn[8];
    auto ldrow = [&](int m, f32x4 (&d)[8]) {
#pragma unroll
        for (int j = 0; j < 8; ++j) d[j] = ((const f32x4*)(C.out + (size_t)m * DM))[lane + 64 * j]; };
    const int m0 = gw * rpw; if (m0 < MT) ldrow(m0, v);
    for (int i = 0; i < rpw; ++i) { const int m = m0 + i; if (m >= MT) break;
        if (i + 1 < rpw && m + 1 < MT) ldrow(m + 1, vn);
        const float rstd = rsqrtf(C.SSQ[(size_t)DEPTH * MT + m] * (1.f / DM) + EPSN);
        f32x4* o4 = (f32x4*)(C.out + (size_t)m * DM) + lane;
#pragma unroll
        for (int j = 0; j < 8; ++j) o4[64 * j] = v[j] * rstd * g[j];
#pragma unroll
        for (int j = 0; j < 8; ++j) v[j] = vn[j]; }
}

constexpr int ROWP = 1040;
struct TailPre { v4u zz[8]; };
DI void tail_prefetch(const Ctx& C, int row0, int zcol, TailPre& P) {
#pragma unroll
    for (int it = 0; it < 8; ++it) { const int idx = C.tid + 512 * it, row = idx >> 6, ch = idx & 63; P.zz[it] = *(const v4u*)(C.PROJ + (size_t)(row0 + row) * NIN + zcol + ch * 8); }
}
DI void branch_tail(const Ctx& C, int l, int row0, LAS unsigned char* ST, LAS float* ssq, LAS float* rstd_l, const TailPre& P, int ycol) {
    if (C.tid < 64) { float t = 0.f;
#pragma unroll
        for (int w = 0; w < 8; ++w) t += ssq[w * 64 + C.tid];
        rstd_l[C.tid] = rsqrtf(t * (1.f / 512.f) + EPSN); }
    __syncthreads();
    const float* gb = C.in[I_BNG] + (size_t)l * DM + ycol;
    const f32x4 g0 = *(const f32x4*)(gb + (C.tid & 63) * 8), g1 = *(const f32x4*)(gb + (C.tid & 63) * 8 + 4);
#pragma unroll
    for (int it = 0; it < 8; ++it) { const int idx = C.tid + 512 * it, row = idx >> 6, ch = idx & 63;
        const v4u raw = *(const LAS v4u*)(ST + row * ROWP + ch * 16);
        const v4u zz = P.zz[it];
        float r[8], z[8]; unpack8(raw, r); unpack8(zz, z); const float rs = rstd_l[row];
        const float gg[8] = {g0.x, g0.y, g0.z, g0.w, g1.x, g1.y, g1.z, g1.w}; float o[8];
#pragma unroll
        for (int e = 0; e < 8; ++e) o[e] = r[e] * rs * gg[e] * silu_f(z[e]);
        v4u w; w.x = pk2(o[0], o[1]); w.y = pk2(o[2], o[3]); w.z = pk2(o[4], o[5]); w.w = pk2(o[6], o[7]);
        *(v4u*)(C.HY + (size_t)(row0 + row) * DM + ycol + ch * 8) = w; }
    __syncthreads();
}

struct SsmGroup { float ar, ai; bf16x8 bf[4]; };
DI void ssm_load_group(const Ctx& C, int l, int g, int lane, SsmGroup& S) {
    const unsigned char* blk = C.ws + WS_SSMP + (size_t)l * SSMP_LAYER;
    const float* AB = (const float*)(blk + SSMP_ABAR) + g * 128; S.ar = AB[lane]; S.ai = AB[64 + lane];
    const bf16x8* BF = (const bf16x8*)(blk + SSMP_BF) + (size_t)g * 4 * 64;
#pragma unroll
    for (int f = 0; f < 4; ++f) S.bf[f] = BF[f * 64 + lane];
}
struct SsmA { bf16x8 a0[4], a1[4]; };
DI void ssm_load_a(const Ctx& C, int row0, int g, int lane, SsmA& A) {
    const int i = lane & 31, kh = lane >> 5, ti = 4 * (i >> 3) + (i & 3); const bool act = ((i >> 2) & 1) == kh;
    const bf16* src = C.PROJ + (size_t)(row0 + ti) * NIN + COL_US + 16 * g;
#pragma unroll
    for (int blk = 0; blk < 4; ++blk) { A.a0[blk] = ld8(src + (size_t)blk * 16 * NIN); A.a1[blk] = ld8(src + (size_t)blk * 16 * NIN + 8);
        if (!act) { A.a0[blk] = zero8(); A.a1[blk] = zero8(); } }
}
DI void ssm_bu(const SsmGroup& S, const bf16x8 a0, const bf16x8 a1, f32x16& dre, f32x16& dim) {
    const f32x16 z = {};
    dre = mfma32(a0, S.bf[0], z); dre = mfma32(a1, S.bf[1], dre);
    dim = mfma32(a0, S.bf[2], z); dim = mfma32(a1, S.bf[3], dim);
}
DI void ssm_local_unit(const Ctx& C0, int l, int u) {
    Ctx C = C0; fresh(C);
    const int lane = C.lane, row0 = (u >> 6) * LP + (u & 63) * 64;
    float* SL = (float*)(C.ws + WS_SLOC) + (size_t)u * 4096;
    SsmGroup S; SsmA A; ssm_load_group(C, l, C.wave * 4, lane, S); ssm_load_a(C, row0, C.wave * 4, lane, A);
#pragma unroll 1
    for (int gi = 0; gi < 4; ++gi) { const int g = C.wave * 4 + gi;
        SsmGroup Sn; SsmA An; if (gi < 3) { ssm_load_group(C, l, g + 1, lane, Sn); ssm_load_a(C, row0, g + 1, lane, An); }
        float hr = 0.f, hi = 0.f;
#pragma unroll
        for (int blk = 0; blk < 4; ++blk) { f32x16 dre, dim; ssm_bu(S, A.a0[blk], A.a1[blk], dre, dim);
#pragma unroll
            for (int r = 0; r < 16; ++r) { const float nr = S.ar * hr - S.ai * hi + dre[r], ni = S.ar * hi + S.ai * hr + dim[r]; hr = nr; hi = ni; } }
        SL[g * 64 + lane] = hr; SL[2048 + g * 64 + lane] = hi;
        if (gi < 3) { S = Sn; A = An; } }
}
DI void ssm_carry_phase(const Ctx& C0, int l) {
    Ctx C = C0; fresh(C);
    const int t = C.wave * C.G + C.bid, NW = C.G * 8;
    if (t >= 256) { if (l == 0) cache_convert(C, l, t - 256, NW - 256); return; }
    const int b = t >> 5, g = t & 31, lane = C.lane;
    const float* A6 = (const float*)(C.ws + WS_SSMP + (size_t)l * SSMP_LAYER + SSMP_ABAR64) + g * 128; const float a6r = A6[lane], a6i = A6[64 + lane];
    float* SL = (float*)(C.ws + WS_SLOC) + (size_t)(b * 64) * 4096 + g * 64 + lane;
    float hr = 0.f, hi = 0.f;
#pragma unroll 1
    for (int nb = 0; nb < 4; ++nb) { float sr[16], si[16];
#pragma unroll
        for (int i = 0; i < 16; ++i) { sr[i] = SL[(size_t)(16 * nb + i) * 4096]; si[i] = SL[(size_t)(16 * nb + i) * 4096 + 2048]; }
#pragma unroll
        for (int i = 0; i < 16; ++i) { SL[(size_t)(16 * nb + i) * 4096] = hr; SL[(size_t)(16 * nb + i) * 4096 + 2048] = hi;
            const float nr = a6r * hr - a6i * hi + sr[i], ni = a6r * hi + a6i * hr + si[i]; hr = nr; hi = ni; } }
}
struct SsmPre { SsmGroup S; SsmA A; bf16x8 cf[4]; f32x4 dsk; v2u uu[4]; float hr, hi; };
DI void ssm_prefetch(const Ctx& C, int l, int g, int row0, bool samp, int b, int n, int lane, SsmPre& P) {
    const unsigned char* blk_p = C.ws + WS_SSMP + (size_t)l * SSMP_LAYER;
    ssm_load_group(C, l, g, lane, P.S); ssm_load_a(C, row0, g, lane, P.A);
    const bf16x8* CF = (const bf16x8*)(blk_p + SSMP_CF) + (size_t)g * 4 * 64;
#pragma unroll
    for (int k = 0; k < 4; ++k) P.cf[k] = CF[k * 64 + lane];
    const int t16 = lane & 15, kq = lane >> 4;
    P.dsk = *(const f32x4*)(C.in[I_SD] + (size_t)(l * 32 + g) * 16 + 4 * kq);
#pragma unroll
    for (int blk = 0; blk < 4; ++blk) P.uu[blk] = *(const v2u*)(C.PROJ + (size_t)(row0 + 16 * blk + t16) * NIN + COL_US + 16 * g + 4 * kq);
    if (samp) { P.hr = C.in[I_SRE][((size_t)(l * NBS + b) * 32 + g) * 64 + lane]; P.hi = C.in[I_SIM][((size_t)(l * NBS + b) * 32 + g) * 64 + lane]; }
    else { const float* SL = (const float*)(C.ws + WS_SLOC) + (size_t)(b * 64 + n) * 4096 + g * 64 + lane; P.hr = SL[0]; P.hi = SL[2048]; }
}
DI void ssm_main_unit(const Ctx& C0, int l, int u) {
    Ctx C = C0; fresh(C);
    const int lane = C.lane, wave = C.wave; const bool samp = u >= 512;
    const int b = samp ? u - 512 : (u >> 6), n = samp ? 0 : (u & 63), row0 = samp ? MP + 64 * b : b * LP + 64 * n;
    LAS unsigned char* GG = C.lds; LAS unsigned char* HT = C.lds + 64 * ROWP + wave * 4352;
    LAS float* ssq = (LAS float*)(C.lds + 64 * ROWP + 8 * 4352); LAS float* rstd_l = ssq + 512;
    { SsmPre P; ssm_prefetch(C, l, wave * 4, row0, samp, b, n, lane, P);
#pragma unroll 1
      for (int gi = 0; gi < 4; ++gi) { const int g = wave * 4 + gi;
        SsmPre Pn; if (gi < 3) ssm_prefetch(C, l, g + 1, row0, samp, b, n, lane, Pn);
        const int t16 = lane & 15, kq = lane >> 4;
        float hr = P.hr, hi = P.hi;
#pragma unroll
        for (int blk = 0; blk < 4; ++blk) { f32x16 dre, dim; ssm_bu(P.S, P.A.a0[blk], P.A.a1[blk], dre, dim);
#pragma unroll
            for (int r = 0; r < 16; ++r) { const float nr = P.S.ar * hr - P.S.ai * hi + dre[r], ni = P.S.ar * hi + P.S.ai * hr + dim[r]; hr = nr; hi = ni;
                *(LAS unsigned*)(HT + r * 272 + lane * 4) = pk2(nr, ni); }
            f32x4 yt = {0.f, 0.f, 0.f, 0.f};
#pragma unroll
            for (int k = 0; k < 4; ++k) { const bf16x8 hb = *(const LAS bf16x8*)(HT + t16 * 272 + (32 * k + 8 * kq) * 2); yt = mfma16(P.cf[k], hb, yt); }
            const v2u uu = P.uu[blk];
            const float y0 = gelu_tanh_f(yt[0] + P.dsk[0] * bflo(uu.x)), y1 = gelu_tanh_f(yt[1] + P.dsk[1] * bfhi(uu.x)), y2 = gelu_tanh_f(yt[2] + P.dsk[2] * bflo(uu.y)), y3 = gelu_tanh_f(yt[3] + P.dsk[3] * bfhi(uu.y));
            v2u o; o.x = pk2(y0, y1); o.y = pk2(y2, y3);
            *(LAS v2u*)(GG + (16 * blk + t16) * ROWP + (16 * g + 4 * kq) * 2) = o; }
        if (samp || n == 63) { float* ore = C.out + (samp ? O_SRS + ((size_t)(l * NBS + b) * 2048) : O_SRP + ((size_t)(l * NBP + b) * 2048)) + g * 64 + lane;
            float* oim = C.out + (samp ? O_SIS + ((size_t)(l * NBS + b) * 2048) : O_SIP + ((size_t)(l * NBP + b) * 2048)) + g * 64 + lane; *ore = hr; *oim = hi; }
        if (gi < 3) P = Pn; } }
    __syncthreads();
    const int hi5 = lane >> 5, r32 = lane & 31;
    const bf16x8* WG = (const bf16x8*)(C.ws + WS_WGLU) + (size_t)l * 1024 * 64 + lane;
    const float* bg = C.in[I_BGLU] + (size_t)l * 1024;
    float sq[2] = {0.f, 0.f}; v2u ost[2][4][2];
#pragma unroll
    for (int c = 0; c < 2; ++c) {
        const bf16x8* Wv = WG + (size_t)((2 * wave + c) * 32) * 64; const bf16x8* Wt = WG + (size_t)((16 + 2 * wave + c) * 32) * 64;
        f32x16 av[2], ag[2]; av[0] = f32x16{}; av[1] = f32x16{}; ag[0] = f32x16{}; ag[1] = f32x16{};
        bf16x8 rv[8], rg[8];
#pragma unroll
        for (int i = 0; i < 8; ++i) { rv[i] = Wv[(size_t)i * 64]; rg[i] = Wt[(size_t)i * 64]; }
#pragma unroll 1
        for (int k0 = 0; k0 < 32; k0 += 8) {
#pragma unroll
            for (int i = 0; i < 8; ++i) { const int kap = k0 + i;
                const bf16x8 b0 = *(const LAS bf16x8*)(GG + r32 * ROWP + (16 * kap + 8 * hi5) * 2), b1 = *(const LAS bf16x8*)(GG + (32 + r32) * ROWP + (16 * kap + 8 * hi5) * 2);
                av[0] = mfma32(rv[i], b0, av[0]); av[1] = mfma32(rv[i], b1, av[1]); ag[0] = mfma32(rg[i], b0, ag[0]); ag[1] = mfma32(rg[i], b1, ag[1]);
                if (kap + 8 < 32) { rv[i] = Wv[(size_t)(kap + 8) * 64]; rg[i] = Wt[(size_t)(kap + 8) * 64]; } } }
#pragma unroll
        for (int rr = 0; rr < 4; ++rr) { const int ch0 = 64 * wave + 32 * c + 8 * rr + 4 * hi5; const f32x4 bv = *(const f32x4*)(bg + ch0), bgt = *(const f32x4*)(bg + 512 + ch0);
#pragma unroll
            for (int tt = 0; tt < 2; ++tt) { float o[4];
#pragma unroll
                for (int e = 0; e < 4; ++e) { o[e] = (av[tt][4 * rr + e] + bv[e]) * sigm_f(ag[tt][4 * rr + e] + bgt[e]); sq[tt] += o[e] * o[e]; }
                ost[c][rr][tt].x = pk2(o[0], o[1]); ost[c][rr][tt].y = pk2(o[2], o[3]); } }
    }
    TailPre TP; tail_prefetch(C, row0, COL_ZS, TP);
#pragma unroll
    for (int tt = 0; tt < 2; ++tt) { const float t = xh_sum(sq[tt]); if (hi5 == 0) ssq[wave * 64 + 32 * tt + r32] = t; }
    __syncthreads();
#pragma unroll
    for (int c = 0; c < 2; ++c)
#pragma unroll
        for (int rr = 0; rr < 4; ++rr) { const int ch0 = 64 * wave + 32 * c + 8 * rr + 4 * hi5;
#pragma unroll
            for (int tt = 0; tt < 2; ++tt) *(LAS v2u*)(GG + (32 * tt + r32) * ROWP + ch0 * 2) = ost[c][rr][tt]; }
    __syncthreads();
    branch_tail(C, l, row0, GG, ssq, rstd_l, TP, 1024);
}

template <int W> DI void pool_diff(const Ctx& C, int l, bool samp, int b, int n, int row0, int gi, int th, int lane, LAS unsigned char* DF) {
    const int t0 = 32 * th + 8 * (lane >> 4), ch0 = 128 * gi + 8 * (lane & 15);
    const float* sp = C.in[I_SPOOL] + (size_t)(l * NBS + b) * 15 * 512;
    float x[W + 7][8];
#pragma unroll
    for (int i = 0; i < W + 7; ++i) { const int rel = t0 - (W - 1) + i;
        if (rel >= 0 || (!samp && n > 0)) unpack8(*(const v4u*)(C.PROJ + (size_t)(row0 + rel) * NIN + COL_UP + ch0), x[i]);
        else if (samp) { const float* s = sp + (size_t)(15 + rel) * 512 + ch0; const f32x4 a = *(const f32x4*)s, c4 = *(const f32x4*)(s + 4); x[i][0] = a.x; x[i][1] = a.y; x[i][2] = a.z; x[i][3] = a.w; x[i][4] = c4.x; x[i][5] = c4.y; x[i][6] = c4.z; x[i][7] = c4.w; }
        else {
#pragma unroll
            for (int e = 0; e < 8; ++e) x[i][e] = 0.f; } }
    const bool last = samp || n == 63;
    float* po = C.out + (samp ? O_PS + (size_t)(l * NBS + b) * 15 * 512 : O_PP + (size_t)(l * NBP + b) * 15 * 512);
#pragma unroll
    for (int tt = 0; tt < 8; ++tt) { const int t = t0 + tt, pos = 64 * n + t; float d[8];
        const float cnt = samp ? (float)W : (float)((pos + 1 < W) ? pos + 1 : W), ic = 1.f / cnt;
#pragma unroll
        for (int e = 0; e < 8; ++e) { float s = 0.f;
#pragma unroll
            for (int j = 0; j < W; ++j) s += x[tt + j][e];
            d[e] = s * ic - x[tt + W - 1][e]; }
        v4u o; o.x = pk2(d[0], d[1]); o.y = pk2(d[2], d[3]); o.z = pk2(d[4], d[5]); o.w = pk2(d[6], d[7]);
        *(LAS v4u*)(DF + t * ROWP + ch0 * 2) = o;
        if (last && t >= 49) { float* p = po + (size_t)(t - 49) * 512 + ch0; *(f32x4*)p = (f32x4){x[tt + W - 1][0], x[tt + W - 1][1], x[tt + W - 1][2], x[tt + W - 1][3]}; *(f32x4*)(p + 4) = (f32x4){x[tt + W - 1][4], x[tt + W - 1][5], x[tt + W - 1][6], x[tt + W - 1][7]}; } }
}
DI void pool_unit(const Ctx& C0, int l, int u) {
    Ctx C = C0; fresh(C);
    const int lane = C.lane, wave = C.wave; const bool samp = u >= 512;
    const int b = samp ? u - 512 : (u >> 6), n = samp ? 0 : (u & 63), row0 = samp ? MP + 64 * b : b * LP + 64 * n;
    LAS unsigned char* DF = C.lds; LAS float* ssq = (LAS float*)(C.lds + 64 * ROWP); LAS float* rstd_l = ssq + 512;
    { const int gi = wave >> 1, th = wave & 1;
      if (gi == 0) pool_diff<2>(C, l, samp, b, n, row0, 0, th, lane, DF); else if (gi == 1) pool_diff<4>(C, l, samp, b, n, row0, 1, th, lane, DF);
      else if (gi == 2) pool_diff<8>(C, l, samp, b, n, row0, 2, th, lane, DF); else pool_diff<16>(C, l, samp, b, n, row0, 3, th, lane, DF); }
    TailPre TP; tail_prefetch(C, row0, COL_ZP, TP);
    __syncthreads();
    const int hi5 = lane >> 5, r32 = lane & 31, gi = wave >> 1;
    f32x16 acc[2][2];
#pragma unroll
    for (int c = 0; c < 2; ++c) { acc[c][0] = f32x16{}; acc[c][1] = f32x16{}; }
    const bf16x8* WP = (const bf16x8*)(C.ws + WS_WPOOL) + (size_t)((l * 4 + gi) * 32) * 64 + lane;
#pragma unroll
    for (int kap = 0; kap < 8; ++kap) { bf16x8 af[2], bt[2];
#pragma unroll
        for (int c = 0; c < 2; ++c) af[c] = WP[(size_t)((2 * (wave & 1) + c) * 8 + kap) * 64];
#pragma unroll
        for (int tt = 0; tt < 2; ++tt) bt[tt] = *(const LAS bf16x8*)(DF + (32 * tt + r32) * ROWP + (128 * gi + 16 * kap + 8 * hi5) * 2);
#pragma unroll
        for (int c = 0; c < 2; ++c)
#pragma unroll
            for (int tt = 0; tt < 2; ++tt) acc[c][tt] = mfma32(af[c], bt[tt], acc[c][tt]); }
    const float* ps = C.in[I_PSCALE] + (size_t)l * 512;
    float sq[2] = {0.f, 0.f};
#pragma unroll
    for (int c = 0; c < 2; ++c)
#pragma unroll
        for (int rr = 0; rr < 4; ++rr) { const int d0 = 128 * gi + 32 * (2 * (wave & 1) + c) + 8 * rr + 4 * hi5; const f32x4 sc = *(const f32x4*)(ps + d0);
#pragma unroll
            for (int tt = 0; tt < 2; ++tt)
#pragma unroll
                for (int e = 0; e < 4; ++e) { const float o = acc[c][tt][4 * rr + e] * sc[e]; acc[c][tt][4 * rr + e] = o; sq[tt] += o * o; } }
#pragma unroll
    for (int tt = 0; tt < 2; ++tt) { const float t = xh_sum(sq[tt]); if (hi5 == 0) ssq[wave * 64 + 32 * tt + r32] = t; }
    __syncthreads();
#pragma unroll
    for (int c = 0; c < 2; ++c)
#pragma unroll
        for (int rr = 0; rr < 4; ++rr) { const int d0 = 128 * gi + 32 * (2 * (wave & 1) + c) + 8 * rr + 4 * hi5;
#pragma unroll
            for (int tt = 0; tt < 2; ++tt) { v2u o; o.x = pk2(acc[c][tt][4 * rr], acc[c][tt][4 * rr + 1]); o.y = pk2(acc[c][tt][4 * rr + 2], acc[c][tt][4 * rr + 3]);
                *(LAS v2u*)(DF + (32 * tt + r32) * ROWP + d0 * 2) = o; } }
    __syncthreads();
    branch_tail(C, l, row0, DF, ssq, rstd_l, TP, 1536);
}

constexpr int AT_STG = 65536, AT_TAB = 2 * AT_STG, AT_SSQ = AT_TAB + 2 * 4 * 384 * 4, AT_RSTD = AT_SSQ + 8 * 32 * 4, AT_FLAG = AT_RSTD + 256;
DI void attn_unit(const Ctx& C0, int l, int ucode) {
    Ctx C = C0; fresh(C);
    const int lane = C.lane, wave = C.wave, r32 = lane & 31, hi = lane >> 5, hd = wave >> 1, qh = wave & 1; const bool samp = (ucode >> 16) & 1;
    const int b = (ucode >> 8) & 255, n = samp ? 16 : (ucode & 255), rq0 = samp ? MP + 64 * b : b * LP + 64 * n;
    const int jstart = samp ? 0 : (n >= 8 ? 0 : 8 - n), nt = 9 - jstart, nsteps = 4 * nt;
    unsigned long long jseq = 0ull; { int cnt = 0; for (int k = 0; k < 9; ++k) { const int jj = samp ? k : (((k - (n - 8)) % 9) + 9) % 9; if (jj >= jstart) { jseq |= (unsigned long long)jj << (4 * cnt); ++cnt; } } }
    auto jof = [&](int ti) { return (int)((jseq >> (4 * ti)) & 15ull); };
    LAS unsigned char* KV = C.lds + hd * 16384;
    LAS float* TAB = (LAS float*)(C.lds + AT_TAB) + hd * 384;
    LAS float* ssq = (LAS float*)(C.lds + AT_SSQ); LAS float* rstd_l = (LAS float*)(C.lds + AT_RSTD); LAS volatile int* flag = (LAS volatile int*)(C.lds + AT_FLAG);
    if (C.tid < 8) flag[C.tid] = 0;
    __syncthreads();
    const float c1 = 0.125f * LOG2E;
    const int qi = 32 * qh + r32, sw = (r32 >> 1) & 7;
    auto issue = [&](int h, int j, auto STC) {
        constexpr int st = decltype(STC)::value;
        const char* src; unsigned pitchB;
        if (samp && j < 8) { src = (const char*)((qh ? C.VC : C.KC) + ((size_t)(l * NBS + b) * 512 + 64 * j) * 1024 + h * 64); pitchB = 2048u; }
        else { const size_t row = samp ? (size_t)rq0 : (size_t)(b * LP + 64 * (n - 8 + j)); src = (const char*)(C.PROJ + row * NIN + (qh ? COL_V : COL_K) + h * 64); pitchB = (unsigned)NIN * 2u; }
        LAS unsigned char* dst = KV + st * AT_STG + qh * 8192;
        if (qh == 0) { const unsigned rl = (unsigned)lane >> 3, cl = (unsigned)lane & 7u, sw0 = (rl >> 1) & 3u;
            const unsigned vo0 = rl * pitchB + ((cl ^ sw0) << 4), vo1 = rl * pitchB + ((cl ^ (sw0 | 4u)) << 4);
#pragma unroll
            for (int pc = 0; pc < 8; ++pc) __builtin_amdgcn_global_load_lds((const unsigned*)(src + (size_t)(8u * pc * pitchB) + ((pc & 1) ? vo1 : vo0)), (LAS unsigned*)(dst + pc * 1024), 16, 0, 0);
        } else { const unsigned vo = ((unsigned)lane >> 2) * pitchB + (((unsigned)lane & 3u) << 4);
#pragma unroll
            for (int pc = 0; pc < 8; ++pc) __builtin_amdgcn_global_load_lds((const unsigned*)(src + (size_t)(16u * (pc & 3) * pitchB + (pc >> 2) * 64u) + vo), (LAS unsigned*)(dst + pc * 1024), 16, 0, 0);
        }
    };
    float tv[3];
    auto tab_load = [&](int h) { const float* rb = C.in[I_RELB] + (size_t)(l * 16 + h) * 513;
#pragma unroll
        for (int k = 0; k < 3; ++k) { const int y = 192 * qh + lane + 64 * k; tv[k] = rb[y < 64 ? 512 : 576 - y]; } };
    auto tab_store = [&](int buf) {
#pragma unroll
        for (int k = 0; k < 3; ++k) TAB[buf * 1536 + 192 * qh + lane + 64 * k] = tv[k] * LOG2E; };
    bf16x8 qf[4], qn[4];
    auto q_load = [&](int h, bf16x8 (&q)[4]) { const bf16* qp = C.PROJ + (size_t)(rq0 + qi) * NIN + COL_Q + h * 64 + 8 * hi;
#pragma unroll
        for (int k = 0; k < 4; ++k) q[k] = ld8(qp + 16 * k); };
    tab_load(hd); tab_store(0); q_load(hd, qf); issue(hd, jof(0), std::integral_constant<int, 0>{});
    f32x16 O[2], negm, Lacc; float mref = 0.f, ssq_acc = 0.f;
    O[0] = f32x16{}; O[1] = f32x16{}; negm = f32x16{}; Lacc = f32x16{};
    const bf16x8 ones8 = {0x3F80, 0x3F80, 0x3F80, 0x3F80, 0x3F80, 0x3F80, 0x3F80, 0x3F80};
    int hg = 0, ti = 0;
    auto step = [&](int s, auto CURC) {
        constexpr int cur = decltype(CURC)::value;
        const int h = 4 * hg + hd, j = jof(ti);
        __builtin_amdgcn_s_waitcnt(0);
        if (lane == 0) flag[wave] = s + 1;
        while (__builtin_amdgcn_readfirstlane(flag[wave ^ 1]) < s + 1) { }
        asm volatile("" ::: "memory");
        if (s + 1 < nsteps) { if (ti + 1 < nt) issue(h, jof(ti + 1), std::integral_constant<int, (cur ^ 1)>{}); else issue(h + 4, jof(0), std::integral_constant<int, (cur ^ 1)>{}); }
        const bool lastt = (ti == nt - 1), more = lastt && hg < 3;
        if (more) { tab_load(h + 4); q_load(h + 4, qn); }
        LAS const unsigned char* Kst = KV + cur * AT_STG; LAS const unsigned char* Vst = Kst + 8192; LAS const float* T = TAB + (hg & 1) * 1536;
        f32x16 S[2];
        { bf16x8 kf[2][4];
          const unsigned ka = (unsigned)(uintptr_t)(Kst + r32 * 128);
#pragma unroll
          for (int k = 0; k < 4; ++k) { const unsigned ko = ka + (unsigned)(((2 * k + hi) ^ sw) << 4);
              asm volatile("ds_read_b128 %0, %1" : "=v"(kf[0][k]) : "v"(ko));
              asm volatile("ds_read_b128 %0, %1 offset:4096" : "=v"(kf[1][k]) : "v"(ko)); }
          asm volatile("s_waitcnt lgkmcnt(0)" : "+v"(kf[0][0]), "+v"(kf[0][1]), "+v"(kf[0][2]), "+v"(kf[0][3]), "+v"(kf[1][0]), "+v"(kf[1][1]), "+v"(kf[1][2]), "+v"(kf[1][3]));
#pragma unroll
          for (int k = 0; k < 4; ++k) { S[0] = mfma32(kf[0][k], qf[k], k == 0 ? negm : S[0]); S[1] = mfma32(kf[1][k], qf[k], k == 0 ? negm : S[1]); } }
        float mx = -1e30f;
        if (j <= 3) { const float bconst = T[0];
#pragma unroll
            for (int kb = 0; kb < 2; ++kb)
#pragma unroll
                for (int r = 0; r < 16; ++r) { const float sv = S[kb][r] * c1 + bconst; S[kb][r] = sv; mx = fmaxf(mx, sv); }
        } else { const int ybase = 320 - 64 * (8 - j) - qi + 4 * hi;
#pragma unroll
            for (int kb = 0; kb < 2; ++kb)
#pragma unroll
                for (int r = 0; r < 16; ++r) { const float sv = S[kb][r] * c1 + T[ybase + 32 * kb + 8 * (r >> 2) + (r & 3)]; S[kb][r] = sv; mx = fmaxf(mx, sv); }
        }
        mx = xh_max(mx);
        if (__any(fabsf(mx) > 8.0f)) {
            mref += mx;
#pragma unroll
            for (int kb = 0; kb < 2; ++kb)
#pragma unroll
                for (int r = 0; r < 16; ++r) S[kb][r] -= mx;
            const float f = ex2(-mx), nm = -mref * (1.0f / c1);
#pragma unroll
            for (int r = 0; r < 16; ++r) { negm[r] = nm; O[0][r] *= f; O[1][r] *= f; Lacc[r] *= f; }
        }
#pragma unroll
        for (int kb = 0; kb < 2; ++kb)
#pragma unroll
            for (int r = 0; r < 16; ++r) S[kb][r] = ex2(S[kb][r]);
        bf16x8 pf[4];
#pragma unroll
        for (int ks = 0; ks < 4; ++ks) { const int kb = ks >> 1, s8 = 8 * (ks & 1); v4u w;
            w.x = pk2(S[kb][s8], S[kb][s8 + 1]); w.y = pk2(S[kb][s8 + 2], S[kb][s8 + 3]); w.z = pk2(S[kb][s8 + 4], S[kb][s8 + 5]); w.w = pk2(S[kb][s8 + 6], S[kb][s8 + 7]);
            pf[ks] = __builtin_bit_cast(bf16x8, w); }
#pragma unroll
        for (int ks = 0; ks < 4; ++ks) Lacc = mfma32(ones8, pf[ks], Lacc);
        LAS const unsigned char* vb = Vst + (4 * hi + ((lane & 15) >> 2)) * 64 + ((lane >> 4) & 1) * 32 + (lane & 3) * 8;
        const unsigned vba = (unsigned)(uintptr_t)vb;
#pragma unroll
        for (int kh = 0; kh < 2; ++kh) { s16x4 lo[2][2], up[2][2];
#pragma unroll
            for (int k2 = 0; k2 < 2; ++k2)
#pragma unroll
                for (int db = 0; db < 2; ++db) { const int ks = 2 * kh + k2;
                    asm volatile("ds_read_b64_tr_b16 %0, %1 offset:%2" : "=v"(lo[k2][db]) : "v"(vba), "i"(db * 4096 + ks * 1024));
                    asm volatile("ds_read_b64_tr_b16 %0, %1 offset:%2" : "=v"(up[k2][db]) : "v"(vba), "i"(db * 4096 + ks * 1024 + 512)); }
            asm volatile("s_waitcnt lgkmcnt(0)" : "+v"(lo[0][0]), "+v"(lo[0][1]), "+v"(lo[1][0]), "+v"(lo[1][1]), "+v"(up[0][0]), "+v"(up[0][1]), "+v"(up[1][0]), "+v"(up[1][1]));
#pragma unroll
            for (int k2 = 0; k2 < 2; ++k2)
#pragma unroll
                for (int db = 0; db < 2; ++db) { const bf16x8 vf = {lo[k2][db][0], lo[k2][db][1], lo[k2][db][2], lo[k2][db][3], up[k2][db][0], up[k2][db][1], up[k2][db][2], up[k2][db][3]};
                    O[db] = mfma32(vf, pf[2 * kh + k2], O[db]); } }
        if (lastt) {
            const float inv = 1.f / Lacc[0]; float sq = 0.f;
            bf16* yp = C.HY + (size_t)(rq0 + qi) * DM + h * 64 + 4 * hi;
#pragma unroll
            for (int db = 0; db < 2; ++db)
#pragma unroll
                for (int rr = 0; rr < 4; ++rr) { float o[4];
#pragma unroll
                    for (int e = 0; e < 4; ++e) { o[e] = O[db][4 * rr + e] * inv; sq += o[e] * o[e]; }
                    v2u w; w.x = pk2(o[0], o[1]); w.y = pk2(o[2], o[3]); *(v2u*)(yp + 32 * db + 8 * rr) = w; }
            ssq_acc += xh_sum(sq);
            O[0] = f32x16{}; O[1] = f32x16{}; negm = f32x16{}; Lacc = f32x16{}; mref = 0.f;
            if (more) { tab_store((hg + 1) & 1);
#pragma unroll
                for (int k = 0; k < 4; ++k) qf[k] = qn[k]; }
            ++hg; ti = 0;
        } else ++ti;
    };
    for (int s = 0; s < nsteps; s += 2) { step(s, std::integral_constant<int, 0>{}); step(s + 1, std::integral_constant<int, 1>{}); }
    if (hi == 0) ssq[wave * 32 + r32] = ssq_acc;
    asm volatile("s_waitcnt vmcnt(0)" ::: "memory");
    __syncthreads();
    if (C.tid < 64) { const int q2 = C.tid >> 5, rr = C.tid & 31; float t = 0.f;
#pragma unroll
        for (int w = 0; w < 4; ++w) t += ssq[(2 * w + q2) * 32 + rr];
        rstd_l[C.tid] = rsqrtf(t * (1.f / 1024.f) + EPSN); }
    __syncthreads();
    const float* gb = C.in[I_BNG] + (size_t)l * DM;
    const f32x4 g0 = *(const f32x4*)(gb + (C.tid & 127) * 8), g1 = *(const f32x4*)(gb + (C.tid & 127) * 8 + 4);
#pragma unroll 2
    for (int it = 0; it < 16; ++it) { const int idx = C.tid + 512 * it, row = idx >> 7, ch = idx & 127;
        bf16* yp = C.HY + (size_t)(rq0 + row) * DM + ch * 8;
        const v4u raw = *(const v4u*)yp; const v4u zz = *(const v4u*)(C.PROJ + (size_t)(rq0 + row) * NIN + COL_ZA + ch * 8);
        float r[8], z[8]; unpack8(raw, r); unpack8(zz, z); const float rs = rstd_l[row];
        const float gg[8] = {g0.x, g0.y, g0.z, g0.w, g1.x, g1.y, g1.z, g1.w}; float o[8];
#pragma unroll
        for (int e = 0; e < 8; ++e) o[e] = r[e] * rs * gg[e] * silu_f(z[e]);
        v4u w; w.x = pk2(o[0], o[1]); w.y = pk2(o[2], o[3]); w.z = pk2(o[4], o[5]); w.w = pk2(o[6], o[7]);
        *(v4u*)yp = w; }
    __syncthreads();
}

DI int q_issue(const Ctx& C0, unsigned* ctr) {
    Ctx C = C0; fresh(C);
    int v = 0; if (C.tid == 0) v = (int)__hip_atomic_fetch_add(ctr, 1u, __ATOMIC_RELAXED, __HIP_MEMORY_SCOPE_AGENT);
    return v;
}
DI int q_bcast(const Ctx& C0, int v) {
    Ctx C = C0; fresh(C);
    LAS volatile int* slot = (LAS volatile int*)(C.lds + MISC_OFF + 32);
    if (C.tid == 0) *slot = v;
    __syncthreads();
    const int r = *slot;
    __syncthreads();
    return r;
}
DI int attn_code(unsigned xx, unsigned v) { return (v < 64u) ? (int)((xx << 8) | (63u - v)) : (int)((1u << 16) | ((4u * xx + (v - 64u)) << 8)); }
DI int q_issue_attn(const Ctx& C0, unsigned* ctr8) {
    Ctx C = C0; fresh(C);
    int v = 0; if (C.tid == 0) v = (int)__hip_atomic_fetch_add(ctr8 + 64 * (xb_xcc_id() & 7u), 1u, __ATOMIC_RELAXED, __HIP_MEMORY_SCOPE_AGENT);
    return v;
}
DI int q_bcast_attn(const Ctx& C0, unsigned* ctr8, int v) {
    Ctx C = C0; fresh(C);
    LAS volatile int* slot = (LAS volatile int*)(C.lds + MISC_OFF + 32);
    if (C.tid == 0) { const unsigned x = xb_xcc_id() & 7u; int code = -1;
        if ((unsigned)v < 68u) code = attn_code(x, (unsigned)v);
        else for (unsigned k = 1; k < 8; ++k) { const unsigned xx = (x + k) & 7u; const unsigned w = __hip_atomic_fetch_add(ctr8 + 64 * xx, 1u, __ATOMIC_RELAXED, __HIP_MEMORY_SCOPE_AGENT);
            if (w < 68u) { code = attn_code(xx, w); break; } }
        *slot = code; }
    __syncthreads();
    const int r = *slot;
    __syncthreads();
    return r;
}
__global__ void __launch_bounds__(512, 2) hymba_fwd(Args args) {
    extern __shared__ __attribute__((aligned(16))) unsigned char lds_raw[];
    Ctx C; C.in = args.in; C.out = args.out; C.ws = args.ws; C.lds = (LAS unsigned char*)lds_raw;
    C.tid = threadIdx.x; C.lane = C.tid & 63; C.wave = __builtin_amdgcn_readfirstlane(C.tid >> 6); C.G = gridDim.x; C.bid = blockIdx.x;
    C.HY = (bf16*)(args.ws + WS_HY); C.HB = (bf16*)(args.ws + WS_HB); C.PROJ = (bf16*)(args.ws + WS_PROJ); C.KC = (bf16*)(args.ws + WS_KC); C.VC = (bf16*)(args.ws + WS_VC);
    C.WIN = (bf16*)(args.ws + WS_WIN); C.WOUT = (bf16*)(args.ws + WS_WOUT); C.MOD = (float*)(args.ws + WS_MOD); C.SSQ = (float*)(args.ws + WS_SSQ); C.SB = (float*)(args.ws + WS_SB); C.GS = (float*)(args.ws + WS_GS); C.ctl = (unsigned*)(args.ws + WS_CTL);
    if (C.tid < 16) ((LAS unsigned*)(C.lds + MISC_OFF))[C.tid] = 0u;
    __syncthreads();
    const int lo = args.ph_lo, hi = args.ph_hi;
    const bool multi = (hi - lo) > 1;
    XcdBarrier bar; bar.bar = C.ctl + CW_BAR; bar.x = 0; bar.st = nullptr;
    if (multi) bar = xcd_barrier_post(C.ctl + CW_BAR, (volatile LAS unsigned*)(C.lds + MISC_OFF));
#define IN(k) (lo <= (k) && (k) < hi)
#define SEAM(k) do { if (IN(k) && IN((k) + 1)) xcd_barrier(bar); } while (0)
    int ph = 0;
#define TP_B(k) do { if (TPROBE == (k) && blockIdx.x == 0 && threadIdx.x == 0) *(LAS volatile unsigned long long*)(C.lds + MISC_OFF + 40) = __builtin_amdgcn_s_memrealtime(); } while (0)
#define TP_E(k) do { if (TPROBE == (k) && blockIdx.x == 0 && threadIdx.x == 0) *(LAS volatile unsigned long long*)(C.lds + MISC_OFF + 48) += __builtin_amdgcn_s_memrealtime() - *(LAS volatile unsigned long long*)(C.lds + MISC_OFF + 40); } while (0)
#ifndef PHM
#define PHM 0xff
#endif
    TP_B(1); if ((PHM & 1) && IN(ph)) { p0_prologue(C, true); if (REP & 16) p0_prologue(C, false); }
    SEAM(ph); ++ph; TP_E(1);
    TP_B(2); if ((PHM & 2) && IN(ph)) p0b_phase(C);
    SEAM(ph); ++ph; TP_E(2);
    for (int l = 0; l < DEPTH; ++l) {
        TP_B(3); if ((PHM & 4) && IN(ph)) {
            pg8::Gemm g{C.HB, C.WIN + (size_t)l * NIN * DM, MT, NIN, DM}; pg8::G1Order S; S.init(MT, NIN, C.G, C.bid, (l > 0 && C.G == 256) ? 1 : 0, nullptr);
            pg8::EpiProj E{C.PROJ, C.out + O_KP + (size_t)l * NBP * 512 * 1024, C.out + O_VP + (size_t)l * NBP * 512 * 1024, C.out + O_KS + (size_t)l * NBS * 64 * 1024, C.out + O_VS + (size_t)l * NBS * 64 * 1024,
                           C.SSQ + (size_t)l * MT, C.SB + (size_t)l * 40 * NIN};
            pg8::gemm_phase<pg8::EpiProj, pg8::G1Order, true, true>(C.lds, g, S, E);
        }
        SEAM(ph); ++ph; TP_E(3); TP_B(4);
        if ((PHM & 8) && IN(ph)) { for (int u = C.bid; u < 512; u += C.G) ssm_local_unit(C, l, u); }
        SEAM(ph); ++ph;
        if ((PHM & 8) && IN(ph)) ssm_carry_phase(C, l);
        SEAM(ph); ++ph; TP_E(4); TP_B(5);
        if ((PHM & 0x70) && IN(ph)) {
            unsigned* ctr = C.ctl + CW_Q + 64 * 16 * l;
            TP_B(8); if (PHM & 0x10) { int tk = q_issue_attn(C, ctr); for (;;) { const int u = q_bcast_attn(C, ctr, tk); if (u < 0) break; tk = q_issue_attn(C, ctr); attn_unit(C, l, u); } } TP_E(8);
            TP_B(9); if (PHM & 0x20) { int tk = q_issue(C, ctr + 64 * 8); for (;;) { const int u = q_bcast(C, tk); if (u >= 544) break; tk = q_issue(C, ctr + 64 * 8); ssm_main_unit(C, l, u); } } TP_E(9);
            TP_B(10); if (PHM & 0x40) { int tk = q_issue(C, ctr + 64 * 9); for (;;) { const int u = q_bcast(C, tk); if (u >= 544) break; tk = q_issue(C, ctr + 64 * 9); pool_unit(C, l, u); } } TP_E(10);
        }
        SEAM(ph); ++ph; TP_E(5); TP_B(6);
        if ((PHM & 0x80) && IN(ph)) {
            unsigned* rbsig = C.ctl + CW_RB + 64 * l;
            pg8::Gemm g{C.HY, C.WOUT + (size_t)l * DM * DM, MT, DM, DM}; pg8::G2Order S; S.init(MT, DM, C.G, C.bid); S.sig = (l + 1 < DEPTH && C.G == 256) ? rbsig : nullptr;
            pg8::EpiRes E{l == 0 ? C.in[I_XP] : C.out, l == 0 ? C.in[I_XS] : C.out + (size_t)MP * DM, C.out, C.MOD + (size_t)l * 40 * NIN + 2 * DM,
                          (l + 1 < DEPTH) ? C.GS + (size_t)(l + 1) * 40 * DM : nullptr, C.HB, C.SSQ + (size_t)(l + 1) * MT};
            pg8::gemm_phase<pg8::EpiRes, pg8::G2Order, true, true>(C.lds, g, S, E);
            if (l + 1 < DEPTH && C.bid >= 64) {
                __syncthreads();
                if (C.G == 256) { pg8::Gemm g1{C.HB, C.WIN + (size_t)(l + 1) * NIN * DM, MT, NIN, DM}; pg8::G1Order S1; S1.init(MT, NIN, C.G, C.bid, 2, rbsig);
                  pg8::EpiProj E1{C.PROJ, C.out + O_KP + (size_t)(l + 1) * NBP * 512 * 1024, C.out + O_VP + (size_t)(l + 1) * NBP * 512 * 1024, C.out + O_KS + (size_t)(l + 1) * NBS * 64 * 1024, C.out + O_VS + (size_t)(l + 1) * NBS * 64 * 1024,
                                  C.SSQ + (size_t)(l + 1) * MT, C.SB + (size_t)(l + 1) * 40 * NIN};
                  pg8::gemm_phase<pg8::EpiProj, pg8::G1Order, true, true>(C.lds, g1, S1, E1); }
                __syncthreads();
                for (int it = C.bid - 64; it < 256; it += C.G - 64) cache_item(C, l + 1, it); }
        }
        SEAM(ph); ++ph; TP_E(6);
    }
    TP_B(7); TP_B(11); if ((PHM & 2) && IN(ph)) final_norm_phase(C); TP_E(7);
    if (TPROBE == 11) { xcd_barrier(bar); TP_E(11); }
    if (TPROBE && blockIdx.x == 0 && threadIdx.x == 0) { const unsigned long long d = *(LAS volatile unsigned long long*)(C.lds + MISC_OFF + 48), t0 = __builtin_amdgcn_s_memrealtime();
        while (__builtin_amdgcn_s_memrealtime() - t0 < d) __builtin_amdgcn_s_sleep(8); }
#undef IN
#undef SEAM
}

#ifndef N_LAUNCH_MODE
#define N_LAUNCH_MODE 1
#endif
extern "C" void kernel_launch(void* const* d_in, const int* in_sizes, int n_in, void* d_out, int out_size, void* d_ws, size_t ws_size, hipStream_t stream) {
    static int grid = 0;
    if (grid == 0) {
        if (n_in != N_IN || (size_t)out_size != O_END || ws_size < WS_END) { fprintf(stderr, "kernel_launch: unexpected sizes n_in %d out %d ws %zu (need %zu)\n", n_in, out_size, ws_size, (size_t)WS_END); grid = -1; return; }
        int dev = 0, cus = 0, per_cu = 0;
        if (hipGetDevice(&dev) != hipSuccess || hipDeviceGetAttribute(&cus, hipDeviceAttributeMultiprocessorCount, dev) != hipSuccess) { grid = -1; return; }
        if (hipFuncSetAttribute((const void*)hymba_fwd, hipFuncAttributeMaxDynamicSharedMemorySize, LDS_BYTES) != hipSuccess) { fprintf(stderr, "kernel_launch: hipFuncSetAttribute failed\n"); grid = -1; return; }
        if (hipOccupancyMaxActiveBlocksPerMultiprocessor(&per_cu, (const void*)hymba_fwd, 512, LDS_BYTES) != hipSuccess || per_cu < 1) fprintf(stderr, "kernel_launch: occupancy query says %d\n", per_cu);
        (void)hipGetLastError();
        grid = cus;
    }
    if (grid < 0) return;
    (void)in_sizes;
    if (hipMemsetAsync((char*)d_ws + WS_CTL, 0, ZERO_BYTES, stream) != hipSuccess) return;
    Args a{};
    for (int i = 0; i < N_IN; ++i) a.in[i] = (const float*)d_in[i];
    a.out = (float*)d_out; a.ws = (unsigned char*)d_ws;
#if N_LAUNCH_MODE == 1
    a.ph_lo = 0; a.ph_hi = NPH;
    hipLaunchKernelGGL(hymba_fwd, dim3(grid), dim3(512), LDS_BYTES, stream, a);
#else
    for (int p = 0; p < NPH; ++p) { a.ph_lo = p; a.ph_hi = p + 1; hipLaunchKernelGGL(hymba_fwd, dim3(grid), dim3(512), LDS_BYTES, stream, a); }
#endif
}
```

```cpp
#include <hip/hip_runtime.h>
#include <cstdio>
#include <cstdint>
#include <type_traits>
namespace pg8 {
#define PG8_LAS __attribute__((address_space(3)))
typedef unsigned short bf16_t;
typedef short bf16x8 __attribute__((ext_vector_type(8)));
typedef float f32x4 __attribute__((ext_vector_type(4)));
typedef unsigned u32x4 __attribute__((ext_vector_type(4)));
constexpr int BM = 256, BK = 64, HALF = 128, HTB = HALF * BK * 2  , STAGE_BYTES = 8 * HTB, NXCD = 8, WGM = 8;

__host__ __device__ __forceinline__ int lds_byte(int r, int c) { const int st = (r >> 4) * 2 + (c >> 5), rr = r & 15, cc = c & 31, ob = rr * 64 + cc * 2; return st * 1024 + (ob ^ (((ob >> 9) & 1) << 5)); }
__host__ __device__ __forceinline__ void stage_rc(int b, int& R, int& C) { const int st = b / 1024, sb = b % 1024, swz = sb ^ (((sb >> 9) & 1) << 5); R = (st >> 1) * 16 + swz / 64; C = (st & 1) * 32 + (swz % 64) / 2; }
__host__ __device__ __forceinline__ int perm32(int rho) { const int n = rho >> 4, i = rho & 15; return 8 * (i >> 2) + 4 * n + (i & 3); }

struct Unit { int pm, pn; };
struct Gemm { const bf16_t* A; const bf16_t* Bt; int M, N, K; };

struct StaticOrder {
    int nM, nN, nwg, G, c;
    __host__ __device__ void init(int M, int N, int G_, int c_) { nM = M / BM; nN = N / BM; nwg = nM * nN; G = G_; c = c_; }
    __host__ __device__ bool next(int i, Unit& u) const {
        const long L = (long)i * G + c; if (L >= nwg) return false;
        int wgid = (int)L; { const int q = nwg / NXCD, r = nwg % NXCD, xcd = wgid % NXCD, off = wgid / NXCD; wgid = (xcd < r ? xcd * (q + 1) : r * (q + 1) + (xcd - r) * q) + off; }
        const int nig = WGM * nN, gid = wgid / nig, fm = gid * WGM, gsz = (nM - fm) < WGM ? (nM - fm) : WGM;
        u.pm = fm + ((wgid % nig) % gsz); u.pn = (wgid % nig) / gsz; return true;
    }
    __device__ __forceinline__ void a_ready(const Unit&) const {}
    __device__ __forceinline__ void done(const Unit&) const {}
};

__device__ __forceinline__ unsigned cvt_pk_bf16(float lo, float hi) { unsigned r; asm volatile("v_cvt_pk_bf16_f32 %0, %1, %2" : "=v"(r) : "v"(lo), "v"(hi)); return r; }
typedef float f32x2 __attribute__((ext_vector_type(2)));
struct EpiProj {
    static constexpr bool PERM = true, AFTER_DRAIN = false;
    bf16_t* O; float* kp; float* vp; float* ks; float* vs; const float* ssq; const float* sb;
    __device__ __forceinline__ void operator()(const f32x4 (&acc)[2][2][4][2], const Unit& u, int wr, int wc, int fr, int fq) const {
        const int lrow0 = wr * 64 + fr, col0 = u.pn * BM + wc * 32 + 8 * fq;
#if defined(TPROBE) && TPROBE == 15
        if (blockIdx.x == 0 && threadIdx.x == 0) *(volatile PG8_LAS unsigned long long*)(147456 - 64 + 40) = __builtin_amdgcn_s_memrealtime();
#endif
        float* fo = nullptr;
        const bool isk = (u.pn >= 4 && u.pn < 8), isv = (u.pn >= 8 && u.pn < 12);
        if (isk || isv) {
            if (u.pm >= 128) fo = (isk ? ks : vs) + (size_t)(u.pm - 128) * 256 * 1024;
            else if ((u.pm & 15) >= 14) fo = (isk ? kp : vp) + ((size_t)(u.pm >> 4) * 512 + (size_t)((u.pm & 15) - 14) * 256) * 1024;
        }
        const int fcol0 = (u.pn & 3) * 256 + wc * 32 + 8 * fq;
#pragma unroll
        for (int ai = 0; ai < 2; ++ai) {
            const int brow = (u.pm < 128) ? (u.pm >> 4) : (8 + (u.pm - 128) * 4 + 2 * ai + wr);
            const float* sbp = sb + (size_t)brow * 6144 + col0;
            const f32x4 s00 = *(const f32x4*)sbp, s01 = *(const f32x4*)(sbp + 4), s10 = *(const f32x4*)(sbp + HALF), s11 = *(const f32x4*)(sbp + HALF + 4);
#pragma unroll
            for (int m = 0; m < 4; ++m) { const int lr = lrow0 + ai * HALF + m * 16; const int row = u.pm * BM + lr; bf16_t* rowp = O + (size_t)row * 6144 + col0;
                const float rs = rsqrtf(ssq[row] * (1.0f / 2048.0f) + 1e-6f);
                { const f32x4 v0 = acc[ai][0][m][0] * rs + s00, v1 = acc[ai][0][m][1] * rs + s01;
                  u32x4 w; w.x = cvt_pk_bf16(v0[0], v0[1]); w.y = cvt_pk_bf16(v0[2], v0[3]); w.z = cvt_pk_bf16(v1[0], v1[1]); w.w = cvt_pk_bf16(v1[2], v1[3]); *(u32x4*)rowp = w;
                  if (fo) { float* fp = fo + (size_t)lr * 1024 + fcol0; *(f32x4*)fp = v0; *(f32x4*)(fp + 4) = v1; } }
                { const f32x4 v0 = acc[ai][1][m][0] * rs + s10, v1 = acc[ai][1][m][1] * rs + s11;
                  u32x4 w; w.x = cvt_pk_bf16(v0[0], v0[1]); w.y = cvt_pk_bf16(v0[2], v0[3]); w.z = cvt_pk_bf16(v1[0], v1[1]); w.w = cvt_pk_bf16(v1[2], v1[3]); *(u32x4*)(rowp + HALF) = w;
                  if (fo) { float* fp = fo + (size_t)lr * 1024 + fcol0 + HALF; *(f32x4*)fp = v0; *(f32x4*)(fp + 4) = v1; } } }
        }
#if defined(TPROBE) && TPROBE == 15
        if (blockIdx.x == 0 && threadIdx.x == 0) { asm volatile("s_waitcnt vmcnt(0)" ::: "memory"); *(volatile PG8_LAS unsigned long long*)(147456 - 64 + 48) += __builtin_amdgcn_s_memrealtime() - *(volatile PG8_LAS unsigned long long*)(147456 - 64 + 40); }
#endif
    }
};
struct EpiRes {
    static constexpr bool PERM = false, AFTER_DRAIN = false;
    const float* xin_p; const float* xin_s; float* xout; const float* gate; const float* gs; bf16_t* hout; float* ssqn;
    __device__ __forceinline__ void operator()(const f32x4 (&acc)[2][2][4][2], const Unit& u, int wr, int wc, int fr, int fq) const {
        typedef unsigned u32x2 __attribute__((ext_vector_type(2)));
#if defined(TPROBE) && TPROBE == 14
        if (blockIdx.x == 0 && threadIdx.x == 0) *(volatile PG8_LAS unsigned long long*)(147456 - 64 + 40) = __builtin_amdgcn_s_memrealtime();
#endif
        const int col0 = u.pn * BM + wc * 32 + 4 * fq;
        const int r0 = u.pm * BM + wr * 64 + fr;
        const float* xbase = (u.pm < 128) ? (xin_p + (size_t)r0 * 2048 + col0) : (xin_s + (size_t)(r0 - 32768) * 2048 + col0);
        f32x4 xr[3][2][2];
#define EPR_LOAD(i) do { const int _ro = ((i) >> 2) * HALF + ((i) & 3) * 16; _Pragma("unroll") for (int bj = 0; bj < 2; ++bj) _Pragma("unroll") for (int n = 0; n < 2; ++n) xr[(i) % 3][bj][n] = *(const f32x4*)(xbase + (size_t)_ro * 2048 + bj * HALF + n * 16); } while (0)
        EPR_LOAD(0); EPR_LOAD(1);
#pragma unroll
        for (int ai = 0; ai < 2; ++ai) {
            const int brow = (u.pm < 128) ? (u.pm >> 4) : (8 + (u.pm - 128) * 4 + 2 * ai + wr);
            f32x4 gv[2][2], gsv[2][2];
#pragma unroll
            for (int bj = 0; bj < 2; ++bj)
#pragma unroll
                for (int n = 0; n < 2; ++n) { gv[bj][n] = *(const f32x4*)(gate + (size_t)brow * 6144 + col0 + bj * HALF + n * 16);
                    gsv[bj][n] = gs ? *(const f32x4*)(gs + (size_t)brow * 2048 + col0 + bj * HALF + n * 16) : (f32x4){0.f, 0.f, 0.f, 0.f}; }
#pragma unroll
            for (int m = 0; m < 4; ++m) { const int i = ai * 4 + m, roff = ai * HALF + m * 16, r = r0 + roff;
                if (i + 2 < 8) EPR_LOAD(i + 2);
                float* xo = xout + (size_t)r * 2048 + col0; bf16_t* ho = hout + (size_t)r * 2048 + col0;
                float part = 0.f;
#pragma unroll
                for (int bj = 0; bj < 2; ++bj)
#pragma unroll
                    for (int n = 0; n < 2; ++n) { const int c = bj * HALF + n * 16; const f32x4 xn = xr[i % 3][bj][n] + gv[bj][n] * acc[ai][bj][m][n];
                        *(f32x4*)(xo + c) = xn; part += (xn[0] * xn[0] + xn[1] * xn[1]) + (xn[2] * xn[2] + xn[3] * xn[3]);
                        if (gs) { const f32x4 h = xn * gsv[bj][n]; u32x2 w; w.x = cvt_pk_bf16(h[0], h[1]); w.y = cvt_pk_bf16(h[2], h[3]); *(u32x2*)(ho + c) = w; } }
                { auto r16 = __builtin_amdgcn_permlane16_swap(__float_as_uint(part), __float_as_uint(part), false, false); part = __uint_as_float(r16[0]) + __uint_as_float(r16[1]);
                  auto r32 = __builtin_amdgcn_permlane32_swap(__float_as_uint(part), __float_as_uint(part), false, false); part = __uint_as_float(r32[0]) + __uint_as_float(r32[1]); }
                if (fq == 0) unsafeAtomicAdd(ssqn + r, part);
                asm volatile("" ::: "memory"); }
        }
#undef EPR_LOAD
#if defined(TPROBE) && TPROBE == 14
        if (blockIdx.x == 0 && threadIdx.x == 0) { asm volatile("s_waitcnt vmcnt(0)" ::: "memory"); *(volatile PG8_LAS unsigned long long*)(147456 - 64 + 48) += __builtin_amdgcn_s_memrealtime() - *(volatile PG8_LAS unsigned long long*)(147456 - 64 + 40); }
#endif
    }
};

struct G2Order : StaticOrder {
    unsigned* sig; bool late; mutable int hits;
    __device__ __forceinline__ void done(const Unit& u) const {
        if (sig && u.pm < 8) {
            if (late) ++hits;
            else { asm volatile("s_waitcnt vmcnt(0)" ::: "memory"); __syncthreads();
                if (threadIdx.x == 0) { __builtin_amdgcn_fence(__ATOMIC_RELEASE, "agent"); asm volatile("s_waitcnt vmcnt(0)" ::: "memory"); __hip_atomic_fetch_add(sig, 1u, __ATOMIC_RELAXED, __HIP_MEMORY_SCOPE_AGENT); } } }
    }
    __device__ __forceinline__ void flush() const {
        if (sig && late && hits > 0) { asm volatile("s_waitcnt vmcnt(0)" ::: "memory"); __syncthreads();
            if (threadIdx.x == 0) { __builtin_amdgcn_fence(__ATOMIC_RELEASE, "agent"); asm volatile("s_waitcnt vmcnt(0)" ::: "memory"); __hip_atomic_fetch_add(sig, (unsigned)hits, __ATOMIC_RELAXED, __HIP_MEMORY_SCOPE_AGENT); } }
    }
};
struct G1Order {
    StaticOrder so; int mode; const unsigned* sig;
    __device__ void init(int M, int N, int G_, int c_, int mode_, const unsigned* sig_) { mode = mode_; sig = sig_; so.init(mode_ == 1 ? M - 8 * BM : M, N, G_, c_); }
    __device__ bool next(int i, Unit& u) const {
        if (mode == 2) { if (i > 0) return false; const int e = so.c - 64, x = e & 7, t = e >> 3; u.pn = 3 * x + t % 3; u.pm = t / 3; return true; }
        if (!so.next(i, u)) return false;
        if (mode == 1) u.pm += 8;
        return true;
    }
    __device__ __forceinline__ void a_ready(const Unit&) const {
        if (mode == 2) { if (threadIdx.x == 0) { while (__hip_atomic_load(sig, __ATOMIC_RELAXED, __HIP_MEMORY_SCOPE_AGENT) < 64u) __builtin_amdgcn_s_sleep(8);
                __builtin_amdgcn_fence(__ATOMIC_ACQUIRE, "agent"); asm volatile("s_waitcnt vmcnt(0)" ::: "memory"); }
            __syncthreads(); }
    }
    __device__ __forceinline__ void done(const Unit&) const {}
};
template <class Epi, class Sched, bool ALIGN_EPI = false, bool SP2 = false>
__device__ __forceinline__ void gemm_phase(PG8_LAS unsigned char* lds, const Gemm g, const Sched& S, const Epi& E) {
    int tid_ = threadIdx.x; asm volatile("" : "+v"(tid_));
    const int tid = tid_, wid = __builtin_amdgcn_readfirstlane(tid >> 6), lane = tid & 63, wr = wid >> 2, wc = wid & 3, fr = lane & 15, fq = lane >> 4;
    const int K = g.K, nt = K / BK;
    unsigned voffA[2], voffB[2];
#pragma unroll
    for (int i = 0; i < 2; ++i) { int R, C; stage_rc(tid * 16 + i * 8192, R, C); const int Rb = Epi::PERM ? ((R & ~31) + perm32(R & 31)) : R;
        voffA[i] = (unsigned)(R * K + C) * 2u; voffB[i] = (unsigned)(Rb * K + C) * 2u; }
    const size_t kstep = (size_t)(BK * 2);
    const size_t hstep = (size_t)HALF * K * 2;
    const size_t tstep = 2 * hstep;
    const unsigned ldsw = (unsigned)wid * 1024u;
    const int aoff = lds_byte(wr * 64 + fr, fq * 8), boff = lds_byte(wc * 32 + fr, fq * 8);
#define PG8_SA(b, h) (((b) * 2 + (h)) * HTB)
#define PG8_SB(b, h) ((4 + (b) * 2 + (h)) * HTB)
#define PG8_STAGE(bufoff, gbase, voff) do { _Pragma("unroll") for (int _i = 0; _i < 2; ++_i) \
        __builtin_amdgcn_global_load_lds((const unsigned*)((const char*)(gbase) + (voff)[_i]), (PG8_LAS unsigned*)(lds + (bufoff) + ldsw + _i * 8192), 16, 0, 0); } while (0)
#define PG8_LDA(dst, b, h) do { _Pragma("unroll") for (int m = 0; m < 4; ++m) _Pragma("unroll") for (int k = 0; k < 2; ++k) dst[m][k] = *(const PG8_LAS bf16x8*)(lds + PG8_SA(b, h) + aoff + m * 2048 + k * 1024); } while (0)
#define PG8_LDB(dst, b, h) do { _Pragma("unroll") for (int n = 0; n < 2; ++n) _Pragma("unroll") for (int k = 0; k < 2; ++k) dst[n][k] = *(const PG8_LAS bf16x8*)(lds + PG8_SB(b, h) + boff + n * 2048 + k * 1024); } while (0)
#define PG8_MMA(ai, bj, At, Bt) do { __builtin_amdgcn_s_setprio(1); _Pragma("unroll") for (int m = 0; m < 4; ++m) _Pragma("unroll") for (int n = 0; n < 2; ++n) _Pragma("unroll") for (int k = 0; k < 2; ++k) \
        acc[ai][bj][m][n] = __builtin_amdgcn_mfma_f32_16x16x32_bf16(Bt[n][k], At[m][k], acc[ai][bj][m][n], 0, 0, 0); __builtin_amdgcn_s_setprio(0); } while (0)
#define PG8_WAIT_V(n) asm volatile("s_waitcnt vmcnt(" #n ")" ::: "memory")
#define PG8_WAIT_L(n) asm volatile("s_waitcnt lgkmcnt(" #n ")" ::: "memory")
#define PG8_BAR __builtin_amdgcn_s_barrier()
#define PG8_SCHED __builtin_amdgcn_sched_barrier(0)
    Unit cur, nxt; int ui = 0;
    if (!S.next(0, cur)) return;
    f32x4 acc[2][2][4][2];
#pragma unroll
    for (int a = 0; a < 2; ++a)
#pragma unroll
        for (int b = 0; b < 2; ++b)
#pragma unroll
            for (int m = 0; m < 4; ++m)
#pragma unroll
                for (int n = 0; n < 2; ++n) acc[a][b][m][n] = (f32x4){0.f, 0.f, 0.f, 0.f};
    bf16x8 At[4][2], B0[2][2], B1[2][2];
    const char* cA = (const char*)g.A + (size_t)cur.pm * tstep; const char* cB = (const char*)g.Bt + (size_t)cur.pn * tstep;
    S.a_ready(cur);
    if constexpr (SP2) {
        PG8_STAGE(PG8_SB(0, 0), cB, voffB); PG8_STAGE(PG8_SB(0, 1), cB + hstep, voffB); PG8_STAGE(PG8_SA(0, 0), cA, voffA); PG8_STAGE(PG8_SA(0, 1), cA + hstep, voffA);
        if (wr == 1) PG8_BAR;
        PG8_WAIT_V(2); PG8_BAR;
        PG8_STAGE(PG8_SB(1, 0), cB + kstep, voffB); PG8_STAGE(PG8_SA(1, 0), cA + kstep, voffA); PG8_STAGE(PG8_SB(1, 1), cB + hstep + kstep, voffB);
        PG8_WAIT_V(6); PG8_BAR;
    } else {
        PG8_STAGE(PG8_SB(0, 0), cB, voffB); PG8_STAGE(PG8_SA(0, 0), cA, voffA); PG8_STAGE(PG8_SB(0, 1), cB + hstep, voffB); PG8_STAGE(PG8_SA(0, 1), cA + hstep, voffA);
        if (wr == 1) PG8_BAR;
        PG8_WAIT_V(4); PG8_BAR;
        PG8_STAGE(PG8_SB(1, 0), cB + kstep, voffB); PG8_STAGE(PG8_SA(1, 0), cA + kstep, voffA); PG8_STAGE(PG8_SB(1, 1), cB + hstep + kstep, voffB);
        PG8_WAIT_V(6); PG8_BAR;
    }
    for (;;) {
        const bool has_next = S.next(ui + 1, nxt);
        const char* nA = has_next ? (const char*)g.A + (size_t)nxt.pm * tstep : cA; const char* nB = has_next ? (const char*)g.Bt + (size_t)nxt.pn * tstep : cB;
        for (int t = 0; t < nt; t += 2) {
            const bool last = (t == nt - 2);
            const char* a1 = cA + (size_t)(t + 1) * kstep;
            const char* a2 = last ? nA : cA + (size_t)(t + 2) * kstep; const char* b2 = last ? nB : cB + (size_t)(t + 2) * kstep;
            const char* a3 = a2 + kstep; const char* b3 = b2 + kstep;
            if (last && has_next) S.a_ready(nxt);
            if constexpr (SP2) {
            PG8_LDB(B0, 0, 0); PG8_LDB(B1, 0, 1); PG8_SCHED; PG8_LDA(At, 0, 0); PG8_STAGE(PG8_SA(1, 1), a1 + hstep, voffA);
            PG8_WAIT_V(8); PG8_WAIT_L(0); PG8_BAR; PG8_MMA(0, 0, At, B0); PG8_MMA(0, 1, At, B1); PG8_BAR; PG8_SCHED;
            PG8_LDA(At, 0, 1); PG8_STAGE(PG8_SB(0, 0), b2, voffB); PG8_STAGE(PG8_SB(0, 1), b2 + hstep, voffB); PG8_STAGE(PG8_SA(0, 0), a2, voffA);
            PG8_WAIT_V(8); PG8_WAIT_L(0); PG8_BAR; PG8_MMA(1, 0, At, B0); PG8_MMA(1, 1, At, B1); PG8_BAR; PG8_SCHED;
            PG8_LDB(B0, 1, 0); PG8_LDB(B1, 1, 1); PG8_SCHED; PG8_LDA(At, 1, 0); PG8_STAGE(PG8_SA(0, 1), a2 + hstep, voffA);
            PG8_WAIT_V(8); PG8_WAIT_L(0); PG8_BAR; PG8_MMA(0, 0, At, B0); PG8_MMA(0, 1, At, B1); PG8_BAR; PG8_SCHED;
            PG8_LDA(At, 1, 1); PG8_STAGE(PG8_SB(1, 0), b3, voffB); PG8_STAGE(PG8_SB(1, 1), b3 + hstep, voffB); PG8_STAGE(PG8_SA(1, 0), a3, voffA);
            PG8_WAIT_V(8); PG8_WAIT_L(0); PG8_BAR; PG8_MMA(1, 0, At, B0); PG8_MMA(1, 1, At, B1); PG8_BAR; PG8_SCHED;
            } else {
            PG8_LDB(B0, 0, 0); PG8_SCHED; PG8_LDA(At, 0, 0); PG8_STAGE(PG8_SA(1, 1), a1 + hstep, voffA);
            PG8_WAIT_L(8); PG8_BAR; PG8_WAIT_L(0); PG8_MMA(0, 0, At, B0); PG8_BAR; PG8_SCHED;
            PG8_LDB(B1, 0, 1); PG8_STAGE(PG8_SB(0, 0), b2, voffB);
            PG8_BAR; PG8_WAIT_L(0); PG8_MMA(0, 1, At, B1); PG8_BAR;
            PG8_LDA(At, 0, 1); PG8_STAGE(PG8_SA(0, 0), a2, voffA);
            PG8_BAR; PG8_WAIT_L(0); PG8_MMA(1, 0, At, B0); PG8_BAR; PG8_SCHED;
            PG8_STAGE(PG8_SB(0, 1), b2 + hstep, voffB);
            PG8_WAIT_V(6); PG8_BAR; PG8_MMA(1, 1, At, B1); PG8_BAR;
            PG8_LDB(B0, 1, 0); PG8_SCHED; PG8_LDA(At, 1, 0); PG8_STAGE(PG8_SA(0, 1), a2 + hstep, voffA);
            PG8_WAIT_L(8); PG8_BAR; PG8_WAIT_L(0); PG8_MMA(0, 0, At, B0); PG8_BAR; PG8_SCHED;
            PG8_LDB(B1, 1, 1); PG8_STAGE(PG8_SB(1, 0), b3, voffB);
            PG8_BAR; PG8_WAIT_L(0); PG8_MMA(0, 1, At, B1); PG8_BAR;
            PG8_LDA(At, 1, 1); PG8_STAGE(PG8_SA(1, 0), a3, voffA);
            PG8_BAR; PG8_WAIT_L(0); PG8_MMA(1, 0, At, B0); PG8_BAR; PG8_SCHED;
            PG8_STAGE(PG8_SB(1, 1), b3 + hstep, voffB);
            PG8_WAIT_V(6); PG8_BAR; PG8_MMA(1, 1, At, B1); PG8_BAR;
            }
        }
        if constexpr (ALIGN_EPI) { if (wr == 0) PG8_BAR; }
        if constexpr (!Epi::AFTER_DRAIN) { E(acc, cur, wr, wc, fr, fq); S.done(cur); }
        if (!has_next) break;
#pragma unroll
        for (int a = 0; a < 2; ++a)
#pragma unroll
            for (int b = 0; b < 2; ++b)
#pragma unroll
                for (int m = 0; m < 4; ++m)
#pragma unroll
                    for (int n = 0; n < 2; ++n) acc[a][b][m][n] = (f32x4){0.f, 0.f, 0.f, 0.f};
        cur = nxt; cA = nA; cB = nB; ++ui;
        if constexpr (ALIGN_EPI) { if (wr == 1) PG8_BAR; }
    }
    PG8_WAIT_V(0);
    if constexpr (!ALIGN_EPI) { if (wr == 0) PG8_BAR; }
    PG8_BAR;
    if constexpr (Epi::AFTER_DRAIN) { E.fused(acc, cur, wr, wc, fr, fq, lds, wid, lane); S.done(cur); }
#undef PG8_SA
#undef PG8_SB
#undef PG8_STAGE
#undef PG8_LDA
#undef PG8_LDB
#undef PG8_MMA
#undef PG8_WAIT_V
#undef PG8_WAIT_L
#undef PG8_BAR
#undef PG8_SCHED
}
}
#define LAS __attribute__((address_space(3)))
#define XB_TMO      128
#define XB_XCNT(j)  (256  + 64 * (j))
#define XB_XSUB(j)  (1280 + 64 * (j))
#define XB_XGEN(j)  (2304 + 64 * (j))
#define XB_TOP      3328
#define XB_TOPGEN   3392
#define XCD_BAR_WORDS 3456
#define XB_SPIN_CAP (1u << 18)
#define LAS __attribute__((address_space(3)))

__device__ __forceinline__ unsigned xb_ld(unsigned* p)              { return __hip_atomic_load(p, __ATOMIC_RELAXED, __HIP_MEMORY_SCOPE_AGENT); }
__device__ __forceinline__ unsigned xb_add(unsigned* p, unsigned v) { return __hip_atomic_fetch_add(p, v, __ATOMIC_RELAXED, __HIP_MEMORY_SCOPE_AGENT); }
__device__ __forceinline__ unsigned xb_xcc_id() { return (unsigned)__builtin_amdgcn_s_getreg((3 << 11) | 20) & 0xFu; }
#define XB_SPIN(cond, bar) do { unsigned _sp = 0; while (cond) { __builtin_amdgcn_s_sleep(1); \
    if ((++_sp & 255u) == 0u) { if (xb_ld(&(bar)[XB_TMO])) break; if (_sp > XB_SPIN_CAP) { atomicAdd(&(bar)[XB_TMO], 1u); break; } } } } while (0)

struct XcdBarrier {
    unsigned* bar; unsigned x;
    volatile LAS unsigned* st;
};

__device__ __forceinline__ XcdBarrier xcd_barrier_post(unsigned* bar, volatile LAS unsigned* st) {
    XcdBarrier b; b.bar = bar; b.x = xb_xcc_id(); b.st = st;
    if (threadIdx.x == 0) (void)xb_add(&bar[XB_XCNT(b.x)], 1u);
    return b;
}
__device__ __forceinline__ void xcd_barrier_complete(unsigned* bar, unsigned x, unsigned& nloc, unsigned& nx) {
    const unsigned G = gridDim.x * gridDim.y * gridDim.z;
    unsigned sum, cnt, mine, sp = 0u;
    for (;;) {
        sum = 0u; cnt = 0u; mine = 0u;
#pragma unroll
        for (unsigned j = 0; j < 16; ++j) { const unsigned c = xb_ld(&bar[XB_XCNT(j)]); sum += c; cnt += (c > 0u) ? 1u : 0u; mine = (j == x) ? c : mine; }
        if (sum == G) break;
        __builtin_amdgcn_s_sleep(1);
        if ((++sp & 255u) == 0u) { if (xb_ld(&bar[XB_TMO])) break; if (sp > XB_SPIN_CAP) { atomicAdd(&bar[XB_TMO], 1u); break; } }
    }
    nloc = mine > 0u ? mine : 1u; nx = cnt > 0u ? cnt : 1u;
}

__device__ __forceinline__ void xcd_barrier(const XcdBarrier& b) {
    asm volatile("s_waitcnt vmcnt(0)" ::: "memory");
    __syncthreads();
    if (threadIdx.x == 0) {
        unsigned* bar = b.bar;
        __builtin_amdgcn_s_waitcnt(0);
        unsigned nloc = b.st[0], nx = b.st[1];
        if (nloc == 0u) { xcd_barrier_complete(bar, b.x, nloc, nx); b.st[0] = nloc; b.st[1] = nx; }
        const unsigned old = xb_add(&bar[XB_XSUB(b.x)], 1u);
        const unsigned gen = old / nloc;
        if (old + 1u == (gen + 1u) * nloc) {
            __builtin_amdgcn_fence(__ATOMIC_RELEASE, "agent");
            asm volatile("s_waitcnt vmcnt(0)" ::: "memory");
            const unsigned og = xb_add(&bar[XB_TOP], 1u);
            const unsigned tg = og / nx;
            if (og + 1u == (tg + 1u) * nx) xb_add(&bar[XB_TOPGEN], 1u);
            else XB_SPIN(xb_ld(&bar[XB_TOPGEN]) == tg, bar);
            __builtin_amdgcn_fence(__ATOMIC_ACQUIRE, "agent");
            xb_add(&bar[XB_XGEN(b.x)], 1u);
            asm volatile("s_waitcnt vmcnt(0)" ::: "memory");
        } else {
            XB_SPIN(xb_ld(&bar[XB_XGEN(b.x)]) == gen, bar);
            __builtin_amdgcn_fence(__ATOMIC_ACQUIRE, "agent");
            asm volatile("s_waitcnt vmcnt(0)" ::: "memory");
        }
    }
    __syncthreads();
}


#ifndef REP
#define REP 0
#endif
#ifndef TPROBE
#define TPROBE 0
#endif
#ifndef AVAR
#define AVAR 0
#endif
constexpr int DM = 2048, NIN = 6144, MP = 32768, MS = 2048, MT = MP + MS, DEPTH = 4;
constexpr int NBP = 8, LP = 4096, NBS = 32, LSQ = 64;
constexpr int COL_Q = 0, COL_K = 1024, COL_V = 2048, COL_ZA = 3072, COL_US = 4096, COL_ZS = 4608, COL_UP = 5120, COL_ZP = 5632;
constexpr float EPSN = 1e-6f, LOG2E = 1.4426950408889634f;
constexpr size_t O_YP = 0, O_YS = O_YP + (size_t)MP * DM, O_KP = O_YS + (size_t)MS * DM, O_VP = O_KP + (size_t)DEPTH * NBP * 512 * 1024,
    O_SRP = O_VP + (size_t)DEPTH * NBP * 512 * 1024, O_SIP = O_SRP + (size_t)DEPTH * NBP * 2048, O_PP = O_SIP + (size_t)DEPTH * NBP * 2048,
    O_KS = O_PP + (size_t)DEPTH * NBP * 15 * 512, O_VS = O_KS + (size_t)DEPTH * NBS * 64 * 1024, O_SRS = O_VS + (size_t)DEPTH * NBS * 64 * 1024,
    O_SIS = O_SRS + (size_t)DEPTH * NBS * 2048, O_PS = O_SIS + (size_t)DEPTH * NBS * 2048, O_END = O_PS + (size_t)DEPTH * NBS * 15 * 512;
enum { I_XP = 0, I_XS, I_CP, I_CS, I_CK, I_CV, I_SRE, I_SIM, I_SPOOL, I_NORMG, I_WADA, I_BADA, I_WIN, I_RELB, I_AR, I_AI, I_LDT, I_BR, I_BI, I_CR, I_CI, I_SD, I_WGLU, I_BGLU,
       I_WPOOL, I_PSCALE, I_BNG, I_WOUT, I_FNG, N_IN };
constexpr size_t MiB = 1u << 20;
constexpr size_t WS_CTL = 0, WS_MOD = 1 * MiB, WS_SSQ = 5 * MiB, WS_SB = 6 * MiB, ZERO_BYTES = 10 * MiB, WS_GS = 10 * MiB, WS_SSMP = 12 * MiB, SSMP_LAYER = 512 * 1024, WS_WGLU = 14 * MiB, WS_WPOOL = 18 * MiB,
    WS_SLOC = 19 * MiB, WS_WOUT = 28 * MiB, WS_WIN = 60 * MiB, WS_HY = 156 * MiB, WS_PROJ = 292 * MiB, WS_KC = 700 * MiB, WS_VC = 828 * MiB, WS_HB = 956 * MiB, WS_END = 1092 * MiB;
constexpr size_t SSMP_ABAR = 0, SSMP_ABAR64 = 16384, SSMP_BF = 32768, SSMP_CF = 32768 + 131072;
constexpr int CW_BAR = 4096, CW_Q = 16384, CW_RB = 12288;
constexpr int LDS_BYTES = 147456, MISC_OFF = LDS_BYTES - 64;
constexpr int NPH = 3 + 5 * DEPTH;

#define GAS __attribute__((address_space(1)))
typedef unsigned short bf16;
typedef unsigned v4u __attribute__((ext_vector_type(4)));
typedef unsigned v2u __attribute__((ext_vector_type(2)));
typedef float f32x4 __attribute__((ext_vector_type(4)));
typedef float f32x16 __attribute__((ext_vector_type(16)));
typedef short bf16x8 __attribute__((ext_vector_type(8)));
typedef short s16x4 __attribute__((ext_vector_type(4)));
typedef float f32x2_t __attribute__((ext_vector_type(2)));
typedef __bf16 bf16x2_t __attribute__((ext_vector_type(2)));
#define DI __device__ __forceinline__
DI unsigned pk2(float lo, float hi) { f32x2_t v = {lo, hi}; bf16x2_t b = __builtin_convertvector(v, bf16x2_t); return __builtin_bit_cast(unsigned, b); }
DI float bflo(unsigned u) { return __uint_as_float(u << 16); }
DI float bfhi(unsigned u) { return __uint_as_float(u & 0xffff0000u); }
DI float ex2(float x) { return __builtin_amdgcn_exp2f(x); }
DI float rcpf_(float x) { return __builtin_amdgcn_rcpf(x); }
DI float silu_f(float z) { return z * rcpf_(1.f + ex2(-LOG2E * z)); }
DI float sigm_f(float z) { return rcpf_(1.f + ex2(-LOG2E * z)); }
DI float gelu_tanh_f(float x) { const float t = x + 0.044715f * x * x * x; return x * rcpf_(1.f + ex2(-(1.5957691216057308f * LOG2E) * t)); }
DI float xh_max(float v) { auto rr = __builtin_amdgcn_permlane32_swap(__float_as_uint(v), __float_as_uint(v), false, false); return fmaxf(__uint_as_float(rr[0]), __uint_as_float(rr[1])); }
DI float xh_sum(float v) { auto rr = __builtin_amdgcn_permlane32_swap(__float_as_uint(v), __float_as_uint(v), false, false); return __uint_as_float(rr[0]) + __uint_as_float(rr[1]); }
#define SWZ_XOR(v, k) __uint_as_float((unsigned)__builtin_amdgcn_ds_swizzle((int)__float_as_uint(v), ((k) << 10) | 0x1f))
DI float wave_sum(float v) { v += SWZ_XOR(v, 1); v += SWZ_XOR(v, 2); v += SWZ_XOR(v, 4); v += SWZ_XOR(v, 8); v += SWZ_XOR(v, 16); return xh_sum(v); }
DI f32x16 mfma32(bf16x8 a, bf16x8 b, f32x16 c) { return __builtin_amdgcn_mfma_f32_32x32x16_bf16(a, b, c, 0, 0, 0); }
DI f32x4 mfma16(bf16x8 a, bf16x8 b, f32x4 c) { return __builtin_amdgcn_mfma_f32_16x16x32_bf16(a, b, c, 0, 0, 0); }
typedef short v4i16_t __attribute__((ext_vector_type(4)));
DI s16x4 lds_tr(LAS const unsigned char* p) { return __builtin_bit_cast(s16x4, __builtin_amdgcn_ds_read_tr16_b64_v4i16((LAS v4i16_t*)p)); }
DI bf16x8 zero8() { return (bf16x8){0, 0, 0, 0, 0, 0, 0, 0}; }
DI bf16x8 ld8(const bf16* p) { return *(const bf16x8*)p; }
DI void unpack8(v4u w, float (&f)[8]) { f[0] = bflo(w.x); f[1] = bfhi(w.x); f[2] = bflo(w.y); f[3] = bfhi(w.y); f[4] = bflo(w.z); f[5] = bfhi(w.z); f[6] = bflo(w.w); f[7] = bfhi(w.w); }

struct Args { const float* in[N_IN]; float* out; unsigned char* ws; int ph_lo, ph_hi; };
static_assert(sizeof(Args) == (N_IN + 2) * 8 + 8, "Args has no padding");

DI int otid() { int t = threadIdx.x; asm volatile("" : "+v"(t)); return t; }
struct Ctx {
    const float* const* in; float* out; unsigned char* ws; LAS unsigned char* lds;
    int tid, lane, wave, G, bid;
    bf16* HY; bf16* HB; bf16* PROJ; bf16* KC; bf16* VC; bf16* WIN; bf16* WOUT; float* MOD; float* SSQ; float* SB; float* GS; unsigned* ctl;
};

DI void fresh(Ctx& C) { C.tid = otid(); C.lane = C.tid & 63; C.wave = __builtin_amdgcn_readfirstlane(C.tid >> 6); }
template <bool SILU> DI void p0_mod_unit(const Ctx& C0, int task) {
    Ctx C = C0; fresh(C);
    const int l = task / 192, rem = task % 192, ke = rem / 24, cb = rem % 24, k0 = ke * 256;
    LAS float* sc = (LAS float*)C.lds;
    for (int idx = C.tid; idx < 64 * 256; idx += 512) { const int r = idx >> 8, kk = idx & 255; float v = 0.f;
        if (r < 40) { if (SILU) { const float cv = (r < 8) ? C.in[I_CP][r * DM + k0 + kk] : C.in[I_CS][(r - 8) * DM + k0 + kk]; v = silu_f(cv); } else v = C.MOD[((size_t)l * 40 + r) * NIN + k0 + kk]; }
        sc[r * 257 + kk] = v; }
    __syncthreads();
    const int jl = C.lane & 31, kh = C.lane >> 5, j = cb * 256 + C.wave * 32 + jl;
    const float* Wp = C.in[SILU ? I_WADA : I_WIN] + (size_t)l * DM * NIN + (size_t)(k0 + kh) * NIN + j;
    f32x16 d0 = {}, d1 = {};
    float wv[16];
#pragma unroll
    for (int i = 0; i < 16; ++i) wv[i] = Wp[(size_t)i * 2 * NIN];
#pragma unroll 1
    for (int kp0 = 0; kp0 < 128; kp0 += 16) {
#pragma unroll
        for (int i = 0; i < 16; ++i) { const int kp = kp0 + i;
            const float a0 = sc[jl * 257 + 2 * kp + kh], a1 = sc[(32 + jl) * 257 + 2 * kp + kh];
            d0 = __builtin_amdgcn_mfma_f32_32x32x2f32(a0, wv[i], d0, 0, 0, 0); d1 = __builtin_amdgcn_mfma_f32_32x32x2f32(a1, wv[i], d1, 0, 0, 0);
            if (kp + 16 < 128) wv[i] = Wp[(size_t)(kp + 16) * 2 * NIN]; } }
    float* M = (SILU ? C.MOD : C.SB) + (size_t)l * 40 * NIN + j;
    const float bias = (SILU && ke == 0) ? C.in[I_BADA][l * NIN + j] : 0.f;
#pragma unroll
    for (int reg = 0; reg < 16; ++reg) unsafeAtomicAdd(M + (size_t)(8 * (reg >> 2) + 4 * kh + (reg & 3)) * NIN, d0[reg] + bias);
#pragma unroll
    for (int reg = 0; reg < 4; ++reg) unsafeAtomicAdd(M + (size_t)(32 + 4 * kh + reg) * NIN, d1[reg] + bias);
    __syncthreads();
}
DI void p0_transpose_item(const float* W, int K, int N, bf16* WT, LAS float* scr, int item, int lane) {
    const int nblk = N / 32, kb = item / nblk, nb = item % nblk, k0 = 64 * kb, n0 = 32 * nb;
#pragma unroll 8
    for (int i = 0; i < 32; ++i) { const int kk = 2 * i + (lane >> 5); scr[kk * 33 + (lane & 31)] = W[(size_t)(k0 + kk) * N + n0 + (lane & 31)]; }
    asm volatile("s_waitcnt lgkmcnt(0)" ::: "memory");
    const int c = lane & 7;
#pragma unroll
    for (int j = 0; j < 4; ++j) { const int n = (lane >> 3) + 8 * j; const LAS float* s = scr + (8 * c) * 33 + n;
        v4u o; o.x = pk2(s[0 * 33], s[1 * 33]); o.y = pk2(s[2 * 33], s[3 * 33]); o.z = pk2(s[4 * 33], s[5 * 33]); o.w = pk2(s[6 * 33], s[7 * 33]);
        *(v4u*)(WT + (size_t)(n0 + n) * K + k0 + 8 * c) = o; }
    asm volatile("s_waitcnt lgkmcnt(0)" ::: "memory");
}
DI void p0_ssm_params(const Ctx& C, int l, int g, int lane) {
    unsigned char* blk = C.ws + WS_SSMP + (size_t)l * SSMP_LAYER;
    const int gp = (l * 32 + g) * 64 + lane;
    const float dt = expf(C.in[I_LDT][l * 32 + g]);
    const float ar = C.in[I_AR][gp], ai = C.in[I_AI][gp];
    const float x = ar * dt, ang = ai * dt;
    float sn, cs; sincosf(ang, &sn, &cs);
    const float mag = expf(x), em1 = expm1f(x);
    const float abr = mag * cs, abi = mag * sn;
    float sh, ch; sincosf(0.5f * ang, &sh, &ch); (void)ch;
    const float nr = em1 * cs - 2.f * sh * sh, ni = abi;
    const float den = ar * ar + ai * ai;
    const float cr = (nr * ar + ni * ai) / den, ci = (ni * ar - nr * ai) / den;
    float* AB = (float*)(blk + SSMP_ABAR) + g * 128; AB[lane] = abr; AB[64 + lane] = abi;
    { float s64, c64; sincosf(64.f * ang, &s64, &c64); const float m64 = expf(64.f * x); float* A6 = (float*)(blk + SSMP_ABAR64) + g * 128; A6[lane] = m64 * c64; A6[64 + lane] = m64 * s64; }
    const float* br = C.in[I_BR] + (size_t)gp * 16; const float* bi = C.in[I_BI] + (size_t)gp * 16;
    float bbr[16], bbi[16];
#pragma unroll
    for (int c = 0; c < 16; ++c) { const float b_r = br[c], b_i = bi[c]; bbr[c] = cr * b_r - ci * b_i; bbi[c] = cr * b_i + ci * b_r; }
    v4u* BF = (v4u*)(blk + SSMP_BF) + (size_t)g * 4 * 64;
#pragma unroll
    for (int half = 0; half < 2; ++half) {
        v4u o; o.x = pk2(bbr[8 * half], bbr[8 * half + 1]); o.y = pk2(bbr[8 * half + 2], bbr[8 * half + 3]); o.z = pk2(bbr[8 * half + 4], bbr[8 * half + 5]); o.w = pk2(bbr[8 * half + 6], bbr[8 * half + 7]);
        BF[(0 + half) * 64 + lane] = o;
        o.x = pk2(bbi[8 * half], bbi[8 * half + 1]); o.y = pk2(bbi[8 * half + 2], bbi[8 * half + 3]); o.z = pk2(bbi[8 * half + 4], bbi[8 * half + 5]); o.w = pk2(bbi[8 * half + 6], bbi[8 * half + 7]);
        BF[(2 + half) * 64 + lane] = o; }
    v4u* CF = (v4u*)(blk + SSMP_CF) + (size_t)g * 4 * 64;
    const int c = lane & 15, kq = lane >> 4;
    const float* crp = C.in[I_CR] + ((size_t)(l * 32 + g) * 16 + c) * 64; const float* cip = C.in[I_CI] + ((size_t)(l * 32 + g) * 16 + c) * 64;
#pragma unroll
    for (int kap = 0; kap < 4; ++kap) { const int p0 = 16 * kap + 4 * kq;
        v4u o; o.x = pk2(crp[p0], -cip[p0]); o.y = pk2(crp[p0 + 1], -cip[p0 + 1]); o.z = pk2(crp[p0 + 2], -cip[p0 + 2]); o.w = pk2(crp[p0 + 3], -cip[p0 + 3]);
        CF[kap * 64 + lane] = o; }
}
DI void cache_convert(const Ctx& C, int l, int part, int nparts) {
    const size_t n8 = (size_t)NBS * 512 * 1024 / 8, base = (size_t)l * NBS * 512 * 1024;
    for (size_t i = (size_t)part * 64 + C.lane; i < 2 * n8; i += (size_t)nparts * 64) { const bool isv = i >= n8; const size_t e = base + (isv ? i - n8 : i) * 8;
        const float* s = (isv ? C.in[I_CV] : C.in[I_CK]) + e; const f32x4 a = *(const f32x4*)s, b = *(const f32x4*)(s + 4);
        v4u o; o.x = pk2(a.x, a.y); o.y = pk2(a.z, a.w); o.z = pk2(b.x, b.y); o.w = pk2(b.z, b.w); *(v4u*)((isv ? C.VC : C.KC) + e) = o; }
}
DI void cache_item(const Ctx& C0, int l, int it) {
    Ctx C = C0; fresh(C);
    const size_t n8 = (size_t)NBS * 512 * 1024 / 8, base = (size_t)l * NBS * 512 * 1024, i0 = (size_t)it * (2 * n8 / 256);
#pragma unroll 4
    for (int k = 0; k < (int)(2 * n8 / 256 / 512); ++k) { const size_t i = i0 + (size_t)k * 512 + C.tid; const bool isv = i >= n8; const size_t e = base + (isv ? i - n8 : i) * 8;
        const float* s = (isv ? C.in[I_CV] : C.in[I_CK]) + e; const f32x4 a = *(const f32x4*)s, b = *(const f32x4*)(s + 4);
        v4u o; o.x = pk2(a.x, a.y); o.y = pk2(a.z, a.w); o.z = pk2(b.x, b.y); o.w = pk2(b.z, b.w); *(v4u*)((isv ? C.VC : C.KC) + e) = o; }
}
DI void p0_convert(const Ctx& C0);
DI void p0_prologue(const Ctx& C0, bool with_mod) {
    if (C0.bid & 1) { if (with_mod) for (int u = C0.bid; u < 768; u += C0.G) p0_mod_unit<true>(C0, u); __syncthreads(); p0_convert(C0); }
    else { p0_convert(C0); __syncthreads(); if (with_mod) for (int u = C0.bid; u < 768; u += C0.G) p0_mod_unit<true>(C0, u); }
}
DI void p0_convert(const Ctx& C0) {
    Ctx C = C0; fresh(C);
    const int gw = C.bid * 8 + C.wave, NGW = C.G * 8, lane = C.lane;
    LAS float* scr = (LAS float*)(C.lds + C.wave * 16384);
    constexpr int I_IN = (DM / 64) * (NIN / 32), I_OUT = (DM / 64) * (DM / 32);
    for (int it = gw; it < DEPTH * (I_IN + I_OUT); it += NGW) {
        const int l = it / (I_IN + I_OUT), r = it % (I_IN + I_OUT);
        if (r < I_IN) p0_transpose_item(C.in[I_WIN] + (size_t)l * DM * NIN, DM, NIN, C.WIN + (size_t)l * NIN * DM, scr, r, lane);
        else p0_transpose_item(C.in[I_WOUT] + (size_t)l * DM * DM, DM, DM, C.WOUT + (size_t)l * DM * DM, scr, r - I_IN, lane);
    }
    for (int it = gw; it < DEPTH * 1024; it += NGW) { const int l = it >> 10, ct = (it >> 5) & 31, kap = it & 31;
        const float* w = C.in[I_WGLU] + (size_t)l * 512 * 1024 + (size_t)(16 * kap + 8 * (lane >> 5)) * 1024 + 32 * ct + (lane & 31);
        v4u o; o.x = pk2(w[0], w[1024]); o.y = pk2(w[2048], w[3072]); o.z = pk2(w[4096], w[5120]); o.w = pk2(w[6144], w[7168]);
        ((v4u*)(C.ws + WS_WGLU))[(size_t)it * 64 + lane] = o; }
    for (int it = gw; it < DEPTH * 128; it += NGW) { const int lg = it >> 5, ct = (it >> 3) & 3, kap = it & 7;
        const float* w = C.in[I_WPOOL] + (size_t)lg * 128 * 128 + (size_t)(16 * kap + 8 * (lane >> 5)) * 128 + 32 * ct + (lane & 31);
        v4u o; o.x = pk2(w[0], w[128]); o.y = pk2(w[256], w[384]); o.z = pk2(w[512], w[640]); o.w = pk2(w[768], w[896]);
        ((v4u*)(C.ws + WS_WPOOL))[(size_t)it * 64 + lane] = o; }
    for (int it = gw; it < DEPTH * 32; it += NGW) p0_ssm_params(C, it >> 5, it & 31, lane);
}

DI void p0b_rows(const Ctx& C0);
DI void p0b_phase(const Ctx& C0) {
    if (C0.bid & 1) { for (int u = C0.bid; u < 768; u += C0.G) p0_mod_unit<false>(C0, u); p0b_rows(C0); }
    else { p0b_rows(C0); __syncthreads(); for (int u = C0.bid; u < 768; u += C0.G) p0_mod_unit<false>(C0, u); }
}
DI void p0b_rows(const Ctx& C0) {
    Ctx C = C0; fresh(C);
    for (int i = C.bid * 512 + C.tid; i < DEPTH * 40 * DM; i += C.G * 512) { const int l = i / (40 * DM), r = (i / DM) % 40, k = i % DM;
        C.GS[i] = C.in[I_NORMG][l * DM + k] * (1.f + C.MOD[((size_t)l * 40 + r) * NIN + DM + k]); }
    const int gw = C.bid * 8 + C.wave, NGW = C.G * 8, lane = C.lane, rpw = (MT + NGW - 1) / NGW;
    f32x4 gs[8]; int cur_b = -1;
    f32x4 v[8], vn[8];
    auto ldrow = [&](int m, f32x4 (&d)[8]) { const float* xr = (m < MP) ? C.in[I_XP] + (size_t)m * DM : C.in[I_XS] + (size_t)(m - MP) * DM;
#pragma unroll
        for (int j = 0; j < 8; ++j) d[j] = ((const f32x4*)xr)[lane + 64 * j]; };
    const int m0 = gw * rpw; if (m0 < MT) ldrow(m0, v);
    for (int i = 0; i < rpw; ++i) { const int m = m0 + i; if (m >= MT) break;
        if (i + 1 < rpw && m + 1 < MT) ldrow(m + 1, vn);
        const int brow = (m < MP) ? (m >> 12) : 8 + ((m - MP) >> 6);
        if (brow != cur_b) { cur_b = brow; const float* md = C.MOD + (size_t)brow * NIN + DM;
#pragma unroll
            for (int j = 0; j < 8; ++j) gs[j] = ((const f32x4*)C.in[I_NORMG])[lane + 64 * j] * (((const f32x4*)md)[lane + 64 * j] + 1.f); }
        float sq = 0.f; v2u* o8 = (v2u*)(C.HB + (size_t)m * DM) + lane;
#pragma unroll
        for (int j = 0; j < 8; ++j) { sq += (v[j].x * v[j].x + v[j].y * v[j].y) + (v[j].z * v[j].z + v[j].w * v[j].w); const f32x4 h = v[j] * gs[j]; v2u o; o.x = pk2(h.x, h.y); o.y = pk2(h.z, h.w); o8[64 * j] = o; }
        sq = wave_sum(sq); if (lane == 0) C.SSQ[m] = sq;
#pragma unroll
        for (int j = 0; j < 8; ++j) v[j] = vn[j]; }
}
DI void final_norm_phase(const Ctx& C0) {
    Ctx C = C0; fresh(C);
    const int gw = C.bid * 8 + C.wave, NGW = C.G * 8, lane = C.lane, rpw = (MT + NGW - 1) / NGW;
    f32x4 g[8];
#pragma unroll
    for (int j = 0; j < 8; ++j) g[j] = ((const f32x4*)C.in[I_FNG])[lane + 64 * j];
    f32x4 v[8], vn[8];
    auto ldrow = [&](int m, f32x4 (&d)[8]) {
#pragma unroll
        for (int j = 0; j < 8; ++j) d[j] = ((const f32x4*)(C.out + (size_t)m * DM))[lane + 64 * j]; };
    const int m0 = gw * rpw; if (m0 < MT) ldrow(m0, v);
    for (int i = 0; i < rpw; ++i) { const int m = m0 + i; if (m >= MT) break;
        if (i + 1 < rpw && m + 1 < MT) ldrow(m + 1, vn);
        const float rstd = rsqrtf(C.SSQ[(size_t)DEPTH * MT + m] * (1.f / DM) + EPSN);
        f32x4* o4 = (f32x4*)(C.out + (size_t)m * DM) + lane;
#pragma unroll
        for (int j = 0; j < 8; ++j) o4[64 * j] = v[j] * rstd * g[j];
#pragma unroll
        for (int j = 0; j < 8; ++j) v[j] = vn[j]; }
}

constexpr int ROWP = 1040;
struct TailPre { v4u zz[8]; };
DI void tail_prefetch(const Ctx& C, int row0, int zcol, TailPre& P) {
#pragma unroll
    for (int it = 0; it < 8; ++it) { const int idx = C.tid + 512 * it, row = idx >> 6, ch = idx & 63; P.zz[it] = *(const v4u*)(C.PROJ + (size_t)(row0 + row) * NIN + zcol + ch * 8); }
}
DI void branch_tail(const Ctx& C, int l, int row0, LAS unsigned char* ST, LAS float* ssq, LAS float* rstd_l, const TailPre& P, int ycol) {
    if (C.tid < 64) { float t = 0.f;
#pragma unroll
        for (int w = 0; w < 8; ++w) t += ssq[w * 64 + C.tid];
        rstd_l[C.tid] = rsqrtf(t * (1.f / 512.f) + EPSN); }
    __syncthreads();
    const float* gb = C.in[I_BNG] + (size_t)l * DM + ycol;
    const f32x4 g0 = *(const f32x4*)(gb + (C.tid & 63) * 8), g1 = *(const f32x4*)(gb + (C.tid & 63) * 8 + 4);
#pragma unroll
    for (int it = 0; it < 8; ++it) { const int idx = C.tid + 512 * it, row = idx >> 6, ch = idx & 63;
        const v4u raw = *(const LAS v4u*)(ST + row * ROWP + ch * 16);
        const v4u zz = P.zz[it];
        float r[8], z[8]; unpack8(raw, r); unpack8(zz, z); const float rs = rstd_l[row];
        const float gg[8] = {g0.x, g0.y, g0.z, g0.w, g1.x, g1.y, g1.z, g1.w}; float o[8];
#pragma unroll
        for (int e = 0; e < 8; ++e) o[e] = r[e] * rs * gg[e] * silu_f(z[e]);
        v4u w; w.x = pk2(o[0], o[1]); w.y = pk2(o[2], o[3]); w.z = pk2(o[4], o[5]); w.w = pk2(o[6], o[7]);
        *(v4u*)(C.HY + (size_t)(row0 + row) * DM + ycol + ch * 8) = w; }
    __syncthreads();
}

struct SsmGroup { float ar, ai; bf16x8 bf[4]; };
DI void ssm_load_group(const Ctx& C, int l, int g, int lane, SsmGroup& S) {
    const unsigned char* blk = C.ws + WS_SSMP + (size_t)l * SSMP_LAYER;
    const float* AB = (const float*)(blk + SSMP_ABAR) + g * 128; S.ar = AB[lane]; S.ai = AB[64 + lane];
    const bf16x8* BF = (const bf16x8*)(blk + SSMP_BF) + (size_t)g * 4 * 64;
#pragma unroll
    for (int f = 0; f < 4; ++f) S.bf[f] = BF[f * 64 + lane];
}
struct SsmA { bf16x8 a0[4], a1[4]; };
DI void ssm_load_a(const Ctx& C, int row0, int g, int lane, SsmA& A) {
    const int i = lane & 31, kh = lane >> 5, ti = 4 * (i >> 3) + (i & 3); const bool act = ((i >> 2) & 1) == kh;
    const bf16* src = C.PROJ + (size_t)(row0 + ti) * NIN + COL_US + 16 * g;
#pragma unroll
    for (int blk = 0; blk < 4; ++blk) { A.a0[blk] = ld8(src + (size_t)blk * 16 * NIN); A.a1[blk] = ld8(src + (size_t)blk * 16 * NIN + 8);
        if (!act) { A.a0[blk] = zero8(); A.a1[blk] = zero8(); } }
}
DI void ssm_bu(const SsmGroup& S, const bf16x8 a0, const bf16x8 a1, f32x16& dre, f32x16& dim) {
    const f32x16 z = {};
    dre = mfma32(a0, S.bf[0], z); dre = mfma32(a1, S.bf[1], dre);
    dim = mfma32(a0, S.bf[2], z); dim = mfma32(a1, S.bf[3], dim);
}
DI void ssm_local_unit(const Ctx& C0, int l, int u) {
    Ctx C = C0; fresh(C);
    const int lane = C.lane, row0 = (u >> 6) * LP + (u & 63) * 64;
    float* SL = (float*)(C.ws + WS_SLOC) + (size_t)u * 4096;
    SsmGroup S; SsmA A; ssm_load_group(C, l, C.wave * 4, lane, S); ssm_load_a(C, row0, C.wave * 4, lane, A);
#pragma unroll 1
    for (int gi = 0; gi < 4; ++gi) { const int g = C.wave * 4 + gi;
        SsmGroup Sn; SsmA An; if (gi < 3) { ssm_load_group(C, l, g + 1, lane, Sn); ssm_load_a(C, row0, g + 1, lane, An); }
        float hr = 0.f, hi = 0.f;
#pragma unroll
        for (int blk = 0; blk < 4; ++blk) { f32x16 dre, dim; ssm_bu(S, A.a0[blk], A.a1[blk], dre, dim);
#pragma unroll
            for (int r = 0; r < 16; ++r) { const float nr = S.ar * hr - S.ai * hi + dre[r], ni = S.ar * hi + S.ai * hr + dim[r]; hr = nr; hi = ni; } }
        SL[g * 64 + lane] = hr; SL[2048 + g * 64 + lane] = hi;
        if (gi < 3) { S = Sn; A = An; } }
}
DI void ssm_carry_phase(const Ctx& C0, int l) {
    Ctx C = C0; fresh(C);
    const int t = C.wave * C.G + C.bid, NW = C.G * 8;
    if (t >= 256) { if (l == 0) cache_convert(C, l, t - 256, NW - 256); return; }
    const int b = t >> 5, g = t & 31, lane = C.lane;
    const float* A6 = (const float*)(C.ws + WS_SSMP + (size_t)l * SSMP_LAYER + SSMP_ABAR64) + g * 128; const float a6r = A6[lane], a6i = A6[64 + lane];
    float* SL = (float*)(C.ws + WS_SLOC) + (size_t)(b * 64) * 4096 + g * 64 + lane;
    float hr = 0.f, hi = 0.f;
#pragma unroll 1
    for (int nb = 0; nb < 4; ++nb) { float sr[16], si[16];
#pragma unroll
        for (int i = 0; i < 16; ++i) { sr[i] = SL[(size_t)(16 * nb + i) * 4096]; si[i] = SL[(size_t)(16 * nb + i) * 4096 + 2048]; }
#pragma unroll
        for (int i = 0; i < 16; ++i) { SL[(size_t)(16 * nb + i) * 4096] = hr; SL[(size_t)(16 * nb + i) * 4096 + 2048] = hi;
            const float nr = a6r * hr - a6i * hi + sr[i], ni = a6r * hi + a6i * hr + si[i]; hr = nr; hi = ni; } }
}
struct SsmPre { SsmGroup S; SsmA A; bf16x8 cf[4]; f32x4 dsk; v2u uu[4]; float hr, hi; };
DI void ssm_prefetch(const Ctx& C, int l, int g, int row0, bool samp, int b, int n, int lane, SsmPre& P) {
    const unsigned char* blk_p = C.ws + WS_SSMP + (size_t)l * SSMP_LAYER;
    ssm_load_group(C, l, g, lane, P.S); ssm_load_a(C, row0, g, lane, P.A);
    const bf16x8* CF = (const bf16x8*)(blk_p + SSMP_CF) + (size_t)g * 4 * 64;
#pragma unroll
    for (int k = 0; k < 4; ++k) P.cf[k] = CF[k * 64 + lane];
    const int t16 = lane & 15, kq = lane >> 4;
    P.dsk = *(const f32x4*)(C.in[I_SD] + (size_t)(l * 32 + g) * 16 + 4 * kq);
#pragma unroll
    for (int blk = 0; blk < 4; ++blk) P.uu[blk] = *(const v2u*)(C.PROJ + (size_t)(row0 + 16 * blk + t16) * NIN + COL_US + 16 * g + 4 * kq);
    if (samp) { P.hr = C.in[I_SRE][((size_t)(l * NBS + b) * 32 + g) * 64 + lane]; P.hi = C.in[I_SIM][((size_t)(l * NBS + b) * 32 + g) * 64 + lane]; }
    else { const float* SL = (const float*)(C.ws + WS_SLOC) + (size_t)(b * 64 + n) * 4096 + g * 64 + lane; P.hr = SL[0]; P.hi = SL[2048]; }
}
DI void ssm_main_unit(const Ctx& C0, int l, int u) {
    Ctx C = C0; fresh(C);
    const int lane = C.lane, wave = C.wave; const bool samp = u >= 512;
    const int b = samp ? u - 512 : (u >> 6), n = samp ? 0 : (u & 63), row0 = samp ? MP + 64 * b : b * LP + 64 * n;
    LAS unsigned char* GG = C.lds; LAS unsigned char* HT = C.lds + 64 * ROWP + wave * 4352;
    LAS float* ssq = (LAS float*)(C.lds + 64 * ROWP + 8 * 4352); LAS float* rstd_l = ssq + 512;
    { SsmPre P; ssm_prefetch(C, l, wave * 4, row0, samp, b, n, lane, P);
#pragma unroll 1
      for (int gi = 0; gi < 4; ++gi) { const int g = wave * 4 + gi;
        SsmPre Pn; if (gi < 3) ssm_prefetch(C, l, g + 1, row0, samp, b, n, lane, Pn);
        const int t16 = lane & 15, kq = lane >> 4;
        float hr = P.hr, hi = P.hi;
#pragma unroll
        for (int blk = 0; blk < 4; ++blk) { f32x16 dre, dim; ssm_bu(P.S, P.A.a0[blk], P.A.a1[blk], dre, dim);
#pragma unroll
            for (int r = 0; r < 16; ++r) { const float nr = P.S.ar * hr - P.S.ai * hi + dre[r], ni = P.S.ar * hi + P.S.ai * hr + dim[r]; hr = nr; hi = ni;
                *(LAS unsigned*)(HT + r * 272 + lane * 4) = pk2(nr, ni); }
            f32x4 yt = {0.f, 0.f, 0.f, 0.f};
#pragma unroll
            for (int k = 0; k < 4; ++k) { const bf16x8 hb = *(const LAS bf16x8*)(HT + t16 * 272 + (32 * k + 8 * kq) * 2); yt = mfma16(P.cf[k], hb, yt); }
            const v2u uu = P.uu[blk];
            const float y0 = gelu_tanh_f(yt[0] + P.dsk[0] * bflo(uu.x)), y1 = gelu_tanh_f(yt[1] + P.dsk[1] * bfhi(uu.x)), y2 = gelu_tanh_f(yt[2] + P.dsk[2] * bflo(uu.y)), y3 = gelu_tanh_f(yt[3] + P.dsk[3] * bfhi(uu.y));
            v2u o; o.x = pk2(y0, y1); o.y = pk2(y2, y3);
            *(LAS v2u*)(GG + (16 * blk + t16) * ROWP + (16 * g + 4 * kq) * 2) = o; }
        if (samp || n == 63) { float* ore = C.out + (samp ? O_SRS + ((size_t)(l * NBS + b) * 2048) : O_SRP + ((size_t)(l * NBP + b) * 2048)) + g * 64 + lane;
            float* oim = C.out + (samp ? O_SIS + ((size_t)(l * NBS + b) * 2048) : O_SIP + ((size_t)(l * NBP + b) * 2048)) + g * 64 + lane; *ore = hr; *oim = hi; }
        if (gi < 3) P = Pn; } }
    __syncthreads();
    const int hi5 = lane >> 5, r32 = lane & 31;
    const bf16x8* WG = (const bf16x8*)(C.ws + WS_WGLU) + (size_t)l * 1024 * 64 + lane;
    const float* bg = C.in[I_BGLU] + (size_t)l * 1024;
    float sq[2] = {0.f, 0.f}; v2u ost[2][4][2];
#pragma unroll
    for (int c = 0; c < 2; ++c) {
        const bf16x8* Wv = WG + (size_t)((2 * wave + c) * 32) * 64; const bf16x8* Wt = WG + (size_t)((16 + 2 * wave + c) * 32) * 64;
        f32x16 av[2], ag[2]; av[0] = f32x16{}; av[1] = f32x16{}; ag[0] = f32x16{}; ag[1] = f32x16{};
        bf16x8 rv[8], rg[8];
#pragma unroll
        for (int i = 0; i < 8; ++i) { rv[i] = Wv[(size_t)i * 64]; rg[i] = Wt[(size_t)i * 64]; }
#pragma unroll 1
        for (int k0 = 0; k0 < 32; k0 += 8) {
#pragma unroll
            for (int i = 0; i < 8; ++i) { const int kap = k0 + i;
                const bf16x8 b0 = *(const LAS bf16x8*)(GG + r32 * ROWP + (16 * kap + 8 * hi5) * 2), b1 = *(const LAS bf16x8*)(GG + (32 + r32) * ROWP + (16 * kap + 8 * hi5) * 2);
                av[0] = mfma32(rv[i], b0, av[0]); av[1] = mfma32(rv[i], b1, av[1]); ag[0] = mfma32(rg[i], b0, ag[0]); ag[1] = mfma32(rg[i], b1, ag[1]);
                if (kap + 8 < 32) { rv[i] = Wv[(size_t)(kap + 8) * 64]; rg[i] = Wt[(size_t)(kap + 8) * 64]; } } }
#pragma unroll
        for (int rr = 0; rr < 4; ++rr) { const int ch0 = 64 * wave + 32 * c + 8 * rr + 4 * hi5; const f32x4 bv = *(const f32x4*)(bg + ch0), bgt = *(const f32x4*)(bg + 512 + ch0);
#pragma unroll
            for (int tt = 0; tt < 2; ++tt) { float o[4];
#pragma unroll
                for (int e = 0; e < 4; ++e) { o[e] = (av[tt][4 * rr + e] + bv[e]) * sigm_f(ag[tt][4 * rr + e] + bgt[e]); sq[tt] += o[e] * o[e]; }
                ost[c][rr][tt].x = pk2(o[0], o[1]); ost[c][rr][tt].y = pk2(o[2], o[3]); } }
    }
    TailPre TP; tail_prefetch(C, row0, COL_ZS, TP);
#pragma unroll
    for (int tt = 0; tt < 2; ++tt) { const float t = xh_sum(sq[tt]); if (hi5 == 0) ssq[wave * 64 + 32 * tt + r32] = t; }
    __syncthreads();
#pragma unroll
    for (int c = 0; c < 2; ++c)
#pragma unroll
        for (int rr = 0; rr < 4; ++rr) { const int ch0 = 64 * wave + 32 * c + 8 * rr + 4 * hi5;
#pragma unroll
            for (int tt = 0; tt < 2; ++tt) *(LAS v2u*)(GG + (32 * tt + r32) * ROWP + ch0 * 2) = ost[c][rr][tt]; }
    __syncthreads();
    branch_tail(C, l, row0, GG, ssq, rstd_l, TP, 1024);
}

template <int W> DI void pool_diff(const Ctx& C, int l, bool samp, int b, int n, int row0, int gi, int th, int lane, LAS unsigned char* DF) {
    const int t0 = 32 * th + 8 * (lane >> 4), ch0 = 128 * gi + 8 * (lane & 15);
    const float* sp = C.in[I_SPOOL] + (size_t)(l * NBS + b) * 15 * 512;
    float x[W + 7][8];
#pragma unroll
    for (int i = 0; i < W + 7; ++i) { const int rel = t0 - (W - 1) + i;
        if (rel >= 0 || (!samp && n > 0)) unpack8(*(const v4u*)(C.PROJ + (size_t)(row0 + rel) * NIN + COL_UP + ch0), x[i]);
        else if (samp) { const float* s = sp + (size_t)(15 + rel) * 512 + ch0; const f32x4 a = *(const f32x4*)s, c4 = *(const f32x4*)(s + 4); x[i][0] = a.x; x[i][1] = a.y; x[i][2] = a.z; x[i][3] = a.w; x[i][4] = c4.x; x[i][5] = c4.y; x[i][6] = c4.z; x[i][7] = c4.w; }
        else {
#pragma unroll
            for (int e = 0; e < 8; ++e) x[i][e] = 0.f; } }
    const bool last = samp || n == 63;
    float* po = C.out + (samp ? O_PS + (size_t)(l * NBS + b) * 15 * 512 : O_PP + (size_t)(l * NBP + b) * 15 * 512);
#pragma unroll
    for (int tt = 0; tt < 8; ++tt) { const int t = t0 + tt, pos = 64 * n + t; float d[8];
        const float cnt = samp ? (float)W : (float)((pos + 1 < W) ? pos + 1 : W), ic = 1.f / cnt;
#pragma unroll
        for (int e = 0; e < 8; ++e) { float s = 0.f;
#pragma unroll
            for (int j = 0; j < W; ++j) s += x[tt + j][e];
            d[e] = s * ic - x[tt + W - 1][e]; }
        v4u o; o.x = pk2(d[0], d[1]); o.y = pk2(d[2], d[3]); o.z = pk2(d[4], d[5]); o.w = pk2(d[6], d[7]);
        *(LAS v4u*)(DF + t * ROWP + ch0 * 2) = o;
        if (last && t >= 49) { float* p = po + (size_t)(t - 49) * 512 + ch0; *(f32x4*)p = (f32x4){x[tt + W - 1][0], x[tt + W - 1][1], x[tt + W - 1][2], x[tt + W - 1][3]}; *(f32x4*)(p + 4) = (f32x4){x[tt + W - 1][4], x[tt + W - 1][5], x[tt + W - 1][6], x[tt + W - 1][7]}; } }
}
DI void pool_unit(const Ctx& C0, int l, int u) {
    Ctx C = C0; fresh(C);
    const int lane = C.lane, wave = C.wave; const bool samp = u >= 512;
    const int b = samp ? u - 512 : (u >> 6), n = samp ? 0 : (u & 63), row0 = samp ? MP + 64 * b : b * LP + 64 * n;
    LAS unsigned char* DF = C.lds; LAS float* ssq = (LAS float*)(C.lds + 64 * ROWP); LAS float* rstd_l = ssq + 512;
    { const int gi = wave >> 1, th = wave & 1;
      if (gi == 0) pool_diff<2>(C, l, samp, b, n, row0, 0, th, lane, DF); else if (gi == 1) pool_diff<4>(C, l, samp, b, n, row0, 1, th, lane, DF);
      else if (gi == 2) pool_diff<8>(C, l, samp, b, n, row0, 2, th, lane, DF); else pool_diff<16>(C, l, samp, b, n, row0, 3, th, lane, DF); }
    TailPre TP; tail_prefetch(C, row0, COL_ZP, TP);
    __syncthreads();
    const int hi5 = lane >> 5, r32 = lane & 31, gi = wave >> 1;
    f32x16 acc[2][2];
#pragma unroll
    for (int c = 0; c < 2; ++c) { acc[c][0] = f32x16{}; acc[c][1] = f32x16{}; }
    const bf16x8* WP = (const bf16x8*)(C.ws + WS_WPOOL) + (size_t)((l * 4 + gi) * 32) * 64 + lane;
#pragma unroll
    for (int kap = 0; kap < 8; ++kap) { bf16x8 af[2], bt[2];
#pragma unroll
        for (int c = 0; c < 2; ++c) af[c] = WP[(size_t)((2 * (wave & 1) + c) * 8 + kap) * 64];
#pragma unroll
        for (int tt = 0; tt < 2; ++tt) bt[tt] = *(const LAS bf16x8*)(DF + (32 * tt + r32) * ROWP + (128 * gi + 16 * kap + 8 * hi5) * 2);
#pragma unroll
        for (int c = 0; c < 2; ++c)
#pragma unroll
            for (int tt = 0; tt < 2; ++tt) acc[c][tt] = mfma32(af[c], bt[tt], acc[c][tt]); }
    const float* ps = C.in[I_PSCALE] + (size_t)l * 512;
    float sq[2] = {0.f, 0.f};
#pragma unroll
    for (int c = 0; c < 2; ++c)
#pragma unroll
        for (int rr = 0; rr < 4; ++rr) { const int d0 = 128 * gi + 32 * (2 * (wave & 1) + c) + 8 * rr + 4 * hi5; const f32x4 sc = *(const f32x4*)(ps + d0);
#pragma unroll
            for (int tt = 0; tt < 2; ++tt)
#pragma unroll
                for (int e = 0; e < 4; ++e) { const float o = acc[c][tt][4 * rr + e] * sc[e]; acc[c][tt][4 * rr + e] = o; sq[tt] += o * o; } }
#pragma unroll
    for (int tt = 0; tt < 2; ++tt) { const float t = xh_sum(sq[tt]); if (hi5 == 0) ssq[wave * 64 + 32 * tt + r32] = t; }
    __syncthreads();
#pragma unroll
    for (int c = 0; c < 2; ++c)
#pragma unroll
        for (int rr = 0; rr < 4; ++rr) { const int d0 = 128 * gi + 32 * (2 * (wave & 1) + c) + 8 * rr + 4 * hi5;
#pragma unroll
            for (int tt = 0; tt < 2; ++tt) { v2u o; o.x = pk2(acc[c][tt][4 * rr], acc[c][tt][4 * rr + 1]); o.y = pk2(acc[c][tt][4 * rr + 2], acc[c][tt][4 * rr + 3]);
                *(LAS v2u*)(DF + (32 * tt + r32) * ROWP + d0 * 2) = o; } }
    __syncthreads();
    branch_tail(C, l, row0, DF, ssq, rstd_l, TP, 1536);
}

constexpr int AT_STG = 65536, AT_TAB = 2 * AT_STG, AT_SSQ = AT_TAB + 2 * 4 * 384 * 4, AT_RSTD = AT_SSQ + 8 * 32 * 4, AT_FLAG = AT_RSTD + 256;
DI void attn_unit(const Ctx& C0, int l, int ucode) {
    Ctx C = C0; fresh(C);
    const int lane = C.lane, wave = C.wave, r32 = lane & 31, hi = lane >> 5, hd = wave >> 1, qh = wave & 1; const bool samp = (ucode >> 16) & 1;
    const int b = (ucode >> 8) & 255, n = samp ? 16 : (ucode & 255), rq0 = samp ? MP + 64 * b : b * LP + 64 * n;
    const int jstart = samp ? 0 : (n >= 8 ? 0 : 8 - n), nt = 9 - jstart, nsteps = 4 * nt;
    unsigned long long jseq = 0ull; { int cnt = 0; for (int k = 0; k < 9; ++k) { const int jj = samp ? k : (((k - (n - 8)) % 9) + 9) % 9; if (jj >= jstart) { jseq |= (unsigned long long)jj << (4 * cnt); ++cnt; } } }
    auto jof = [&](int ti) { return (int)((jseq >> (4 * ti)) & 15ull); };
    LAS unsigned char* KV = C.lds + hd * 16384;
    LAS float* TAB = (LAS float*)(C.lds + AT_TAB) + hd * 384;
    LAS float* ssq = (LAS float*)(C.lds + AT_SSQ); LAS float* rstd_l = (LAS float*)(C.lds + AT_RSTD); LAS volatile int* flag = (LAS volatile int*)(C.lds + AT_FLAG);
    if (C.tid < 8) flag[C.tid] = 0;
    __syncthreads();
    const float c1 = 0.125f * LOG2E;
    const int qi = 32 * qh + r32, sw = (r32 >> 1) & 7;
    auto issue = [&](int h, int j, auto STC) {
        constexpr int st = decltype(STC)::value;
        const char* src; unsigned pitchB;
        if (samp && j < 8) { src = (const char*)((qh ? C.VC : C.KC) + ((size_t)(l * NBS + b) * 512 + 64 * j) * 1024 + h * 64); pitchB = 2048u; }
        else { const size_t row = samp ? (size_t)rq0 : (size_t)(b * LP + 64 * (n - 8 + j)); src = (const char*)(C.PROJ + row * NIN + (qh ? COL_V : COL_K) + h * 64); pitchB = (unsigned)NIN * 2u; }
        LAS unsigned char* dst = KV + st * AT_STG + qh * 8192;
        if (qh == 0) { const unsigned rl = (unsigned)lane >> 3, cl = (unsigned)lane & 7u, sw0 = (rl >> 1) & 3u;
            const unsigned vo0 = rl * pitchB + ((cl ^ sw0) << 4), vo1 = rl * pitchB + ((cl ^ (sw0 | 4u)) << 4);
#pragma unroll
            for (int pc = 0; pc < 8; ++pc) __builtin_amdgcn_global_load_lds((const unsigned*)(src + (size_t)(8u * pc * pitchB) + ((pc & 1) ? vo1 : vo0)), (LAS unsigned*)(dst + pc * 1024), 16, 0, 0);
        } else { const unsigned vo = ((unsigned)lane >> 2) * pitchB + (((unsigned)lane & 3u) << 4);
#pragma unroll
            for (int pc = 0; pc < 8; ++pc) __builtin_amdgcn_global_load_lds((const unsigned*)(src + (size_t)(16u * (pc & 3) * pitchB + (pc >> 2) * 64u) + vo), (LAS unsigned*)(dst + pc * 1024), 16, 0, 0);
        }
    };
    float tv[3];
    auto tab_load = [&](int h) { const float* rb = C.in[I_RELB] + (size_t)(l * 16 + h) * 513;
#pragma unroll
        for (int k = 0; k < 3; ++k) { const int y = 192 * qh + lane + 64 * k; tv[k] = rb[y < 64 ? 512 : 576 - y]; } };
    auto tab_store = [&](int buf) {
#pragma unroll
        for (int k = 0; k < 3; ++k) TAB[buf * 1536 + 192 * qh + lane + 64 * k] = tv[k] * LOG2E; };
    bf16x8 qf[4], qn[4];
    auto q_load = [&](int h, bf16x8 (&q)[4]) { const bf16* qp = C.PROJ + (size_t)(rq0 + qi) * NIN + COL_Q + h * 64 + 8 * hi;
#pragma unroll
        for (int k = 0; k < 4; ++k) q[k] = ld8(qp + 16 * k); };
    tab_load(hd); tab_store(0); q_load(hd, qf); issue(hd, jof(0), std::integral_constant<int, 0>{});
    f32x16 O[2], negm, Lacc; float mref = 0.f, ssq_acc = 0.f;
    O[0] = f32x16{}; O[1] = f32x16{}; negm = f32x16{}; Lacc = f32x16{};
    const bf16x8 ones8 = {0x3F80, 0x3F80, 0x3F80, 0x3F80, 0x3F80, 0x3F80, 0x3F80, 0x3F80};
    int hg = 0, ti = 0;
    auto step = [&](int s, auto CURC) {
        constexpr int cur = decltype(CURC)::value;
        const int h = 4 * hg + hd, j = jof(ti);
        __builtin_amdgcn_s_waitcnt(0);
        if (lane == 0) flag[wave] = s + 1;
        while (__builtin_amdgcn_readfirstlane(flag[wave ^ 1]) < s + 1) { }
        asm volatile("" ::: "memory");
        if (s + 1 < nsteps) { if (ti + 1 < nt) issue(h, jof(ti + 1), std::integral_constant<int, (cur ^ 1)>{}); else issue(h + 4, jof(0), std::integral_constant<int, (cur ^ 1)>{}); }
        const bool lastt = (ti == nt - 1), more = lastt && hg < 3;
        if (more) { tab_load(h + 4); q_load(h + 4, qn); }
        LAS const unsigned char* Kst = KV + cur * AT_STG; LAS const unsigned char* Vst = Kst + 8192; LAS const float* T = TAB + (hg & 1) * 1536;
        f32x16 S[2];
        { bf16x8 kf[2][4];
          const unsigned ka = (unsigned)(uintptr_t)(Kst + r32 * 128);
#pragma unroll
          for (int k = 0; k < 4; ++k) { const unsigned ko = ka + (unsigned)(((2 * k + hi) ^ sw) << 4);
              asm volatile("ds_read_b128 %0, %1" : "=v"(kf[0][k]) : "v"(ko));
              asm volatile("ds_read_b128 %0, %1 offset:4096" : "=v"(kf[1][k]) : "v"(ko)); }
          asm volatile("s_waitcnt lgkmcnt(0)" : "+v"(kf[0][0]), "+v"(kf[0][1]), "+v"(kf[0][2]), "+v"(kf[0][3]), "+v"(kf[1][0]), "+v"(kf[1][1]), "+v"(kf[1][2]), "+v"(kf[1][3]));
#pragma unroll
          for (int k = 0; k < 4; ++k) { S[0] = mfma32(kf[0][k], qf[k], k == 0 ? negm : S[0]); S[1] = mfma32(kf[1][k], qf[k], k == 0 ? negm : S[1]); } }
        float mx = -1e30f;
        if (j <= 3) { const float bconst = T[0];
#pragma unroll
            for (int kb = 0; kb < 2; ++kb)
#pragma unroll
                for (int r = 0; r < 16; ++r) { const float sv = S[kb][r] * c1 + bconst; S[kb][r] = sv; mx = fmaxf(mx, sv); }
        } else { const int ybase = 320 - 64 * (8 - j) - qi + 4 * hi;
#pragma unroll
            for (int kb = 0; kb < 2; ++kb)
#pragma unroll
                for (int r = 0; r < 16; ++r) { const float sv = S[kb][r] * c1 + T[ybase + 32 * kb + 8 * (r >> 2) + (r & 3)]; S[kb][r] = sv; mx = fmaxf(mx, sv); }
        }
        mx = xh_max(mx);
        if (__any(fabsf(mx) > 8.0f)) {
            mref += mx;
#pragma unroll
            for (int kb = 0; kb < 2; ++kb)
#pragma unroll
                for (int r = 0; r < 16; ++r) S[kb][r] -= mx;
            const float f = ex2(-mx), nm = -mref * (1.0f / c1);
#pragma unroll
            for (int r = 0; r < 16; ++r) { negm[r] = nm; O[0][r] *= f; O[1][r] *= f; Lacc[r] *= f; }
        }
#pragma unroll
        for (int kb = 0; kb < 2; ++kb)
#pragma unroll
            for (int r = 0; r < 16; ++r) S[kb][r] = ex2(S[kb][r]);
        bf16x8 pf[4];
#pragma unroll
        for (int ks = 0; ks < 4; ++ks) { const int kb = ks >> 1, s8 = 8 * (ks & 1); v4u w;
            w.x = pk2(S[kb][s8], S[kb][s8 + 1]); w.y = pk2(S[kb][s8 + 2], S[kb][s8 + 3]); w.z = pk2(S[kb][s8 + 4], S[kb][s8 + 5]); w.w = pk2(S[kb][s8 + 6], S[kb][s8 + 7]);
            pf[ks] = __builtin_bit_cast(bf16x8, w); }
#pragma unroll
        for (int ks = 0; ks < 4; ++ks) Lacc = mfma32(ones8, pf[ks], Lacc);
        LAS const unsigned char* vb = Vst + (4 * hi + ((lane & 15) >> 2)) * 64 + ((lane >> 4) & 1) * 32 + (lane & 3) * 8;
        const unsigned vba = (unsigned)(uintptr_t)vb;
#pragma unroll
        for (int kh = 0; kh < 2; ++kh) { s16x4 lo[2][2], up[2][2];
#pragma unroll
            for (int k2 = 0; k2 < 2; ++k2)
#pragma unroll
                for (int db = 0; db < 2; ++db) { const int ks = 2 * kh + k2;
                    asm volatile("ds_read_b64_tr_b16 %0, %1 offset:%2" : "=v"(lo[k2][db]) : "v"(vba), "i"(db * 4096 + ks * 1024));
                    asm volatile("ds_read_b64_tr_b16 %0, %1 offset:%2" : "=v"(up[k2][db]) : "v"(vba), "i"(db * 4096 + ks * 1024 + 512)); }
            asm volatile("s_waitcnt lgkmcnt(0)" : "+v"(lo[0][0]), "+v"(lo[0][1]), "+v"(lo[1][0]), "+v"(lo[1][1]), "+v"(up[0][0]), "+v"(up[0][1]), "+v"(up[1][0]), "+v"(up[1][1]));
#pragma unroll
            for (int k2 = 0; k2 < 2; ++k2)
#pragma unroll
                for (int db = 0; db < 2; ++db) { const bf16x8 vf = {lo[k2][db][0], lo[k2][db][1], lo[k2][db][2], lo[k2][db][3], up[k2][db][0], up[k2][db][1], up[k2][db][2], up[k2][db][3]};
                    O[db] = mfma32(vf, pf[2 * kh + k2], O[db]); } }
        if (lastt) {
            const float inv = 1.f / Lacc[0]; float sq = 0.f;
            bf16* yp = C.HY + (size_t)(rq0 + qi) * DM + h * 64 + 4 * hi;
#pragma unroll
            for (int db = 0; db < 2; ++db)
#pragma unroll
                for (int rr = 0; rr < 4; ++rr) { float o[4];
#pragma unroll
                    for (int e = 0; e < 4; ++e) { o[e] = O[db][4 * rr + e] * inv; sq += o[e] * o[e]; }
                    v2u w; w.x = pk2(o[0], o[1]); w.y = pk2(o[2], o[3]); *(v2u*)(yp + 32 * db + 8 * rr) = w; }
            ssq_acc += xh_sum(sq);
            O[0] = f32x16{}; O[1] = f32x16{}; negm = f32x16{}; Lacc = f32x16{}; mref = 0.f;
            if (more) { tab_store((hg + 1) & 1);
#pragma unroll
                for (int k = 0; k < 4; ++k) qf[k] = qn[k]; }
            ++hg; ti = 0;
        } else ++ti;
    };
    for (int s = 0; s < nsteps; s += 2) { step(s, std::integral_constant<int, 0>{}); step(s + 1, std::integral_constant<int, 1>{}); }
    if (hi == 0) ssq[wave * 32 + r32] = ssq_acc;
    asm volatile("s_waitcnt vmcnt(0)" ::: "memory");
    __syncthreads();
    if (C.tid < 64) { const int q2 = C.tid >> 5, rr = C.tid & 31; float t = 0.f;
#pragma unroll
        for (int w = 0; w < 4; ++w) t += ssq[(2 * w + q2) * 32 + rr];
        rstd_l[C.tid] = rsqrtf(t * (1.f / 1024.f) + EPSN); }
    __syncthreads();
    const float* gb = C.in[I_BNG] + (size_t)l * DM;
    const f32x4 g0 = *(const f32x4*)(gb + (C.tid & 127) * 8), g1 = *(const f32x4*)(gb + (C.tid & 127) * 8 + 4);
#pragma unroll 2
    for (int it = 0; it < 16; ++it) { const int idx = C.tid + 512 * it, row = idx >> 7, ch = idx & 127;
        bf16* yp = C.HY + (size_t)(rq0 + row) * DM + ch * 8;
        const v4u raw = *(const v4u*)yp; const v4u zz = *(const v4u*)(C.PROJ + (size_t)(rq0 + row) * NIN + COL_ZA + ch * 8);
        float r[8], z[8]; unpack8(raw, r); unpack8(zz, z); const float rs = rstd_l[row];
        const float gg[8] = {g0.x, g0.y, g0.z, g0.w, g1.x, g1.y, g1.z, g1.w}; float o[8];
#pragma unroll
        for (int e = 0; e < 8; ++e) o[e] = r[e] * rs * gg[e] * silu_f(z[e]);
        v4u w; w.x = pk2(o[0], o[1]); w.y = pk2(o[2], o[3]); w.z = pk2(o[4], o[5]); w.w = pk2(o[6], o[7]);
        *(v4u*)yp = w; }
    __syncthreads();
}

DI int q_issue(const Ctx& C0, unsigned* ctr) {
    Ctx C = C0; fresh(C);
    int v = 0; if (C.tid == 0) v = (int)__hip_atomic_fetch_add(ctr, 1u, __ATOMIC_RELAXED, __HIP_MEMORY_SCOPE_AGENT);
    return v;
}
DI int q_bcast(const Ctx& C0, int v) {
    Ctx C = C0; fresh(C);
    LAS volatile int* slot = (LAS volatile int*)(C.lds + MISC_OFF + 32);
    if (C.tid == 0) *slot = v;
    __syncthreads();
    const int r = *slot;
    __syncthreads();
    return r;
}
DI int attn_code(unsigned xx, unsigned v) { return (v < 64u) ? (int)((xx << 8) | (63u - v)) : (int)((1u << 16) | ((4u * xx + (v - 64u)) << 8)); }
DI int q_issue_attn(const Ctx& C0, unsigned* ctr8) {
    Ctx C = C0; fresh(C);
    int v = 0; if (C.tid == 0) v = (int)__hip_atomic_fetch_add(ctr8 + 64 * (xb_xcc_id() & 7u), 1u, __ATOMIC_RELAXED, __HIP_MEMORY_SCOPE_AGENT);
    return v;
}
DI int q_bcast_attn(const Ctx& C0, unsigned* ctr8, int v) {
    Ctx C = C0; fresh(C);
    LAS volatile int* slot = (LAS volatile int*)(C.lds + MISC_OFF + 32);
    if (C.tid == 0) { const unsigned x = xb_xcc_id() & 7u; int code = -1;
        if ((unsigned)v < 68u) code = attn_code(x, (unsigned)v);
        else for (unsigned k = 1; k < 8; ++k) { const unsigned xx = (x + k) & 7u; const unsigned w = __hip_atomic_fetch_add(ctr8 + 64 * xx, 1u, __ATOMIC_RELAXED, __HIP_MEMORY_SCOPE_AGENT);
            if (w < 68u) { code = attn_code(xx, w); break; } }
        *slot = code; }
    __syncthreads();
    const int r = *slot;
    __syncthreads();
    return r;
}
__global__ void __launch_bounds__(512, 2) hymba_fwd(Args args) {
    extern __shared__ __attribute__((aligned(16))) unsigned char lds_raw[];
    Ctx C; C.in = args.in; C.out = args.out; C.ws = args.ws; C.lds = (LAS unsigned char*)lds_raw;
    C.tid = threadIdx.x; C.lane = C.tid & 63; C.wave = __builtin_amdgcn_readfirstlane(C.tid >> 6); C.G = gridDim.x; C.bid = blockIdx.x;
    C.HY = (bf16*)(args.ws + WS_HY); C.HB = (bf16*)(args.ws + WS_HB); C.PROJ = (bf16*)(args.ws + WS_PROJ); C.KC = (bf16*)(args.ws + WS_KC); C.VC = (bf16*)(args.ws + WS_VC);
    C.WIN = (bf16*)(args.ws + WS_WIN); C.WOUT = (bf16*)(args.ws + WS_WOUT); C.MOD = (float*)(args.ws + WS_MOD); C.SSQ = (float*)(args.ws + WS_SSQ); C.SB = (float*)(args.ws + WS_SB); C.GS = (float*)(args.ws + WS_GS); C.ctl = (unsigned*)(args.ws + WS_CTL);
    if (C.tid < 16) ((LAS unsigned*)(C.lds + MISC_OFF))[C.tid] = 0u;
    __syncthreads();
    const int lo = args.ph_lo, hi = args.ph_hi;
    const bool multi = (hi - lo) > 1;
    XcdBarrier bar; bar.bar = C.ctl + CW_BAR; bar.x = 0; bar.st = nullptr;
    if (multi) bar = xcd_barrier_post(C.ctl + CW_BAR, (volatile LAS unsigned*)(C.lds + MISC_OFF));
#define IN(k) (lo <= (k) && (k) < hi)
#define SEAM(k) do { if (IN(k) && IN((k) + 1)) xcd_barrier(bar); } while (0)
    int ph = 0;
#define TP_B(k) do { if (TPROBE == (k) && blockIdx.x == 0 && threadIdx.x == 0) *(LAS volatile unsigned long long*)(C.lds + MISC_OFF + 40) = __builtin_amdgcn_s_memrealtime(); } while (0)
#define TP_E(k) do { if (TPROBE == (k) && blockIdx.x == 0 && threadIdx.x == 0) *(LAS volatile unsigned long long*)(C.lds + MISC_OFF + 48) += __builtin_amdgcn_s_memrealtime() - *(LAS volatile unsigned long long*)(C.lds + MISC_OFF + 40); } while (0)
#ifndef PHM
#define PHM 0xff
#endif
    TP_B(1); if ((PHM & 1) && IN(ph)) { p0_prologue(C, true); if (REP & 16) p0_prologue(C, false); }
    SEAM(ph); ++ph; TP_E(1);
    TP_B(2); if ((PHM & 2) && IN(ph)) p0b_phase(C);
    SEAM(ph); ++ph; TP_E(2);
    for (int l = 0; l < DEPTH; ++l) {
        TP_B(3); if ((PHM & 4) && IN(ph)) {
            pg8::Gemm g{C.HB, C.WIN + (size_t)l * NIN * DM, MT, NIN, DM}; pg8::G1Order S; S.init(MT, NIN, C.G, C.bid, (l > 0 && C.G == 256) ? 1 : 0, nullptr);
            pg8::EpiProj E{C.PROJ, C.out + O_KP + (size_t)l * NBP * 512 * 1024, C.out + O_VP + (size_t)l * NBP * 512 * 1024, C.out + O_KS + (size_t)l * NBS * 64 * 1024, C.out + O_VS + (size_t)l * NBS * 64 * 1024,
                           C.SSQ + (size_t)l * MT, C.SB + (size_t)l * 40 * NIN};
            pg8::gemm_phase<pg8::EpiProj, pg8::G1Order, true, true>(C.lds, g, S, E);
        }
        SEAM(ph); ++ph; TP_E(3); TP_B(4);
        if ((PHM & 8) && IN(ph)) { for (int u = C.bid; u < 512; u += C.G) ssm_local_unit(C, l, u); }
        SEAM(ph); ++ph;
        if ((PHM & 8) && IN(ph)) ssm_carry_phase(C, l);
        SEAM(ph); ++ph; TP_E(4); TP_B(5);
        if ((PHM & 0x70) && IN(ph)) {
            unsigned* ctr = C.ctl + CW_Q + 64 * 16 * l;
            TP_B(8); if (PHM & 0x10) { int tk = q_issue_attn(C, ctr); for (;;) { const int u = q_bcast_attn(C, ctr, tk); if (u < 0) break; tk = q_issue_attn(C, ctr); attn_unit(C, l, u); } } TP_E(8);
            TP_B(9); if (PHM & 0x20) { int tk = q_issue(C, ctr + 64 * 8); for (;;) { const int u = q_bcast(C, tk); if (u >= 544) break; tk = q_issue(C, ctr + 64 * 8); ssm_main_unit(C, l, u); } } TP_E(9);
            TP_B(10); if (PHM & 0x40) { int tk = q_issue(C, ctr + 64 * 9); for (;;) { const int u = q_bcast(C, tk); if (u >= 544) break; tk = q_issue(C, ctr + 64 * 9); pool_unit(C, l, u); } } TP_E(10);
        }
        SEAM(ph); ++ph; TP_E(5); TP_B(6);
        if ((PHM & 0x80) && IN(ph)) {
            unsigned* rbsig = C.ctl + CW_RB + 64 * l;
            pg8::Gemm g{C.HY, C.WOUT + (size_t)l * DM * DM, MT, DM, DM}; pg8::G2Order S; S.init(MT, DM, C.G, C.bid); S.sig = (l + 1 < DEPTH && C.G == 256) ? rbsig : nullptr; S.late = (C.bid >= 64); S.hits = 0;
            pg8::EpiRes E{l == 0 ? C.in[I_XP] : C.out, l == 0 ? C.in[I_XS] : C.out + (size_t)MP * DM, C.out, C.MOD + (size_t)l * 40 * NIN + 2 * DM,
                          (l + 1 < DEPTH) ? C.GS + (size_t)(l + 1) * 40 * DM : nullptr, C.HB, C.SSQ + (size_t)(l + 1) * MT};
            pg8::gemm_phase<pg8::EpiRes, pg8::G2Order, true, true>(C.lds, g, S, E);
            S.flush();
            if (l + 1 < DEPTH && C.bid >= 64) {
                __syncthreads();
                if (C.G == 256) { pg8::Gemm g1{C.HB, C.WIN + (size_t)(l + 1) * NIN * DM, MT, NIN, DM}; pg8::G1Order S1; S1.init(MT, NIN, C.G, C.bid, 2, rbsig);
                  pg8::EpiProj E1{C.PROJ, C.out + O_KP + (size_t)(l + 1) * NBP * 512 * 1024, C.out + O_VP + (size_t)(l + 1) * NBP * 512 * 1024, C.out + O_KS + (size_t)(l + 1) * NBS * 64 * 1024, C.out + O_VS + (size_t)(l + 1) * NBS * 64 * 1024,
                                  C.SSQ + (size_t)(l + 1) * MT, C.SB + (size_t)(l + 1) * 40 * NIN};
                  pg8::gemm_phase<pg8::EpiProj, pg8::G1Order, true, true>(C.lds, g1, S1, E1); }
                __syncthreads();
                for (int it = C.bid - 64; it < 256; it += C.G - 64) cache_item(C, l + 1, it); }
        }
        SEAM(ph); ++ph; TP_E(6);
    }
    TP_B(7); TP_B(11); if ((PHM & 2) && IN(ph)) final_norm_phase(C); TP_E(7);
    if (TPROBE == 11) { xcd_barrier(bar); TP_E(11); }
    if (TPROBE && blockIdx.x == 0 && threadIdx.x == 0) { const unsigned long long d = *(LAS volatile unsigned long long*)(C.lds + MISC_OFF + 48), t0 = __builtin_amdgcn_s_memrealtime();
        while (__builtin_amdgcn_s_memrealtime() - t0 < d) __builtin_amdgcn_s_sleep(8); }
#undef IN
#undef SEAM
}

#ifndef N_LAUNCH_MODE
#define N_LAUNCH_MODE 1
#endif
extern "C" void kernel_launch(void* const* d_in, const int* in_sizes, int n_in, void* d_out, int out_size, void* d_ws, size_t ws_size, hipStream_t stream) {
    static int grid = 0;
    if (grid == 0) {
        if (n_in != N_IN || (size_t)out_size != O_END || ws_size < WS_END) { fprintf(stderr, "kernel_launch: unexpected sizes n_in %d out %d ws %zu (need %zu)\n", n_in, out_size, ws_size, (size_t)WS_END); grid = -1; return; }
        int dev = 0, cus = 0, per_cu = 0;
        if (hipGetDevice(&dev) != hipSuccess || hipDeviceGetAttribute(&cus, hipDeviceAttributeMultiprocessorCount, dev) != hipSuccess) { grid = -1; return; }
        if (hipFuncSetAttribute((const void*)hymba_fwd, hipFuncAttributeMaxDynamicSharedMemorySize, LDS_BYTES) != hipSuccess) { fprintf(stderr, "kernel_launch: hipFuncSetAttribute failed\n"); grid = -1; return; }
        if (hipOccupancyMaxActiveBlocksPerMultiprocessor(&per_cu, (const void*)hymba_fwd, 512, LDS_BYTES) != hipSuccess || per_cu < 1) fprintf(stderr, "kernel_launch: occupancy query says %d\n", per_cu);
        (void)hipGetLastError();
        grid = cus;
    }
    if (grid < 0) return;
    (void)in_sizes;
    if (hipMemsetAsync((char*)d_ws + WS_CTL, 0, ZERO_BYTES, stream) != hipSuccess) return;
    Args a{};
    for (int i = 0; i < N_IN; ++i) a.in[i] = (const float*)d_in[i];
    a.out = (float*)d_out; a.ws = (unsigned char*)d_ws;
#if N_LAUNCH_MODE == 1
    a.ph_lo = 0; a.ph_hi = NPH;
    hipLaunchKernelGGL(hymba_fwd, dim3(grid), dim3(512), LDS_BYTES, stream, a);
#else
    for (int p = 0; p < NPH; ++p) { a.ph_lo = p; a.ph_hi = p + 1; hipLaunchKernelGGL(hymba_fwd, dim3(grid), dim3(512), LDS_BYTES, stream, a); }
#endif
}
```

```cpp
#include <hip/hip_runtime.h>
#include <cstdio>
#include <cstdint>
#include <type_traits>
namespace pg8 {
#define PG8_LAS __attribute__((address_space(3)))
typedef unsigned short bf16_t;
typedef short bf16x8 __attribute__((ext_vector_type(8)));
typedef float f32x4 __attribute__((ext_vector_type(4)));
typedef unsigned u32x4 __attribute__((ext_vector_type(4)));
constexpr int BM = 256, BK = 64, HALF = 128, HTB = HALF * BK * 2  , STAGE_BYTES = 8 * HTB, NXCD = 8, WGM = 8;

__host__ __device__ __forceinline__ int lds_byte(int r, int c) { const int st = (r >> 4) * 2 + (c >> 5), rr = r & 15, cc = c & 31, ob = rr * 64 + cc * 2; return st * 1024 + (ob ^ (((ob >> 9) & 1) << 5)); }
__host__ __device__ __forceinline__ void stage_rc(int b, int& R, int& C) { const int st = b / 1024, sb = b % 1024, swz = sb ^ (((sb >> 9) & 1) << 5); R = (st >> 1) * 16 + swz / 64; C = (st & 1) * 32 + (swz % 64) / 2; }
__host__ __device__ __forceinline__ int perm32(int rho) { const int n = rho >> 4, i = rho & 15; return 8 * (i >> 2) + 4 * n + (i & 3); }

struct Unit { int pm, pn; };
struct Gemm { const bf16_t* A; const bf16_t* Bt; int M, N, K; };

struct StaticOrder {
    int nM, nN, nwg, G, c;
    __host__ __device__ void init(int M, int N, int G_, int c_) { nM = M / BM; nN = N / BM; nwg = nM * nN; G = G_; c = c_; }
    __host__ __device__ bool next(int i, Unit& u) const {
        const long L = (long)i * G + c; if (L >= nwg) return false;
        int wgid = (int)L; { const int q = nwg / NXCD, r = nwg % NXCD, xcd = wgid % NXCD, off = wgid / NXCD; wgid = (xcd < r ? xcd * (q + 1) : r * (q + 1) + (xcd - r) * q) + off; }
        const int nig = WGM * nN, gid = wgid / nig, fm = gid * WGM, gsz = (nM - fm) < WGM ? (nM - fm) : WGM;
        u.pm = fm + ((wgid % nig) % gsz); u.pn = (wgid % nig) / gsz; return true;
    }
    __device__ __forceinline__ void a_ready(const Unit&) const {}
    __device__ __forceinline__ void done(const Unit&) const {}
};

__device__ __forceinline__ unsigned cvt_pk_bf16(float lo, float hi) { unsigned r; asm volatile("v_cvt_pk_bf16_f32 %0, %1, %2" : "=v"(r) : "v"(lo), "v"(hi)); return r; }
typedef float f32x2 __attribute__((ext_vector_type(2)));
struct EpiProj {
    static constexpr bool PERM = true, AFTER_DRAIN = false;
    bf16_t* O; float* kp; float* vp; float* ks; float* vs; const float* ssq; const float* sb;
    __device__ __forceinline__ void operator()(const f32x4 (&acc)[2][2][4][2], const Unit& u, int wr, int wc, int fr, int fq) const {
        const int lrow0 = wr * 64 + fr, col0 = u.pn * BM + wc * 32 + 8 * fq;
#if defined(TPROBE) && TPROBE == 15
        if (blockIdx.x == 0 && threadIdx.x == 0) *(volatile PG8_LAS unsigned long long*)(147456 - 64 + 40) = __builtin_amdgcn_s_memrealtime();
#endif
        float* fo = nullptr;
        const bool isk = (u.pn >= 4 && u.pn < 8), isv = (u.pn >= 8 && u.pn < 12);
        if (isk || isv) {
            if (u.pm >= 128) fo = (isk ? ks : vs) + (size_t)(u.pm - 128) * 256 * 1024;
            else if ((u.pm & 15) >= 14) fo = (isk ? kp : vp) + ((size_t)(u.pm >> 4) * 512 + (size_t)((u.pm & 15) - 14) * 256) * 1024;
        }
        const int fcol0 = (u.pn & 3) * 256 + wc * 32 + 8 * fq;
#pragma unroll
        for (int ai = 0; ai < 2; ++ai) {
            const int brow = (u.pm < 128) ? (u.pm >> 4) : (8 + (u.pm - 128) * 4 + 2 * ai + wr);
            const float* sbp = sb + (size_t)brow * 6144 + col0;
            const f32x4 s00 = *(const f32x4*)sbp, s01 = *(const f32x4*)(sbp + 4), s10 = *(const f32x4*)(sbp + HALF), s11 = *(const f32x4*)(sbp + HALF + 4);
#pragma unroll
            for (int m = 0; m < 4; ++m) { const int lr = lrow0 + ai * HALF + m * 16; const int row = u.pm * BM + lr; bf16_t* rowp = O + (size_t)row * 6144 + col0;
                const float rs = rsqrtf(ssq[row] * (1.0f / 2048.0f) + 1e-6f);
                { const f32x4 v0 = acc[ai][0][m][0] * rs + s00, v1 = acc[ai][0][m][1] * rs + s01;
                  u32x4 w; w.x = cvt_pk_bf16(v0[0], v0[1]); w.y = cvt_pk_bf16(v0[2], v0[3]); w.z = cvt_pk_bf16(v1[0], v1[1]); w.w = cvt_pk_bf16(v1[2], v1[3]); *(u32x4*)rowp = w;
                  if (fo) { float* fp = fo + (size_t)lr * 1024 + fcol0; *(f32x4*)fp = v0; *(f32x4*)(fp + 4) = v1; } }
                { const f32x4 v0 = acc[ai][1][m][0] * rs + s10, v1 = acc[ai][1][m][1] * rs + s11;
                  u32x4 w; w.x = cvt_pk_bf16(v0[0], v0[1]); w.y = cvt_pk_bf16(v0[2], v0[3]); w.z = cvt_pk_bf16(v1[0], v1[1]); w.w = cvt_pk_bf16(v1[2], v1[3]); *(u32x4*)(rowp + HALF) = w;
                  if (fo) { float* fp = fo + (size_t)lr * 1024 + fcol0 + HALF; *(f32x4*)fp = v0; *(f32x4*)(fp + 4) = v1; } } }
        }
#if defined(TPROBE) && TPROBE == 15
        if (blockIdx.x == 0 && threadIdx.x == 0) { asm volatile("s_waitcnt vmcnt(0)" ::: "memory"); *(volatile PG8_LAS unsigned long long*)(147456 - 64 + 48) += __builtin_amdgcn_s_memrealtime() - *(volatile PG8_LAS unsigned long long*)(147456 - 64 + 40); }
#endif
    }
};
struct EpiRes {
    static constexpr bool PERM = false, AFTER_DRAIN = false;
    const float* xin_p; const float* xin_s; float* xout; const float* gate; const float* gs; bf16_t* hout; float* ssqn;
    __device__ __forceinline__ void operator()(const f32x4 (&acc)[2][2][4][2], const Unit& u, int wr, int wc, int fr, int fq) const {
        typedef unsigned u32x2 __attribute__((ext_vector_type(2)));
#if defined(TPROBE) && TPROBE == 14
        if (blockIdx.x == 0 && threadIdx.x == 0) *(volatile PG8_LAS unsigned long long*)(147456 - 64 + 40) = __builtin_amdgcn_s_memrealtime();
#endif
        const int col0 = u.pn * BM + wc * 32 + 4 * fq;
        const int r0 = u.pm * BM + wr * 64 + fr;
        const float* xbase = (u.pm < 128) ? (xin_p + (size_t)r0 * 2048 + col0) : (xin_s + (size_t)(r0 - 32768) * 2048 + col0);
        f32x4 xr[3][2][2];
#define EPR_LOAD(i) do { const int _ro = ((i) >> 2) * HALF + ((i) & 3) * 16; _Pragma("unroll") for (int bj = 0; bj < 2; ++bj) _Pragma("unroll") for (int n = 0; n < 2; ++n) xr[(i) % 3][bj][n] = *(const f32x4*)(xbase + (size_t)_ro * 2048 + bj * HALF + n * 16); } while (0)
        EPR_LOAD(0); EPR_LOAD(1);
#pragma unroll
        for (int ai = 0; ai < 2; ++ai) {
            const int brow = (u.pm < 128) ? (u.pm >> 4) : (8 + (u.pm - 128) * 4 + 2 * ai + wr);
            f32x4 gv[2][2], gsv[2][2];
#pragma unroll
            for (int bj = 0; bj < 2; ++bj)
#pragma unroll
                for (int n = 0; n < 2; ++n) { gv[bj][n] = *(const f32x4*)(gate + (size_t)brow * 6144 + col0 + bj * HALF + n * 16);
                    gsv[bj][n] = gs ? *(const f32x4*)(gs + (size_t)brow * 2048 + col0 + bj * HALF + n * 16) : (f32x4){0.f, 0.f, 0.f, 0.f}; }
#pragma unroll
            for (int m = 0; m < 4; ++m) { const int i = ai * 4 + m, roff = ai * HALF + m * 16, r = r0 + roff;
                if (i + 2 < 8) EPR_LOAD(i + 2);
                float* xo = xout + (size_t)r * 2048 + col0; bf16_t* ho = hout + (size_t)r * 2048 + col0;
                float part = 0.f;
#pragma unroll
                for (int bj = 0; bj < 2; ++bj)
#pragma unroll
                    for (int n = 0; n < 2; ++n) { const int c = bj * HALF + n * 16; const f32x4 xn = xr[i % 3][bj][n] + gv[bj][n] * acc[ai][bj][m][n];
                        *(f32x4*)(xo + c) = xn; part += (xn[0] * xn[0] + xn[1] * xn[1]) + (xn[2] * xn[2] + xn[3] * xn[3]);
                        if (gs) { const f32x4 h = xn * gsv[bj][n]; u32x2 w; w.x = cvt_pk_bf16(h[0], h[1]); w.y = cvt_pk_bf16(h[2], h[3]); *(u32x2*)(ho + c) = w; } }
                { auto r16 = __builtin_amdgcn_permlane16_swap(__float_as_uint(part), __float_as_uint(part), false, false); part = __uint_as_float(r16[0]) + __uint_as_float(r16[1]);
                  auto r32 = __builtin_amdgcn_permlane32_swap(__float_as_uint(part), __float_as_uint(part), false, false); part = __uint_as_float(r32[0]) + __uint_as_float(r32[1]); }
                if (fq == 0) unsafeAtomicAdd(ssqn + r, part);
                asm volatile("" ::: "memory"); }
        }
#undef EPR_LOAD
#if defined(TPROBE) && TPROBE == 14
        if (blockIdx.x == 0 && threadIdx.x == 0) { asm volatile("s_waitcnt vmcnt(0)" ::: "memory"); *(volatile PG8_LAS unsigned long long*)(147456 - 64 + 48) += __builtin_amdgcn_s_memrealtime() - *(volatile PG8_LAS unsigned long long*)(147456 - 64 + 40); }
#endif
    }
};

struct G2Order : StaticOrder {
    unsigned* sig; bool late; mutable int hits;
    __device__ __forceinline__ void done(const Unit& u) const {
        if (sig && u.pm < 8) {
            if (late) ++hits;
            else { asm volatile("s_waitcnt vmcnt(0)" ::: "memory"); __syncthreads();
                if (threadIdx.x == 0) { __builtin_amdgcn_fence(__ATOMIC_RELEASE, "agent"); asm volatile("s_waitcnt vmcnt(0)" ::: "memory"); __hip_atomic_fetch_add(sig, 1u, __ATOMIC_RELAXED, __HIP_MEMORY_SCOPE_AGENT); } } }
    }
    __device__ __forceinline__ void flush() const {
        if (sig && late && hits > 0) { asm volatile("s_waitcnt vmcnt(0)" ::: "memory"); __syncthreads();
            if (threadIdx.x == 0) { __builtin_amdgcn_fence(__ATOMIC_RELEASE, "agent"); asm volatile("s_waitcnt vmcnt(0)" ::: "memory"); __hip_atomic_fetch_add(sig, (unsigned)hits, __ATOMIC_RELAXED, __HIP_MEMORY_SCOPE_AGENT); } }
    }
};
struct G1Order {
    StaticOrder so; int mode; const unsigned* sig;
    __device__ void init(int M, int N, int G_, int c_, int mode_, const unsigned* sig_) { mode = mode_; sig = sig_; so.init(mode_ == 1 ? M - 8 * BM : M, N, G_, c_); }
    __device__ bool next(int i, Unit& u) const {
        if (mode == 2) { if (i > 0) return false; const int e = so.c - 64, x = e & 7, t = e >> 3; u.pn = 3 * x + t % 3; u.pm = t / 3; return true; }
        if (!so.next(i, u)) return false;
        if (mode == 1) u.pm += 8;
        return true;
    }
    __device__ __forceinline__ void a_ready(const Unit&) const {
        if (mode == 2) { if (threadIdx.x == 0) { while (__hip_atomic_load(sig, __ATOMIC_RELAXED, __HIP_MEMORY_SCOPE_AGENT) < 64u) __builtin_amdgcn_s_sleep(8);
                __builtin_amdgcn_fence(__ATOMIC_ACQUIRE, "agent"); asm volatile("s_waitcnt vmcnt(0)" ::: "memory"); }
            __syncthreads(); }
    }
    __device__ __forceinline__ void done(const Unit&) const {}
};
template <class Epi, class Sched, bool ALIGN_EPI = false, bool SP2 = false>
__device__ __forceinline__ void gemm_phase(PG8_LAS unsigned char* lds, const Gemm g, const Sched& S, const Epi& E) {
    int tid_ = threadIdx.x; asm volatile("" : "+v"(tid_));
    const int tid = tid_, wid = __builtin_amdgcn_readfirstlane(tid >> 6), lane = tid & 63, wr = wid >> 2, wc = wid & 3, fr = lane & 15, fq = lane >> 4;
    const int K = g.K, nt = K / BK;
    unsigned voffA[2], voffB[2];
#pragma unroll
    for (int i = 0; i < 2; ++i) { int R, C; stage_rc(tid * 16 + i * 8192, R, C); const int Rb = Epi::PERM ? ((R & ~31) + perm32(R & 31)) : R;
        voffA[i] = (unsigned)(R * K + C) * 2u; voffB[i] = (unsigned)(Rb * K + C) * 2u; }
    const size_t kstep = (size_t)(BK * 2);
    const size_t hstep = (size_t)HALF * K * 2;
    const size_t tstep = 2 * hstep;
    const unsigned ldsw = (unsigned)wid * 1024u;
    const int aoff = lds_byte(wr * 64 + fr, fq * 8), boff = lds_byte(wc * 32 + fr, fq * 8);
#define PG8_SA(b, h) (((b) * 2 + (h)) * HTB)
#define PG8_SB(b, h) ((4 + (b) * 2 + (h)) * HTB)
#define PG8_STAGE(bufoff, gbase, voff) do { _Pragma("unroll") for (int _i = 0; _i < 2; ++_i) \
        __builtin_amdgcn_global_load_lds((const unsigned*)((const char*)(gbase) + (voff)[_i]), (PG8_LAS unsigned*)(lds + (bufoff) + ldsw + _i * 8192), 16, 0, 0); } while (0)
#define PG8_LDA(dst, b, h) do { _Pragma("unroll") for (int m = 0; m < 4; ++m) _Pragma("unroll") for (int k = 0; k < 2; ++k) dst[m][k] = *(const PG8_LAS bf16x8*)(lds + PG8_SA(b, h) + aoff + m * 2048 + k * 1024); } while (0)
#define PG8_LDB(dst, b, h) do { _Pragma("unroll") for (int n = 0; n < 2; ++n) _Pragma("unroll") for (int k = 0; k < 2; ++k) dst[n][k] = *(const PG8_LAS bf16x8*)(lds + PG8_SB(b, h) + boff + n * 2048 + k * 1024); } while (0)
#define PG8_MMA(ai, bj, At, Bt) do { __builtin_amdgcn_s_setprio(1); _Pragma("unroll") for (int m = 0; m < 4; ++m) _Pragma("unroll") for (int n = 0; n < 2; ++n) _Pragma("unroll") for (int k = 0; k < 2; ++k) \
        acc[ai][bj][m][n] = __builtin_amdgcn_mfma_f32_16x16x32_bf16(Bt[n][k], At[m][k], acc[ai][bj][m][n], 0, 0, 0); __builtin_amdgcn_s_setprio(0); } while (0)
#define PG8_WAIT_V(n) asm volatile("s_waitcnt vmcnt(" #n ")" ::: "memory")
#define PG8_WAIT_L(n) asm volatile("s_waitcnt lgkmcnt(" #n ")" ::: "memory")
#define PG8_BAR __builtin_amdgcn_s_barrier()
#define PG8_SCHED __builtin_amdgcn_sched_barrier(0)
    Unit cur, nxt; int ui = 0;
    if (!S.next(0, cur)) return;
    f32x4 acc[2][2][4][2];
#pragma unroll
    for (int a = 0; a < 2; ++a)
#pragma unroll
        for (int b = 0; b < 2; ++b)
#pragma unroll
            for (int m = 0; m < 4; ++m)
#pragma unroll
                for (int n = 0; n < 2; ++n) acc[a][b][m][n] = (f32x4){0.f, 0.f, 0.f, 0.f};
    bf16x8 At[4][2], B0[2][2], B1[2][2];
    const char* cA = (const char*)g.A + (size_t)cur.pm * tstep; const char* cB = (const char*)g.Bt + (size_t)cur.pn * tstep;
    S.a_ready(cur);
    if constexpr (SP2) {
        PG8_STAGE(PG8_SB(0, 0), cB, voffB); PG8_STAGE(PG8_SB(0, 1), cB + hstep, voffB); PG8_STAGE(PG8_SA(0, 0), cA, voffA); PG8_STAGE(PG8_SA(0, 1), cA + hstep, voffA);
        if (wr == 1) PG8_BAR;
        PG8_WAIT_V(2); PG8_BAR;
        PG8_STAGE(PG8_SB(1, 0), cB + kstep, voffB); PG8_STAGE(PG8_SA(1, 0), cA + kstep, voffA); PG8_STAGE(PG8_SB(1, 1), cB + hstep + kstep, voffB);
        PG8_WAIT_V(6); PG8_BAR;
    } else {
        PG8_STAGE(PG8_SB(0, 0), cB, voffB); PG8_STAGE(PG8_SA(0, 0), cA, voffA); PG8_STAGE(PG8_SB(0, 1), cB + hstep, voffB); PG8_STAGE(PG8_SA(0, 1), cA + hstep, voffA);
        if (wr == 1) PG8_BAR;
        PG8_WAIT_V(4); PG8_BAR;
        PG8_STAGE(PG8_SB(1, 0), cB + kstep, voffB); PG8_STAGE(PG8_SA(1, 0), cA + kstep, voffA); PG8_STAGE(PG8_SB(1, 1), cB + hstep + kstep, voffB);
        PG8_WAIT_V(6); PG8_BAR;
    }
    for (;;) {
        const bool has_next = S.next(ui + 1, nxt);
        const char* nA = has_next ? (const char*)g.A + (size_t)nxt.pm * tstep : cA; const char* nB = has_next ? (const char*)g.Bt + (size_t)nxt.pn * tstep : cB;
        for (int t = 0; t < nt; t += 2) {
            const bool last = (t == nt - 2);
            const char* a1 = cA + (size_t)(t + 1) * kstep;
            const char* a2 = last ? nA : cA + (size_t)(t + 2) * kstep; const char* b2 = last ? nB : cB + (size_t)(t + 2) * kstep;
            const char* a3 = a2 + kstep; const char* b3 = b2 + kstep;
            if (last && has_next) S.a_ready(nxt);
            if constexpr (SP2) {
            PG8_LDB(B0, 0, 0); PG8_LDB(B1, 0, 1); PG8_SCHED; PG8_LDA(At, 0, 0); PG8_STAGE(PG8_SA(1, 1), a1 + hstep, voffA);
            PG8_WAIT_V(8); PG8_WAIT_L(0); PG8_BAR; PG8_MMA(0, 0, At, B0); PG8_MMA(0, 1, At, B1); PG8_BAR; PG8_SCHED;
            PG8_LDA(At, 0, 1); PG8_STAGE(PG8_SB(0, 0), b2, voffB); PG8_STAGE(PG8_SB(0, 1), b2 + hstep, voffB); PG8_STAGE(PG8_SA(0, 0), a2, voffA);
            PG8_WAIT_V(8); PG8_WAIT_L(0); PG8_BAR; PG8_MMA(1, 0, At, B0); PG8_MMA(1, 1, At, B1); PG8_BAR; PG8_SCHED;
            PG8_LDB(B0, 1, 0); PG8_LDB(B1, 1, 1); PG8_SCHED; PG8_LDA(At, 1, 0); PG8_STAGE(PG8_SA(0, 1), a2 + hstep, voffA);
            PG8_WAIT_V(8); PG8_WAIT_L(0); PG8_BAR; PG8_MMA(0, 0, At, B0); PG8_MMA(0, 1, At, B1); PG8_BAR; PG8_SCHED;
            PG8_LDA(At, 1, 1); PG8_STAGE(PG8_SB(1, 0), b3, voffB); PG8_STAGE(PG8_SB(1, 1), b3 + hstep, voffB); PG8_STAGE(PG8_SA(1, 0), a3, voffA);
            PG8_WAIT_V(8); PG8_WAIT_L(0); PG8_BAR; PG8_MMA(1, 0, At, B0); PG8_MMA(1, 1, At, B1); PG8_BAR; PG8_SCHED;
            } else {
            PG8_LDB(B0, 0, 0); PG8_SCHED; PG8_LDA(At, 0, 0); PG8_STAGE(PG8_SA(1, 1), a1 + hstep, voffA);
            PG8_WAIT_L(8); PG8_BAR; PG8_WAIT_L(0); PG8_MMA(0, 0, At, B0); PG8_BAR; PG8_SCHED;
            PG8_LDB(B1, 0, 1); PG8_STAGE(PG8_SB(0, 0), b2, voffB);
            PG8_BAR; PG8_WAIT_L(0); PG8_MMA(0, 1, At, B1); PG8_BAR;
            PG8_LDA(At, 0, 1); PG8_STAGE(PG8_SA(0, 0), a2, voffA);
            PG8_BAR; PG8_WAIT_L(0); PG8_MMA(1, 0, At, B0); PG8_BAR; PG8_SCHED;
            PG8_STAGE(PG8_SB(0, 1), b2 + hstep, voffB);
            PG8_WAIT_V(6); PG8_BAR; PG8_MMA(1, 1, At, B1); PG8_BAR;
            PG8_LDB(B0, 1, 0); PG8_SCHED; PG8_LDA(At, 1, 0); PG8_STAGE(PG8_SA(0, 1), a2 + hstep, voffA);
            PG8_WAIT_L(8); PG8_BAR; PG8_WAIT_L(0); PG8_MMA(0, 0, At, B0); PG8_BAR; PG8_SCHED;
            PG8_LDB(B1, 1, 1); PG8_STAGE(PG8_SB(1, 0), b3, voffB);
            PG8_BAR; PG8_WAIT_L(0); PG8_MMA(0, 1, At, B1); PG8_BAR;
            PG8_LDA(At, 1, 1); PG8_STAGE(PG8_SA(1, 0), a3, voffA);
            PG8_BAR; PG8_WAIT_L(0); PG8_MMA(1, 0, At, B0); PG8_BAR; PG8_SCHED;
            PG8_STAGE(PG8_SB(1, 1), b3 + hstep, voffB);
            PG8_WAIT_V(6); PG8_BAR; PG8_MMA(1, 1, At, B1); PG8_BAR;
            }
        }
        if constexpr (ALIGN_EPI) { if (wr == 0) PG8_BAR; }
        if constexpr (!Epi::AFTER_DRAIN) { E(acc, cur, wr, wc, fr, fq); S.done(cur); }
        if (!has_next) break;
#pragma unroll
        for (int a = 0; a < 2; ++a)
#pragma unroll
            for (int b = 0; b < 2; ++b)
#pragma unroll
                for (int m = 0; m < 4; ++m)
#pragma unroll
                    for (int n = 0; n < 2; ++n) acc[a][b][m][n] = (f32x4){0.f, 0.f, 0.f, 0.f};
        cur = nxt; cA = nA; cB = nB; ++ui;
        if constexpr (ALIGN_EPI) { if (wr == 1) PG8_BAR; }
    }
    PG8_WAIT_V(0);
    if constexpr (!ALIGN_EPI) { if (wr == 0) PG8_BAR; }
    PG8_BAR;
    if constexpr (Epi::AFTER_DRAIN) { E.fused(acc, cur, wr, wc, fr, fq, lds, wid, lane); S.done(cur); }
#undef PG8_SA
#undef PG8_SB
#undef PG8_STAGE
#undef PG8_LDA
#undef PG8_LDB
#undef PG8_MMA
#undef PG8_WAIT_V
#undef PG8_WAIT_L
#undef PG8_BAR
#undef PG8_SCHED
}
}
#define LAS __attribute__((address_space(3)))
#define XB_TMO      128
#define XB_XCNT(j)  (256  + 64 * (j))
#define XB_XSUB(j)  (1280 + 64 * (j))
#define XB_XGEN(j)  (2304 + 64 * (j))
#define XB_TOP      3328
#define XB_TOPGEN   3392
#define XCD_BAR_WORDS 3456
#define XB_SPIN_CAP (1u << 18)
#define LAS __attribute__((address_space(3)))

__device__ __forceinline__ unsigned xb_ld(unsigned* p)              { return __hip_atomic_load(p, __ATOMIC_RELAXED, __HIP_MEMORY_SCOPE_AGENT); }
__device__ __forceinline__ unsigned xb_add(unsigned* p, unsigned v) { return __hip_atomic_fetch_add(p, v, __ATOMIC_RELAXED, __HIP_MEMORY_SCOPE_AGENT); }
__device__ __forceinline__ unsigned xb_xcc_id() { return (unsigned)__builtin_amdgcn_s_getreg((3 << 11) | 20) & 0xFu; }
#define XB_SPIN(cond, bar) do { unsigned _sp = 0; while (cond) { __builtin_amdgcn_s_sleep(1); \
    if ((++_sp & 255u) == 0u) { if (xb_ld(&(bar)[XB_TMO])) break; if (_sp > XB_SPIN_CAP) { atomicAdd(&(bar)[XB_TMO], 1u); break; } } } } while (0)

struct XcdBarrier {
    unsigned* bar; unsigned x;
    volatile LAS unsigned* st;
};

__device__ __forceinline__ XcdBarrier xcd_barrier_post(unsigned* bar, volatile LAS unsigned* st) {
    XcdBarrier b; b.bar = bar; b.x = xb_xcc_id(); b.st = st;
    if (threadIdx.x == 0) (void)xb_add(&bar[XB_XCNT(b.x)], 1u);
    return b;
}
__device__ __forceinline__ void xcd_barrier_complete(unsigned* bar, unsigned x, unsigned& nloc, unsigned& nx) {
    const unsigned G = gridDim.x * gridDim.y * gridDim.z;
    unsigned sum, cnt, mine, sp = 0u;
    for (;;) {
        sum = 0u; cnt = 0u; mine = 0u;
#pragma unroll
        for (unsigned j = 0; j < 16; ++j) { const unsigned c = xb_ld(&bar[XB_XCNT(j)]); sum += c; cnt += (c > 0u) ? 1u : 0u; mine = (j == x) ? c : mine; }
        if (sum == G) break;
        __builtin_amdgcn_s_sleep(1);
        if ((++sp & 255u) == 0u) { if (xb_ld(&bar[XB_TMO])) break; if (sp > XB_SPIN_CAP) { atomicAdd(&bar[XB_TMO], 1u); break; } }
    }
    nloc = mine > 0u ? mine : 1u; nx = cnt > 0u ? cnt : 1u;
}

__device__ __forceinline__ void xcd_barrier(const XcdBarrier& b) {
    asm volatile("s_waitcnt vmcnt(0)" ::: "memory");
    __syncthreads();
    if (threadIdx.x == 0) {
        unsigned* bar = b.bar;
        __builtin_amdgcn_s_waitcnt(0);
        unsigned nloc = b.st[0], nx = b.st[1];
        if (nloc == 0u) { xcd_barrier_complete(bar, b.x, nloc, nx); b.st[0] = nloc; b.st[1] = nx; }
        const unsigned old = xb_add(&bar[XB_XSUB(b.x)], 1u);
        const unsigned gen = old / nloc;
        if (old + 1u == (gen + 1u) * nloc) {
            __builtin_amdgcn_fence(__ATOMIC_RELEASE, "agent");
            asm volatile("s_waitcnt vmcnt(0)" ::: "memory");
            const unsigned og = xb_add(&bar[XB_TOP], 1u);
            const unsigned tg = og / nx;
            if (og + 1u == (tg + 1u) * nx) xb_add(&bar[XB_TOPGEN], 1u);
            else XB_SPIN(xb_ld(&bar[XB_TOPGEN]) == tg, bar);
            __builtin_amdgcn_fence(__ATOMIC_ACQUIRE, "agent");
            xb_add(&bar[XB_XGEN(b.x)], 1u);
            asm volatile("s_waitcnt vmcnt(0)" ::: "memory");
        } else {
            XB_SPIN(xb_ld(&bar[XB_XGEN(b.x)]) == gen, bar);
            __builtin_amdgcn_fence(__ATOMIC_ACQUIRE, "agent");
            asm volatile("s_waitcnt vmcnt(0)" ::: "memory");
        }
    }
    __syncthreads();
}


#ifndef REP
#define REP 0
#endif
#ifndef TPROBE
#define TPROBE 0
#endif
#ifndef AVAR
#define AVAR 0
#endif
constexpr int DM = 2048, NIN = 6144, MP = 32768, MS = 2048, MT = MP + MS, DEPTH = 4;
constexpr int NBP = 8, LP = 4096, NBS = 32, LSQ = 64;
constexpr int COL_Q = 0, COL_K = 1024, COL_V = 2048, COL_ZA = 3072, COL_US = 4096, COL_ZS = 4608, COL_UP = 5120, COL_ZP = 5632;
constexpr float EPSN = 1e-6f, LOG2E = 1.4426950408889634f;
constexpr size_t O_YP = 0, O_YS = O_YP + (size_t)MP * DM, O_KP = O_YS + (size_t)MS * DM, O_VP = O_KP + (size_t)DEPTH * NBP * 512 * 1024,
    O_SRP = O_VP + (size_t)DEPTH * NBP * 512 * 1024, O_SIP = O_SRP + (size_t)DEPTH * NBP * 2048, O_PP = O_SIP + (size_t)DEPTH * NBP * 2048,
    O_KS = O_PP + (size_t)DEPTH * NBP * 15 * 512, O_VS = O_KS + (size_t)DEPTH * NBS * 64 * 1024, O_SRS = O_VS + (size_t)DEPTH * NBS * 64 * 1024,
    O_SIS = O_SRS + (size_t)DEPTH * NBS * 2048, O_PS = O_SIS + (size_t)DEPTH * NBS * 2048, O_END = O_PS + (size_t)DEPTH * NBS * 15 * 512;
enum { I_XP = 0, I_XS, I_CP, I_CS, I_CK, I_CV, I_SRE, I_SIM, I_SPOOL, I_NORMG, I_WADA, I_BADA, I_WIN, I_RELB, I_AR, I_AI, I_LDT, I_BR, I_BI, I_CR, I_CI, I_SD, I_WGLU, I_BGLU,
       I_WPOOL, I_PSCALE, I_BNG, I_WOUT, I_FNG, N_IN };
constexpr size_t MiB = 1u << 20;
constexpr size_t WS_CTL = 0, WS_MOD = 1 * MiB, WS_SSQ = 5 * MiB, WS_SB = 6 * MiB, ZERO_BYTES = 10 * MiB, WS_GS = 10 * MiB, WS_SSMP = 12 * MiB, SSMP_LAYER = 512 * 1024, WS_WGLU = 14 * MiB, WS_WPOOL = 18 * MiB,
    WS_SLOC = 19 * MiB, WS_WOUT = 28 * MiB, WS_WIN = 60 * MiB, WS_HY = 156 * MiB, WS_PROJ = 292 * MiB, WS_KC = 700 * MiB, WS_VC = 828 * MiB, WS_HB = 956 * MiB, WS_END = 1092 * MiB;
constexpr size_t SSMP_ABAR = 0, SSMP_ABAR64 = 16384, SSMP_BF = 32768, SSMP_CF = 32768 + 131072;
constexpr int CW_BAR = 4096, CW_Q = 16384, CW_RB = 12288;
constexpr int LDS_BYTES = 147456, MISC_OFF = LDS_BYTES - 64;
constexpr int NPH = 3 + 5 * DEPTH;

#define GAS __attribute__((address_space(1)))
typedef unsigned short bf16;
typedef unsigned v4u __attribute__((ext_vector_type(4)));
typedef unsigned v2u __attribute__((ext_vector_type(2)));
typedef float f32x4 __attribute__((ext_vector_type(4)));
typedef float f32x16 __attribute__((ext_vector_type(16)));
typedef short bf16x8 __attribute__((ext_vector_type(8)));
typedef short s16x4 __attribute__((ext_vector_type(4)));
typedef float f32x2_t __attribute__((ext_vector_type(2)));
typedef __bf16 bf16x2_t __attribute__((ext_vector_type(2)));
#define DI __device__ __forceinline__
DI unsigned pk2(float lo, float hi) { f32x2_t v = {lo, hi}; bf16x2_t b = __builtin_convertvector(v, bf16x2_t); return __builtin_bit_cast(unsigned, b); }
DI float bflo(unsigned u) { return __uint_as_float(u << 16); }
DI float bfhi(unsigned u) { return __uint_as_float(u & 0xffff0000u); }
DI float ex2(float x) { return __builtin_amdgcn_exp2f(x); }
DI float rcpf_(float x) { return __builtin_amdgcn_rcpf(x); }
DI float silu_f(float z) { return z * rcpf_(1.f + ex2(-LOG2E * z)); }
DI float sigm_f(float z) { return rcpf_(1.f + ex2(-LOG2E * z)); }
DI float gelu_tanh_f(float x) { const float t = x + 0.044715f * x * x * x; return x * rcpf_(1.f + ex2(-(1.5957691216057308f * LOG2E) * t)); }
DI float xh_max(float v) { auto rr = __builtin_amdgcn_permlane32_swap(__float_as_uint(v), __float_as_uint(v), false, false); return fmaxf(__uint_as_float(rr[0]), __uint_as_float(rr[1])); }
DI float xh_sum(float v) { auto rr = __builtin_amdgcn_permlane32_swap(__float_as_uint(v), __float_as_uint(v), false, false); return __uint_as_float(rr[0]) + __uint_as_float(rr[1]); }
#define SWZ_XOR(v, k) __uint_as_float((unsigned)__builtin_amdgcn_ds_swizzle((int)__float_as_uint(v), ((k) << 10) | 0x1f))
DI float wave_sum(float v) { v += SWZ_XOR(v, 1); v += SWZ_XOR(v, 2); v += SWZ_XOR(v, 4); v += SWZ_XOR(v, 8); v += SWZ_XOR(v, 16); return xh_sum(v); }
DI f32x16 mfma32(bf16x8 a, bf16x8 b, f32x16 c) { return __builtin_amdgcn_mfma_f32_32x32x16_bf16(a, b, c, 0, 0, 0); }
DI f32x4 mfma16(bf16x8 a, bf16x8 b, f32x4 c) { return __builtin_amdgcn_mfma_f32_16x16x32_bf16(a, b, c, 0, 0, 0); }
typedef short v4i16_t __attribute__((ext_vector_type(4)));
DI s16x4 lds_tr(LAS const unsigned char* p) { return __builtin_bit_cast(s16x4, __builtin_amdgcn_ds_read_tr16_b64_v4i16((LAS v4i16_t*)p)); }
DI bf16x8 zero8() { return (bf16x8){0, 0, 0, 0, 0, 0, 0, 0}; }
DI bf16x8 ld8(const bf16* p) { return *(const bf16x8*)p; }
DI void unpack8(v4u w, float (&f)[8]) { f[0] = bflo(w.x); f[1] = bfhi(w.x); f[2] = bflo(w.y); f[3] = bfhi(w.y); f[4] = bflo(w.z); f[5] = bfhi(w.z); f[6] = bflo(w.w); f[7] = bfhi(w.w); }

struct Args { const float* in[N_IN]; float* out; unsigned char* ws; int ph_lo, ph_hi; };
static_assert(sizeof(Args) == (N_IN + 2) * 8 + 8, "Args has no padding");

DI int otid() { int t = threadIdx.x; asm volatile("" : "+v"(t)); return t; }
struct Ctx {
    const float* const* in; float* out; unsigned char* ws; LAS unsigned char* lds;
    int tid, lane, wave, G, bid;
    bf16* HY; bf16* HB; bf16* PROJ; bf16* KC; bf16* VC; bf16* WIN; bf16* WOUT; float* MOD; float* SSQ; float* SB; float* GS; unsigned* ctl;
};

DI void fresh(Ctx& C) { C.tid = otid(); C.lane = C.tid & 63; C.wave = __builtin_amdgcn_readfirstlane(C.tid >> 6); }
template <bool SILU> DI void p0_mod_unit(const Ctx& C0, int task) {
    Ctx C = C0; fresh(C);
    const int l = task / 192, rem = task % 192, ke = rem / 24, cb = rem % 24, k0 = ke * 256;
    LAS float* sc = (LAS float*)C.lds;
    for (int idx = C.tid; idx < 64 * 256; idx += 512) { const int r = idx >> 8, kk = idx & 255; float v = 0.f;
        if (r < 40) { if (SILU) { const float cv = (r < 8) ? C.in[I_CP][r * DM + k0 + kk] : C.in[I_CS][(r - 8) * DM + k0 + kk]; v = silu_f(cv); } else v = C.MOD[((size_t)l * 40 + r) * NIN + k0 + kk]; }
        sc[r * 257 + kk] = v; }
    __syncthreads();
    const int jl = C.lane & 31, kh = C.lane >> 5, j = cb * 256 + C.wave * 32 + jl;
    const float* Wp = C.in[SILU ? I_WADA : I_WIN] + (size_t)l * DM * NIN + (size_t)(k0 + kh) * NIN + j;
    f32x16 d0 = {}, d1 = {};
    float wv[16];
#pragma unroll
    for (int i = 0; i < 16; ++i) wv[i] = Wp[(size_t)i * 2 * NIN];
#pragma unroll 1
    for (int kp0 = 0; kp0 < 128; kp0 += 16) {
#pragma unroll
        for (int i = 0; i < 16; ++i) { const int kp = kp0 + i;
            const float a0 = sc[jl * 257 + 2 * kp + kh], a1 = sc[(32 + jl) * 257 + 2 * kp + kh];
            d0 = __builtin_amdgcn_mfma_f32_32x32x2f32(a0, wv[i], d0, 0, 0, 0); d1 = __builtin_amdgcn_mfma_f32_32x32x2f32(a1, wv[i], d1, 0, 0, 0);
            if (kp + 16 < 128) wv[i] = Wp[(size_t)(kp + 16) * 2 * NIN]; } }
    float* M = (SILU ? C.MOD : C.SB) + (size_t)l * 40 * NIN + j;
    const float bias = (SILU && ke == 0) ? C.in[I_BADA][l * NIN + j] : 0.f;
#pragma unroll
    for (int reg = 0; reg < 16; ++reg) unsafeAtomicAdd(M + (size_t)(8 * (reg >> 2) + 4 * kh + (reg & 3)) * NIN, d0[reg] + bias);
#pragma unroll
    for (int reg = 0; reg < 4; ++reg) unsafeAtomicAdd(M + (size_t)(32 + 4 * kh + reg) * NIN, d1[reg] + bias);
    __syncthreads();
}
DI void p0_transpose_item(const float* W, int K, int N, bf16* WT, LAS float* scr, int item, int lane) {
    const int nblk = N / 32, kb = item / nblk, nb = item % nblk, k0 = 64 * kb, n0 = 32 * nb;
#pragma unroll 8
    for (int i = 0; i < 32; ++i) { const int kk = 2 * i + (lane >> 5); scr[kk * 33 + (lane & 31)] = W[(size_t)(k0 + kk) * N + n0 + (lane & 31)]; }
    asm volatile("s_waitcnt lgkmcnt(0)" ::: "memory");
    const int c = lane & 7;
#pragma unroll
    for (int j = 0; j < 4; ++j) { const int n = (lane >> 3) + 8 * j; const LAS float* s = scr + (8 * c) * 33 + n;
        v4u o; o.x = pk2(s[0 * 33], s[1 * 33]); o.y = pk2(s[2 * 33], s[3 * 33]); o.z = pk2(s[4 * 33], s[5 * 33]); o.w = pk2(s[6 * 33], s[7 * 33]);
        *(v4u*)(WT + (size_t)(n0 + n) * K + k0 + 8 * c) = o; }
    asm volatile("s_waitcnt lgkmcnt(0)" ::: "memory");
}
DI void p0_ssm_params(const Ctx& C, int l, int g, int lane) {
    unsigned char* blk = C.ws + WS_SSMP + (size_t)l * SSMP_LAYER;
    const int gp = (l * 32 + g) * 64 + lane;
    const float dt = expf(C.in[I_LDT][l * 32 + g]);
    const float ar = C.in[I_AR][gp], ai = C.in[I_AI][gp];
    const float x = ar * dt, ang = ai * dt;
    float sn, cs; sincosf(ang, &sn, &cs);
    const float mag = expf(x), em1 = expm1f(x);
    const float abr = mag * cs, abi = mag * sn;
    float sh, ch; sincosf(0.5f * ang, &sh, &ch); (void)ch;
    const float nr = em1 * cs - 2.f * sh * sh, ni = abi;
    const float den = ar * ar + ai * ai;
    const float cr = (nr * ar + ni * ai) / den, ci = (ni * ar - nr * ai) / den;
    float* AB = (float*)(blk + SSMP_ABAR) + g * 128; AB[lane] = abr; AB[64 + lane] = abi;
    { float s64, c64; sincosf(64.f * ang, &s64, &c64); const float m64 = expf(64.f * x); float* A6 = (float*)(blk + SSMP_ABAR64) + g * 128; A6[lane] = m64 * c64; A6[64 + lane] = m64 * s64; }
    const float* br = C.in[I_BR] + (size_t)gp * 16; const float* bi = C.in[I_BI] + (size_t)gp * 16;
    float bbr[16], bbi[16];
#pragma unroll
    for (int c = 0; c < 16; ++c) { const float b_r = br[c], b_i = bi[c]; bbr[c] = cr * b_r - ci * b_i; bbi[c] = cr * b_i + ci * b_r; }
    v4u* BF = (v4u*)(blk + SSMP_BF) + (size_t)g * 4 * 64;
#pragma unroll
    for (int half = 0; half < 2; ++half) {
        v4u o; o.x = pk2(bbr[8 * half], bbr[8 * half + 1]); o.y = pk2(bbr[8 * half + 2], bbr[8 * half + 3]); o.z = pk2(bbr[8 * half + 4], bbr[8 * half + 5]); o.w = pk2(bbr[8 * half + 6], bbr[8 * half + 7]);
        BF[(0 + half) * 64 + lane] = o;
        o.x = pk2(bbi[8 * half], bbi[8 * half + 1]); o.y = pk2(bbi[8 * half + 2], bbi[8 * half + 3]); o.z = pk2(bbi[8 * half + 4], bbi[8 * half + 5]); o.w = pk2(bbi[8 * half + 6], bbi[8 * half + 7]);
        BF[(2 + half) * 64 + lane] = o; }
    v4u* CF = (v4u*)(blk + SSMP_CF) + (size_t)g * 4 * 64;
    const int c = lane & 15, kq = lane >> 4;
    const float* crp = C.in[I_CR] + ((size_t)(l * 32 + g) * 16 + c) * 64; const float* cip = C.in[I_CI] + ((size_t)(l * 32 + g) * 16 + c) * 64;
#pragma unroll
    for (int kap = 0; kap < 4; ++kap) { const int p0 = 16 * kap + 4 * kq;
        v4u o; o.x = pk2(crp[p0], -cip[p0]); o.y = pk2(crp[p0 + 1], -cip[p0 + 1]); o.z = pk2(crp[p0 + 2], -cip[p0 + 2]); o.w = pk2(crp[p0 + 3], -cip[p0 + 3]);
        CF[kap * 64 + lane] = o; }
}
DI void cache_convert(const Ctx& C, int l, int part, int nparts) {
    const size_t n8 = (size_t)NBS * 512 * 1024 / 8, base = (size_t)l * NBS * 512 * 1024;
    for (size_t i = (size_t)part * 64 + C.lane; i < 2 * n8; i += (size_t)nparts * 64) { const bool isv = i >= n8; const size_t e = base + (isv ? i - n8 : i) * 8;
        const float* s = (isv ? C.in[I_CV] : C.in[I_CK]) + e; const f32x4 a = *(const f32x4*)s, b = *(const f32x4*)(s + 4);
        v4u o; o.x = pk2(a.x, a.y); o.y = pk2(a.z, a.w); o.z = pk2(b.x, b.y); o.w = pk2(b.z, b.w); *(v4u*)((isv ? C.VC : C.KC) + e) = o; }
}
DI void cache_span(const Ctx& C0, int l, int part, int nparts) {
    Ctx C = C0; fresh(C);
    const size_t n8 = (size_t)NBS * 512 * 1024 / 8, base = (size_t)l * NBS * 512 * 1024;
    const int rows = (int)(2 * n8 / 512), per = (rows + nparts - 1) / nparts, r0 = part * per, r1 = (r0 + per < rows) ? r0 + per : rows;
#pragma unroll 4
    for (int r = r0; r < r1; ++r) { const size_t i = (size_t)r * 512 + C.tid; const bool isv = i >= n8; const size_t e = base + (isv ? i - n8 : i) * 8;
        const float* s = (isv ? C.in[I_CV] : C.in[I_CK]) + e; const f32x4 a = *(const f32x4*)s, b = *(const f32x4*)(s + 4);
        v4u o; o.x = pk2(a.x, a.y); o.y = pk2(a.z, a.w); o.z = pk2(b.x, b.y); o.w = pk2(b.z, b.w); *(v4u*)((isv ? C.VC : C.KC) + e) = o; }
}
DI void cache_item(const Ctx& C0, int l, int it) {
    Ctx C = C0; fresh(C);
    const size_t n8 = (size_t)NBS * 512 * 1024 / 8, base = (size_t)l * NBS * 512 * 1024, i0 = (size_t)it * (2 * n8 / 256);
#pragma unroll 4
    for (int k = 0; k < (int)(2 * n8 / 256 / 512); ++k) { const size_t i = i0 + (size_t)k * 512 + C.tid; const bool isv = i >= n8; const size_t e = base + (isv ? i - n8 : i) * 8;
        const float* s = (isv ? C.in[I_CV] : C.in[I_CK]) + e; const f32x4 a = *(const f32x4*)s, b = *(const f32x4*)(s + 4);
        v4u o; o.x = pk2(a.x, a.y); o.y = pk2(a.z, a.w); o.z = pk2(b.x, b.y); o.w = pk2(b.z, b.w); *(v4u*)((isv ? C.VC : C.KC) + e) = o; }
}
DI void p0_convert(const Ctx& C0);
DI void p0_prologue(const Ctx& C0, bool with_mod) {
    if (C0.bid & 1) { if (with_mod) for (int u = C0.bid; u < 768; u += C0.G) p0_mod_unit<true>(C0, u); __syncthreads(); p0_convert(C0); }
    else { p0_convert(C0); __syncthreads(); if (with_mod) for (int u = C0.bid; u < 768; u += C0.G) p0_mod_unit<true>(C0, u); }
}
DI void p0_convert(const Ctx& C0) {
    Ctx C = C0; fresh(C);
    const int gw = C.bid * 8 + C.wave, NGW = C.G * 8, lane = C.lane;
    LAS float* scr = (LAS float*)(C.lds + C.wave * 16384);
    constexpr int I_IN = (DM / 64) * (NIN / 32), I_OUT = (DM / 64) * (DM / 32);
    for (int it = gw; it < DEPTH * (I_IN + I_OUT); it += NGW) {
        const int l = it / (I_IN + I_OUT), r = it % (I_IN + I_OUT);
        if (r < I_IN) p0_transpose_item(C.in[I_WIN] + (size_t)l * DM * NIN, DM, NIN, C.WIN + (size_t)l * NIN * DM, scr, r, lane);
        else p0_transpose_item(C.in[I_WOUT] + (size_t)l * DM * DM, DM, DM, C.WOUT + (size_t)l * DM * DM, scr, r - I_IN, lane);
    }
    for (int it = gw; it < DEPTH * 1024; it += NGW) { const int l = it >> 10, ct = (it >> 5) & 31, kap = it & 31;
        const float* w = C.in[I_WGLU] + (size_t)l * 512 * 1024 + (size_t)(16 * kap + 8 * (lane >> 5)) * 1024 + 32 * ct + (lane & 31);
        v4u o; o.x = pk2(w[0], w[1024]); o.y = pk2(w[2048], w[3072]); o.z = pk2(w[4096], w[5120]); o.w = pk2(w[6144], w[7168]);
        ((v4u*)(C.ws + WS_WGLU))[(size_t)it * 64 + lane] = o; }
    for (int it = gw; it < DEPTH * 128; it += NGW) { const int lg = it >> 5, ct = (it >> 3) & 3, kap = it & 7;
        const float* w = C.in[I_WPOOL] + (size_t)lg * 128 * 128 + (size_t)(16 * kap + 8 * (lane >> 5)) * 128 + 32 * ct + (lane & 31);
        v4u o; o.x = pk2(w[0], w[128]); o.y = pk2(w[256], w[384]); o.z = pk2(w[512], w[640]); o.w = pk2(w[768], w[896]);
        ((v4u*)(C.ws + WS_WPOOL))[(size_t)it * 64 + lane] = o; }
    for (int it = gw; it < DEPTH * 32; it += NGW) p0_ssm_params(C, it >> 5, it & 31, lane);
}

DI void p0b_rows(const Ctx& C0);
DI void p0b_phase(const Ctx& C0) {
    if (C0.bid & 1) { for (int u = C0.bid; u < 768; u += C0.G) p0_mod_unit<false>(C0, u); p0b_rows(C0); }
    else { p0b_rows(C0); __syncthreads(); for (int u = C0.bid; u < 768; u += C0.G) p0_mod_unit<false>(C0, u); }
}
DI void p0b_rows(const Ctx& C0) {
    Ctx C = C0; fresh(C);
    for (int i = C.bid * 512 + C.tid; i < DEPTH * 40 * DM; i += C.G * 512) { const int l = i / (40 * DM), r = (i / DM) % 40, k = i % DM;
        C.GS[i] = C.in[I_NORMG][l * DM + k] * (1.f + C.MOD[((size_t)l * 40 + r) * NIN + DM + k]); }
    const int gw = C.bid * 8 + C.wave, NGW = C.G * 8, lane = C.lane, rpw = (MT + NGW - 1) / NGW;
    f32x4 gs[8]; int cur_b = -1;
    f32x4 v[8], vn[8];
    auto ldrow = [&](int m, f32x4 (&d)[8]) { const float* xr = (m < MP) ? C.in[I_XP] + (size_t)m * DM : C.in[I_XS] + (size_t)(m - MP) * DM;
#pragma unroll
        for (int j = 0; j < 8; ++j) d[j] = ((const f32x4*)xr)[lane + 64 * j]; };
    const int m0 = gw * rpw; if (m0 < MT) ldrow(m0, v);
    for (int i = 0; i < rpw; ++i) { const int m = m0 + i; if (m >= MT) break;
        if (i + 1 < rpw && m + 1 < MT) ldrow(m + 1, vn);
        const int brow = (m < MP) ? (m >> 12) : 8 + ((m - MP) >> 6);
        if (brow != cur_b) { cur_b = brow; const float* md = C.MOD + (size_t)brow * NIN + DM;
#pragma unroll
            for (int j = 0; j < 8; ++j) gs[j] = ((const f32x4*)C.in[I_NORMG])[lane + 64 * j] * (((const f32x4*)md)[lane + 64 * j] + 1.f); }
        float sq = 0.f; v2u* o8 = (v2u*)(C.HB + (size_t)m * DM) + lane;
#pragma unroll
        for (int j = 0; j < 8; ++j) { sq += (v[j].x * v[j].x + v[j].y * v[j].y) + (v[j].z * v[j].z + v[j].w * v[j].w); const f32x4 h = v[j] * gs[j]; v2u o; o.x = pk2(h.x, h.y); o.y = pk2(h.z, h.w); o8[64 * j] = o; }
        sq = wave_sum(sq); if (lane == 0) C.SSQ[m] = sq;
#pragma unroll
        for (int j = 0; j < 8; ++j) v[j] = vn[j]; }
}
DI void final_norm_phase(const Ctx& C0) {
    Ctx C = C0; fresh(C);
    const int gw = C.bid * 8 + C.wave, NGW = C.G * 8, lane = C.lane, rpw = (MT + NGW - 1) / NGW;
    f32x4 g[8];
#pragma unroll
    for (int j = 0; j < 8; ++j) g[j] = ((const f32x4*)C.in[I_FNG])[lane + 64 * j];
    f32x4 v[8], vn[8];
    auto ldrow = [&](int m, f32x4 (&d)[8]) {
#pragma unroll
        for (int j = 0; j < 8; ++j) d[j] = ((const f32x4*)(C.out + (size_t)m * DM))[lane + 64 * j]; };
    const int m0 = gw * rpw; if (m0 < MT) ldrow(m0, v);
    for (int i = 0; i < rpw; ++i) { const int m = m0 + i; if (m >= MT) break;
        if (i + 1 < rpw && m + 1 < MT) ldrow(m + 1, vn);
        const float rstd = rsqrtf(C.SSQ[(size_t)DEPTH * MT + m] * (1.f / DM) + EPSN);
        f32x4* o4 = (f32x4*)(C.out + (size_t)m * DM) + lane;
#pragma unroll
        for (int j = 0; j < 8; ++j) o4[64 * j] = v[j] * rstd * g[j];
#pragma unroll
        for (int j = 0; j < 8; ++j) v[j] = vn[j]; }
}

constexpr int ROWP = 1040;
struct TailPre { v4u zz[8]; };
DI void tail_prefetch(const Ctx& C, int row0, int zcol, TailPre& P) {
#pragma unroll
    for (int it = 0; it < 8; ++it) { const int idx = C.tid + 512 * it, row = idx >> 6, ch = idx & 63; P.zz[it] = *(const v4u*)(C.PROJ + (size_t)(row0 + row) * NIN + zcol + ch * 8); }
}
DI void branch_tail(const Ctx& C, int l, int row0, LAS unsigned char* ST, LAS float* ssq, LAS float* rstd_l, const TailPre& P, int ycol) {
    if (C.tid < 64) { float t = 0.f;
#pragma unroll
        for (int w = 0; w < 8; ++w) t += ssq[w * 64 + C.tid];
        rstd_l[C.tid] = rsqrtf(t * (1.f / 512.f) + EPSN); }
    __syncthreads();
    const float* gb = C.in[I_BNG] + (size_t)l * DM + ycol;
    const f32x4 g0 = *(const f32x4*)(gb + (C.tid & 63) * 8), g1 = *(const f32x4*)(gb + (C.tid & 63) * 8 + 4);
#pragma unroll
    for (int it = 0; it < 8; ++it) { const int idx = C.tid + 512 * it, row = idx >> 6, ch = idx & 63;
        const v4u raw = *(const LAS v4u*)(ST + row * ROWP + ch * 16);
        const v4u zz = P.zz[it];
        float r[8], z[8]; unpack8(raw, r); unpack8(zz, z); const float rs = rstd_l[row];
        const float gg[8] = {g0.x, g0.y, g0.z, g0.w, g1.x, g1.y, g1.z, g1.w}; float o[8];
#pragma unroll
        for (int e = 0; e < 8; ++e) o[e] = r[e] * rs * gg[e] * silu_f(z[e]);
        v4u w; w.x = pk2(o[0], o[1]); w.y = pk2(o[2], o[3]); w.z = pk2(o[4], o[5]); w.w = pk2(o[6], o[7]);
        *(v4u*)(C.HY + (size_t)(row0 + row) * DM + ycol + ch * 8) = w; }
    __syncthreads();
}

struct SsmGroup { float ar, ai; bf16x8 bf[4]; };
DI void ssm_load_group(const Ctx& C, int l, int g, int lane, SsmGroup& S) {
    const unsigned char* blk = C.ws + WS_SSMP + (size_t)l * SSMP_LAYER;
    const float* AB = (const float*)(blk + SSMP_ABAR) + g * 128; S.ar = AB[lane]; S.ai = AB[64 + lane];
    const bf16x8* BF = (const bf16x8*)(blk + SSMP_BF) + (size_t)g * 4 * 64;
#pragma unroll
    for (int f = 0; f < 4; ++f) S.bf[f] = BF[f * 64 + lane];
}
struct SsmA { bf16x8 a0[4], a1[4]; };
DI void ssm_load_a(const Ctx& C, int row0, int g, int lane, SsmA& A) {
    const int i = lane & 31, kh = lane >> 5, ti = 4 * (i >> 3) + (i & 3); const bool act = ((i >> 2) & 1) == kh;
    const bf16* src = C.PROJ + (size_t)(row0 + ti) * NIN + COL_US + 16 * g;
#pragma unroll
    for (int blk = 0; blk < 4; ++blk) { A.a0[blk] = ld8(src + (size_t)blk * 16 * NIN); A.a1[blk] = ld8(src + (size_t)blk * 16 * NIN + 8);
        if (!act) { A.a0[blk] = zero8(); A.a1[blk] = zero8(); } }
}
DI void ssm_bu(const SsmGroup& S, const bf16x8 a0, const bf16x8 a1, f32x16& dre, f32x16& dim) {
    const f32x16 z = {};
    dre = mfma32(a0, S.bf[0], z); dre = mfma32(a1, S.bf[1], dre);
    dim = mfma32(a0, S.bf[2], z); dim = mfma32(a1, S.bf[3], dim);
}
DI void ssm_local_unit(const Ctx& C0, int l, int u) {
    Ctx C = C0; fresh(C);
    const int lane = C.lane, row0 = (u >> 6) * LP + (u & 63) * 64;
    float* SL = (float*)(C.ws + WS_SLOC) + (size_t)u * 4096;
    SsmGroup S; SsmA A; ssm_load_group(C, l, C.wave * 4, lane, S); ssm_load_a(C, row0, C.wave * 4, lane, A);
#pragma unroll 1
    for (int gi = 0; gi < 4; ++gi) { const int g = C.wave * 4 + gi;
        SsmGroup Sn; SsmA An; if (gi < 3) { ssm_load_group(C, l, g + 1, lane, Sn); ssm_load_a(C, row0, g + 1, lane, An); }
        float hr = 0.f, hi = 0.f;
#pragma unroll
        for (int blk = 0; blk < 4; ++blk) { f32x16 dre, dim; ssm_bu(S, A.a0[blk], A.a1[blk], dre, dim);
#pragma unroll
            for (int r = 0; r < 16; ++r) { const float nr = S.ar * hr - S.ai * hi + dre[r], ni = S.ar * hi + S.ai * hr + dim[r]; hr = nr; hi = ni; } }
        SL[g * 64 + lane] = hr; SL[2048 + g * 64 + lane] = hi;
        if (gi < 3) { S = Sn; A = An; } }
}
DI void ssm_carry_phase(const Ctx& C0, int l) {
    Ctx C = C0; fresh(C);
    const int t = C.wave * C.G + C.bid, NW = C.G * 8;
    if (t >= 256) { if (l == 0) cache_convert(C, l, t - 256, NW - 256); return; }
    const int b = t >> 5, g = t & 31, lane = C.lane;
    const float* A6 = (const float*)(C.ws + WS_SSMP + (size_t)l * SSMP_LAYER + SSMP_ABAR64) + g * 128; const float a6r = A6[lane], a6i = A6[64 + lane];
    float* SL = (float*)(C.ws + WS_SLOC) + (size_t)(b * 64) * 4096 + g * 64 + lane;
    float hr = 0.f, hi = 0.f;
#pragma unroll 1
    for (int nb = 0; nb < 4; ++nb) { float sr[16], si[16];
#pragma unroll
        for (int i = 0; i < 16; ++i) { sr[i] = SL[(size_t)(16 * nb + i) * 4096]; si[i] = SL[(size_t)(16 * nb + i) * 4096 + 2048]; }
#pragma unroll
        for (int i = 0; i < 16; ++i) { SL[(size_t)(16 * nb + i) * 4096] = hr; SL[(size_t)(16 * nb + i) * 4096 + 2048] = hi;
            const float nr = a6r * hr - a6i * hi + sr[i], ni = a6r * hi + a6i * hr + si[i]; hr = nr; hi = ni; } }
}
struct SsmPre { SsmGroup S; SsmA A; bf16x8 cf[4]; f32x4 dsk; v2u uu[4]; float hr, hi; };
DI void ssm_prefetch(const Ctx& C, int l, int g, int row0, bool samp, int b, int n, int lane, SsmPre& P) {
    const unsigned char* blk_p = C.ws + WS_SSMP + (size_t)l * SSMP_LAYER;
    ssm_load_group(C, l, g, lane, P.S); ssm_load_a(C, row0, g, lane, P.A);
    const bf16x8* CF = (const bf16x8*)(blk_p + SSMP_CF) + (size_t)g * 4 * 64;
#pragma unroll
    for (int k = 0; k < 4; ++k) P.cf[k] = CF[k * 64 + lane];
    const int t16 = lane & 15, kq = lane >> 4;
    P.dsk = *(const f32x4*)(C.in[I_SD] + (size_t)(l * 32 + g) * 16 + 4 * kq);
#pragma unroll
    for (int blk = 0; blk < 4; ++blk) P.uu[blk] = *(const v2u*)(C.PROJ + (size_t)(row0 + 16 * blk + t16) * NIN + COL_US + 16 * g + 4 * kq);
    if (samp) { P.hr = C.in[I_SRE][((size_t)(l * NBS + b) * 32 + g) * 64 + lane]; P.hi = C.in[I_SIM][((size_t)(l * NBS + b) * 32 + g) * 64 + lane]; }
    else { const float* SL = (const float*)(C.ws + WS_SLOC) + (size_t)(b * 64 + n) * 4096 + g * 64 + lane; P.hr = SL[0]; P.hi = SL[2048]; }
}
DI void ssm_main_unit(const Ctx& C0, int l, int u) {
    Ctx C = C0; fresh(C);
    const int lane = C.lane, wave = C.wave; const bool samp = u >= 512;
    const int b = samp ? u - 512 : (u >> 6), n = samp ? 0 : (u & 63), row0 = samp ? MP + 64 * b : b * LP + 64 * n;
    LAS unsigned char* GG = C.lds; LAS unsigned char* HT = C.lds + 64 * ROWP + wave * 4352;
    LAS float* ssq = (LAS float*)(C.lds + 64 * ROWP + 8 * 4352); LAS float* rstd_l = ssq + 512;
    { SsmPre P; ssm_prefetch(C, l, wave * 4, row0, samp, b, n, lane, P);
#pragma unroll 1
      for (int gi = 0; gi < 4; ++gi) { const int g = wave * 4 + gi;
        SsmPre Pn; if (gi < 3) ssm_prefetch(C, l, g + 1, row0, samp, b, n, lane, Pn);
        const int t16 = lane & 15, kq = lane >> 4;
        float hr = P.hr, hi = P.hi;
#pragma unroll
        for (int blk = 0; blk < 4; ++blk) { f32x16 dre, dim; ssm_bu(P.S, P.A.a0[blk], P.A.a1[blk], dre, dim);
#pragma unroll
            for (int r = 0; r < 16; ++r) { const float nr = P.S.ar * hr - P.S.ai * hi + dre[r], ni = P.S.ar * hi + P.S.ai * hr + dim[r]; hr = nr; hi = ni;
                *(LAS unsigned*)(HT + r * 272 + lane * 4) = pk2(nr, ni); }
            f32x4 yt = {0.f, 0.f, 0.f, 0.f};
#pragma unroll
            for (int k = 0; k < 4; ++k) { const bf16x8 hb = *(const LAS bf16x8*)(HT + t16 * 272 + (32 * k + 8 * kq) * 2); yt = mfma16(P.cf[k], hb, yt); }
            const v2u uu = P.uu[blk];
            const float y0 = gelu_tanh_f(yt[0] + P.dsk[0] * bflo(uu.x)), y1 = gelu_tanh_f(yt[1] + P.dsk[1] * bfhi(uu.x)), y2 = gelu_tanh_f(yt[2] + P.dsk[2] * bflo(uu.y)), y3 = gelu_tanh_f(yt[3] + P.dsk[3] * bfhi(uu.y));
            v2u o; o.x = pk2(y0, y1); o.y = pk2(y2, y3);
            *(LAS v2u*)(GG + (16 * blk + t16) * ROWP + (16 * g + 4 * kq) * 2) = o; }
        if (samp || n == 63) { float* ore = C.out + (samp ? O_SRS + ((size_t)(l * NBS + b) * 2048) : O_SRP + ((size_t)(l * NBP + b) * 2048)) + g * 64 + lane;
            float* oim = C.out + (samp ? O_SIS + ((size_t)(l * NBS + b) * 2048) : O_SIP + ((size_t)(l * NBP + b) * 2048)) + g * 64 + lane; *ore = hr; *oim = hi; }
        if (gi < 3) P = Pn; } }
    __syncthreads();
    const int hi5 = lane >> 5, r32 = lane & 31;
    const bf16x8* WG = (const bf16x8*)(C.ws + WS_WGLU) + (size_t)l * 1024 * 64 + lane;
    const float* bg = C.in[I_BGLU] + (size_t)l * 1024;
    float sq[2] = {0.f, 0.f}; v2u ost[2][4][2];
#pragma unroll
    for (int c = 0; c < 2; ++c) {
        const bf16x8* Wv = WG + (size_t)((2 * wave + c) * 32) * 64; const bf16x8* Wt = WG + (size_t)((16 + 2 * wave + c) * 32) * 64;
        f32x16 av[2], ag[2]; av[0] = f32x16{}; av[1] = f32x16{}; ag[0] = f32x16{}; ag[1] = f32x16{};
        bf16x8 rv[8], rg[8];
#pragma unroll
        for (int i = 0; i < 8; ++i) { rv[i] = Wv[(size_t)i * 64]; rg[i] = Wt[(size_t)i * 64]; }
#pragma unroll 1
        for (int k0 = 0; k0 < 32; k0 += 8) {
#pragma unroll
            for (int i = 0; i < 8; ++i) { const int kap = k0 + i;
                const bf16x8 b0 = *(const LAS bf16x8*)(GG + r32 * ROWP + (16 * kap + 8 * hi5) * 2), b1 = *(const LAS bf16x8*)(GG + (32 + r32) * ROWP + (16 * kap + 8 * hi5) * 2);
                av[0] = mfma32(rv[i], b0, av[0]); av[1] = mfma32(rv[i], b1, av[1]); ag[0] = mfma32(rg[i], b0, ag[0]); ag[1] = mfma32(rg[i], b1, ag[1]);
                if (kap + 8 < 32) { rv[i] = Wv[(size_t)(kap + 8) * 64]; rg[i] = Wt[(size_t)(kap + 8) * 64]; } } }
#pragma unroll
        for (int rr = 0; rr < 4; ++rr) { const int ch0 = 64 * wave + 32 * c + 8 * rr + 4 * hi5; const f32x4 bv = *(const f32x4*)(bg + ch0), bgt = *(const f32x4*)(bg + 512 + ch0);
#pragma unroll
            for (int tt = 0; tt < 2; ++tt) { float o[4];
#pragma unroll
                for (int e = 0; e < 4; ++e) { o[e] = (av[tt][4 * rr + e] + bv[e]) * sigm_f(ag[tt][4 * rr + e] + bgt[e]); sq[tt] += o[e] * o[e]; }
                ost[c][rr][tt].x = pk2(o[0], o[1]); ost[c][rr][tt].y = pk2(o[2], o[3]); } }
    }
    TailPre TP; tail_prefetch(C, row0, COL_ZS, TP);
#pragma unroll
    for (int tt = 0; tt < 2; ++tt) { const float t = xh_sum(sq[tt]); if (hi5 == 0) ssq[wave * 64 + 32 * tt + r32] = t; }
    __syncthreads();
#pragma unroll
    for (int c = 0; c < 2; ++c)
#pragma unroll
        for (int rr = 0; rr < 4; ++rr) { const int ch0 = 64 * wave + 32 * c + 8 * rr + 4 * hi5;
#pragma unroll
            for (int tt = 0; tt < 2; ++tt) *(LAS v2u*)(GG + (32 * tt + r32) * ROWP + ch0 * 2) = ost[c][rr][tt]; }
    __syncthreads();
    branch_tail(C, l, row0, GG, ssq, rstd_l, TP, 1024);
}

template <int W> DI void pool_diff(const Ctx& C, int l, bool samp, int b, int n, int row0, int gi, int th, int lane, LAS unsigned char* DF) {
    const int t0 = 32 * th + 8 * (lane >> 4), ch0 = 128 * gi + 8 * (lane & 15);
    const float* sp = C.in[I_SPOOL] + (size_t)(l * NBS + b) * 15 * 512;
    float x[W + 7][8];
#pragma unroll
    for (int i = 0; i < W + 7; ++i) { const int rel = t0 - (W - 1) + i;
        if (rel >= 0 || (!samp && n > 0)) unpack8(*(const v4u*)(C.PROJ + (size_t)(row0 + rel) * NIN + COL_UP + ch0), x[i]);
        else if (samp) { const float* s = sp + (size_t)(15 + rel) * 512 + ch0; const f32x4 a = *(const f32x4*)s, c4 = *(const f32x4*)(s + 4); x[i][0] = a.x; x[i][1] = a.y; x[i][2] = a.z; x[i][3] = a.w; x[i][4] = c4.x; x[i][5] = c4.y; x[i][6] = c4.z; x[i][7] = c4.w; }
        else {
#pragma unroll
            for (int e = 0; e < 8; ++e) x[i][e] = 0.f; } }
    const bool last = samp || n == 63;
    float* po = C.out + (samp ? O_PS + (size_t)(l * NBS + b) * 15 * 512 : O_PP + (size_t)(l * NBP + b) * 15 * 512);
#pragma unroll
    for (int tt = 0; tt < 8; ++tt) { const int t = t0 + tt, pos = 64 * n + t; float d[8];
        const float cnt = samp ? (float)W : (float)((pos + 1 < W) ? pos + 1 : W), ic = 1.f / cnt;
#pragma unroll
        for (int e = 0; e < 8; ++e) { float s = 0.f;
#pragma unroll
            for (int j = 0; j < W; ++j) s += x[tt + j][e];
            d[e] = s * ic - x[tt + W - 1][e]; }
        v4u o; o.x = pk2(d[0], d[1]); o.y = pk2(d[2], d[3]); o.z = pk2(d[4], d[5]); o.w = pk2(d[6], d[7]);
        *(LAS v4u*)(DF + t * ROWP + ch0 * 2) = o;
        if (last && t >= 49) { float* p = po + (size_t)(t - 49) * 512 + ch0; *(f32x4*)p = (f32x4){x[tt + W - 1][0], x[tt + W - 1][1], x[tt + W - 1][2], x[tt + W - 1][3]}; *(f32x4*)(p + 4) = (f32x4){x[tt + W - 1][4], x[tt + W - 1][5], x[tt + W - 1][6], x[tt + W - 1][7]}; } }
}
DI void pool_unit(const Ctx& C0, int l, int u) {
    Ctx C = C0; fresh(C);
    const int lane = C.lane, wave = C.wave; const bool samp = u >= 512;
    const int b = samp ? u - 512 : (u >> 6), n = samp ? 0 : (u & 63), row0 = samp ? MP + 64 * b : b * LP + 64 * n;
    LAS unsigned char* DF = C.lds; LAS float* ssq = (LAS float*)(C.lds + 64 * ROWP); LAS float* rstd_l = ssq + 512;
    { const int gi = wave >> 1, th = wave & 1;
      if (gi == 0) pool_diff<2>(C, l, samp, b, n, row0, 0, th, lane, DF); else if (gi == 1) pool_diff<4>(C, l, samp, b, n, row0, 1, th, lane, DF);
      else if (gi == 2) pool_diff<8>(C, l, samp, b, n, row0, 2, th, lane, DF); else pool_diff<16>(C, l, samp, b, n, row0, 3, th, lane, DF); }
    TailPre TP; tail_prefetch(C, row0, COL_ZP, TP);
    __syncthreads();
    const int hi5 = lane >> 5, r32 = lane & 31, gi = wave >> 1;
    f32x16 acc[2][2];
#pragma unroll
    for (int c = 0; c < 2; ++c) { acc[c][0] = f32x16{}; acc[c][1] = f32x16{}; }
    const bf16x8* WP = (const bf16x8*)(C.ws + WS_WPOOL) + (size_t)((l * 4 + gi) * 32) * 64 + lane;
#pragma unroll
    for (int kap = 0; kap < 8; ++kap) { bf16x8 af[2], bt[2];
#pragma unroll
        for (int c = 0; c < 2; ++c) af[c] = WP[(size_t)((2 * (wave & 1) + c) * 8 + kap) * 64];
#pragma unroll
        for (int tt = 0; tt < 2; ++tt) bt[tt] = *(const LAS bf16x8*)(DF + (32 * tt + r32) * ROWP + (128 * gi + 16 * kap + 8 * hi5) * 2);
#pragma unroll
        for (int c = 0; c < 2; ++c)
#pragma unroll
            for (int tt = 0; tt < 2; ++tt) acc[c][tt] = mfma32(af[c], bt[tt], acc[c][tt]); }
    const float* ps = C.in[I_PSCALE] + (size_t)l * 512;
    float sq[2] = {0.f, 0.f};
#pragma unroll
    for (int c = 0; c < 2; ++c)
#pragma unroll
        for (int rr = 0; rr < 4; ++rr) { const int d0 = 128 * gi + 32 * (2 * (wave & 1) + c) + 8 * rr + 4 * hi5; const f32x4 sc = *(const f32x4*)(ps + d0);
#pragma unroll
            for (int tt = 0; tt < 2; ++tt)
#pragma unroll
                for (int e = 0; e < 4; ++e) { const float o = acc[c][tt][4 * rr + e] * sc[e]; acc[c][tt][4 * rr + e] = o; sq[tt] += o * o; } }
#pragma unroll
    for (int tt = 0; tt < 2; ++tt) { const float t = xh_sum(sq[tt]); if (hi5 == 0) ssq[wave * 64 + 32 * tt + r32] = t; }
    __syncthreads();
#pragma unroll
    for (int c = 0; c < 2; ++c)
#pragma unroll
        for (int rr = 0; rr < 4; ++rr) { const int d0 = 128 * gi + 32 * (2 * (wave & 1) + c) + 8 * rr + 4 * hi5;
#pragma unroll
            for (int tt = 0; tt < 2; ++tt) { v2u o; o.x = pk2(acc[c][tt][4 * rr], acc[c][tt][4 * rr + 1]); o.y = pk2(acc[c][tt][4 * rr + 2], acc[c][tt][4 * rr + 3]);
                *(LAS v2u*)(DF + (32 * tt + r32) * ROWP + d0 * 2) = o; } }
    __syncthreads();
    branch_tail(C, l, row0, DF, ssq, rstd_l, TP, 1536);
}

constexpr int AT_STG = 65536, AT_TAB = 2 * AT_STG, AT_SSQ = AT_TAB + 2 * 4 * 384 * 4, AT_RSTD = AT_SSQ + 8 * 32 * 4, AT_FLAG = AT_RSTD + 256;
DI void attn_unit(const Ctx& C0, int l, int ucode) {
    Ctx C = C0; fresh(C);
    const int lane = C.lane, wave = C.wave, r32 = lane & 31, hi = lane >> 5, hd = wave >> 1, qh = wave & 1; const bool samp = (ucode >> 16) & 1;
    const int b = (ucode >> 8) & 255, n = samp ? 16 : (ucode & 255), rq0 = samp ? MP + 64 * b : b * LP + 64 * n;
    const int jstart = samp ? 0 : (n >= 8 ? 0 : 8 - n), nt = 9 - jstart, nsteps = 4 * nt;
    unsigned long long jseq = 0ull; { int cnt = 0; for (int k = 0; k < 9; ++k) { const int jj = samp ? k : (((k - (n - 8)) % 9) + 9) % 9; if (jj >= jstart) { jseq |= (unsigned long long)jj << (4 * cnt); ++cnt; } } }
    auto jof = [&](int ti) { return (int)((jseq >> (4 * ti)) & 15ull); };
    LAS unsigned char* KV = C.lds + hd * 16384;
    LAS float* TAB = (LAS float*)(C.lds + AT_TAB) + hd * 384;
    LAS float* ssq = (LAS float*)(C.lds + AT_SSQ); LAS float* rstd_l = (LAS float*)(C.lds + AT_RSTD); LAS volatile int* flag = (LAS volatile int*)(C.lds + AT_FLAG);
    if (C.tid < 8) flag[C.tid] = 0;
    __syncthreads();
    const float c1 = 0.125f * LOG2E;
    const int qi = 32 * qh + r32, sw = (r32 >> 1) & 7;
    auto issue = [&](int h, int j, auto STC) {
        constexpr int st = decltype(STC)::value;
        const char* src; unsigned pitchB;
        if (samp && j < 8) { src = (const char*)((qh ? C.VC : C.KC) + ((size_t)(l * NBS + b) * 512 + 64 * j) * 1024 + h * 64); pitchB = 2048u; }
        else { const size_t row = samp ? (size_t)rq0 : (size_t)(b * LP + 64 * (n - 8 + j)); src = (const char*)(C.PROJ + row * NIN + (qh ? COL_V : COL_K) + h * 64); pitchB = (unsigned)NIN * 2u; }
        LAS unsigned char* dst = KV + st * AT_STG + qh * 8192;
        if (qh == 0) { const unsigned rl = (unsigned)lane >> 3, cl = (unsigned)lane & 7u, sw0 = (rl >> 1) & 3u;
            const unsigned vo0 = rl * pitchB + ((cl ^ sw0) << 4), vo1 = rl * pitchB + ((cl ^ (sw0 | 4u)) << 4);
#pragma unroll
            for (int pc = 0; pc < 8; ++pc) __builtin_amdgcn_global_load_lds((const unsigned*)(src + (size_t)(8u * pc * pitchB) + ((pc & 1) ? vo1 : vo0)), (LAS unsigned*)(dst + pc * 1024), 16, 0, 0);
        } else { const unsigned vo = ((unsigned)lane >> 2) * pitchB + (((unsigned)lane & 3u) << 4);
#pragma unroll
            for (int pc = 0; pc < 8; ++pc) __builtin_amdgcn_global_load_lds((const unsigned*)(src + (size_t)(16u * (pc & 3) * pitchB + (pc >> 2) * 64u) + vo), (LAS unsigned*)(dst + pc * 1024), 16, 0, 0);
        }
    };
    float tv[3];
    auto tab_load = [&](int h) { const float* rb = C.in[I_RELB] + (size_t)(l * 16 + h) * 513;
#pragma unroll
        for (int k = 0; k < 3; ++k) { const int y = 192 * qh + lane + 64 * k; tv[k] = rb[y < 64 ? 512 : 576 - y]; } };
    auto tab_store = [&](int buf) {
#pragma unroll
        for (int k = 0; k < 3; ++k) TAB[buf * 1536 + 192 * qh + lane + 64 * k] = tv[k] * LOG2E; };
    bf16x8 qf[4], qn[4];
    auto q_load = [&](int h, bf16x8 (&q)[4]) { const bf16* qp = C.PROJ + (size_t)(rq0 + qi) * NIN + COL_Q + h * 64 + 8 * hi;
#pragma unroll
        for (int k = 0; k < 4; ++k) q[k] = ld8(qp + 16 * k); };
    tab_load(hd); tab_store(0); q_load(hd, qf); issue(hd, jof(0), std::integral_constant<int, 0>{});
    f32x16 O[2], negm, Lacc; float mref = 0.f, ssq_acc = 0.f;
    O[0] = f32x16{}; O[1] = f32x16{}; negm = f32x16{}; Lacc = f32x16{};
    const bf16x8 ones8 = {0x3F80, 0x3F80, 0x3F80, 0x3F80, 0x3F80, 0x3F80, 0x3F80, 0x3F80};
    int hg = 0, ti = 0;
    auto step = [&](int s, auto CURC) {
        constexpr int cur = decltype(CURC)::value;
        const int h = 4 * hg + hd, j = jof(ti);
        __builtin_amdgcn_s_waitcnt(0);
        if (lane == 0) flag[wave] = s + 1;
        while (__builtin_amdgcn_readfirstlane(flag[wave ^ 1]) < s + 1) { }
        asm volatile("" ::: "memory");
        if (s + 1 < nsteps) { if (ti + 1 < nt) issue(h, jof(ti + 1), std::integral_constant<int, (cur ^ 1)>{}); else issue(h + 4, jof(0), std::integral_constant<int, (cur ^ 1)>{}); }
        const bool lastt = (ti == nt - 1), more = lastt && hg < 3;
        if (more) { tab_load(h + 4); q_load(h + 4, qn); }
        LAS const unsigned char* Kst = KV + cur * AT_STG; LAS const unsigned char* Vst = Kst + 8192; LAS const float* T = TAB + (hg & 1) * 1536;
        f32x16 S[2];
        { bf16x8 kf[2][4];
          const unsigned ka = (unsigned)(uintptr_t)(Kst + r32 * 128);
#pragma unroll
          for (int k = 0; k < 4; ++k) { const unsigned ko = ka + (unsigned)(((2 * k + hi) ^ sw) << 4);
              asm volatile("ds_read_b128 %0, %1" : "=v"(kf[0][k]) : "v"(ko));
              asm volatile("ds_read_b128 %0, %1 offset:4096" : "=v"(kf[1][k]) : "v"(ko)); }
          asm volatile("s_waitcnt lgkmcnt(0)" : "+v"(kf[0][0]), "+v"(kf[0][1]), "+v"(kf[0][2]), "+v"(kf[0][3]), "+v"(kf[1][0]), "+v"(kf[1][1]), "+v"(kf[1][2]), "+v"(kf[1][3]));
#pragma unroll
          for (int k = 0; k < 4; ++k) { S[0] = mfma32(kf[0][k], qf[k], k == 0 ? negm : S[0]); S[1] = mfma32(kf[1][k], qf[k], k == 0 ? negm : S[1]); } }
        float mx = -1e30f;
        if (j <= 3) { const float bconst = T[0];
#pragma unroll
            for (int kb = 0; kb < 2; ++kb)
#pragma unroll
                for (int r = 0; r < 16; ++r) { const float sv = S[kb][r] * c1 + bconst; S[kb][r] = sv; mx = fmaxf(mx, sv); }
        } else { const int ybase = 320 - 64 * (8 - j) - qi + 4 * hi;
#pragma unroll
            for (int kb = 0; kb < 2; ++kb)
#pragma unroll
                for (int r = 0; r < 16; ++r) { const float sv = S[kb][r] * c1 + T[ybase + 32 * kb + 8 * (r >> 2) + (r & 3)]; S[kb][r] = sv; mx = fmaxf(mx, sv); }
        }
        mx = xh_max(mx);
        if (__any(fabsf(mx) > 8.0f)) {
            mref += mx;
#pragma unroll
            for (int kb = 0; kb < 2; ++kb)
#pragma unroll
                for (int r = 0; r < 16; ++r) S[kb][r] -= mx;
            const float f = ex2(-mx), nm = -mref * (1.0f / c1);
#pragma unroll
            for (int r = 0; r < 16; ++r) { negm[r] = nm; O[0][r] *= f; O[1][r] *= f; Lacc[r] *= f; }
        }
#pragma unroll
        for (int kb = 0; kb < 2; ++kb)
#pragma unroll
            for (int r = 0; r < 16; ++r) S[kb][r] = ex2(S[kb][r]);
        bf16x8 pf[4];
#pragma unroll
        for (int ks = 0; ks < 4; ++ks) { const int kb = ks >> 1, s8 = 8 * (ks & 1); v4u w;
            w.x = pk2(S[kb][s8], S[kb][s8 + 1]); w.y = pk2(S[kb][s8 + 2], S[kb][s8 + 3]); w.z = pk2(S[kb][s8 + 4], S[kb][s8 + 5]); w.w = pk2(S[kb][s8 + 6], S[kb][s8 + 7]);
            pf[ks] = __builtin_bit_cast(bf16x8, w); }
#pragma unroll
        for (int ks = 0; ks < 4; ++ks) Lacc = mfma32(ones8, pf[ks], Lacc);
        LAS const unsigned char* vb = Vst + (4 * hi + ((lane & 15) >> 2)) * 64 + ((lane >> 4) & 1) * 32 + (lane & 3) * 8;
        const unsigned vba = (unsigned)(uintptr_t)vb;
#pragma unroll
        for (int kh = 0; kh < 2; ++kh) { s16x4 lo[2][2], up[2][2];
#pragma unroll
            for (int k2 = 0; k2 < 2; ++k2)
#pragma unroll
                for (int db = 0; db < 2; ++db) { const int ks = 2 * kh + k2;
                    asm volatile("ds_read_b64_tr_b16 %0, %1 offset:%2" : "=v"(lo[k2][db]) : "v"(vba), "i"(db * 4096 + ks * 1024));
                    asm volatile("ds_read_b64_tr_b16 %0, %1 offset:%2" : "=v"(up[k2][db]) : "v"(vba), "i"(db * 4096 + ks * 1024 + 512)); }
            asm volatile("s_waitcnt lgkmcnt(0)" : "+v"(lo[0][0]), "+v"(lo[0][1]), "+v"(lo[1][0]), "+v"(lo[1][1]), "+v"(up[0][0]), "+v"(up[0][1]), "+v"(up[1][0]), "+v"(up[1][1]));
#pragma unroll
            for (int k2 = 0; k2 < 2; ++k2)
#pragma unroll
                for (int db = 0; db < 2; ++db) { const bf16x8 vf = {lo[k2][db][0], lo[k2][db][1], lo[k2][db][2], lo[k2][db][3], up[k2][db][0], up[k2][db][1], up[k2][db][2], up[k2][db][3]};
                    O[db] = mfma32(vf, pf[2 * kh + k2], O[db]); } }
        if (lastt) {
            const float inv = 1.f / Lacc[0]; float sq = 0.f;
            bf16* yp = C.HY + (size_t)(rq0 + qi) * DM + h * 64 + 4 * hi;
#pragma unroll
            for (int db = 0; db < 2; ++db)
#pragma unroll
                for (int rr = 0; rr < 4; ++rr) { float o[4];
#pragma unroll
                    for (int e = 0; e < 4; ++e) { o[e] = O[db][4 * rr + e] * inv; sq += o[e] * o[e]; }
                    v2u w; w.x = pk2(o[0], o[1]); w.y = pk2(o[2], o[3]); *(v2u*)(yp + 32 * db + 8 * rr) = w; }
            ssq_acc += xh_sum(sq);
            O[0] = f32x16{}; O[1] = f32x16{}; negm = f32x16{}; Lacc = f32x16{}; mref = 0.f;
            if (more) { tab_store((hg + 1) & 1);
#pragma unroll
                for (int k = 0; k < 4; ++k) qf[k] = qn[k]; }
            ++hg; ti = 0;
        } else ++ti;
    };
    for (int s = 0; s < nsteps; s += 2) { step(s, std::integral_constant<int, 0>{}); step(s + 1, std::integral_constant<int, 1>{}); }
    if (hi == 0) ssq[wave * 32 + r32] = ssq_acc;
    asm volatile("s_waitcnt vmcnt(0)" ::: "memory");
    __syncthreads();
    if (C.tid < 64) { const int q2 = C.tid >> 5, rr = C.tid & 31; float t = 0.f;
#pragma unroll
        for (int w = 0; w < 4; ++w) t += ssq[(2 * w + q2) * 32 + rr];
        rstd_l[C.tid] = rsqrtf(t * (1.f / 1024.f) + EPSN); }
    __syncthreads();
    const float* gb = C.in[I_BNG] + (size_t)l * DM;
    const f32x4 g0 = *(const f32x4*)(gb + (C.tid & 127) * 8), g1 = *(const f32x4*)(gb + (C.tid & 127) * 8 + 4);
#pragma unroll 2
    for (int it = 0; it < 16; ++it) { const int idx = C.tid + 512 * it, row = idx >> 7, ch = idx & 127;
        bf16* yp = C.HY + (size_t)(rq0 + row) * DM + ch * 8;
        const v4u raw = *(const v4u*)yp; const v4u zz = *(const v4u*)(C.PROJ + (size_t)(rq0 + row) * NIN + COL_ZA + ch * 8);
        float r[8], z[8]; unpack8(raw, r); unpack8(zz, z); const float rs = rstd_l[row];
        const float gg[8] = {g0.x, g0.y, g0.z, g0.w, g1.x, g1.y, g1.z, g1.w}; float o[8];
#pragma unroll
        for (int e = 0; e < 8; ++e) o[e] = r[e] * rs * gg[e] * silu_f(z[e]);
        v4u w; w.x = pk2(o[0], o[1]); w.y = pk2(o[2], o[3]); w.z = pk2(o[4], o[5]); w.w = pk2(o[6], o[7]);
        *(v4u*)yp = w; }
    __syncthreads();
}

DI int q_issue(const Ctx& C0, unsigned* ctr) {
    Ctx C = C0; fresh(C);
    int v = 0; if (C.tid == 0) v = (int)__hip_atomic_fetch_add(ctr, 1u, __ATOMIC_RELAXED, __HIP_MEMORY_SCOPE_AGENT);
    return v;
}
DI int q_bcast(const Ctx& C0, int v) {
    Ctx C = C0; fresh(C);
    LAS volatile int* slot = (LAS volatile int*)(C.lds + MISC_OFF + 32);
    if (C.tid == 0) *slot = v;
    __syncthreads();
    const int r = *slot;
    __syncthreads();
    return r;
}
DI int attn_code(unsigned xx, unsigned v) { return (v < 64u) ? (int)((xx << 8) | (63u - v)) : (int)((1u << 16) | ((4u * xx + (v - 64u)) << 8)); }
DI int q_issue_attn(const Ctx& C0, unsigned* ctr8) {
    Ctx C = C0; fresh(C);
    int v = 0; if (C.tid == 0) v = (int)__hip_atomic_fetch_add(ctr8 + 64 * (xb_xcc_id() & 7u), 1u, __ATOMIC_RELAXED, __HIP_MEMORY_SCOPE_AGENT);
    return v;
}
DI int q_bcast_attn(const Ctx& C0, unsigned* ctr8, int v) {
    Ctx C = C0; fresh(C);
    LAS volatile int* slot = (LAS volatile int*)(C.lds + MISC_OFF + 32);
    if (C.tid == 0) { const unsigned x = xb_xcc_id() & 7u; int code = -1;
        if ((unsigned)v < 68u) code = attn_code(x, (unsigned)v);
        else for (unsigned k = 1; k < 8; ++k) { const unsigned xx = (x + k) & 7u; const unsigned w = __hip_atomic_fetch_add(ctr8 + 64 * xx, 1u, __ATOMIC_RELAXED, __HIP_MEMORY_SCOPE_AGENT);
            if (w < 68u) { code = attn_code(xx, w); break; } }
        *slot = code; }
    __syncthreads();
    const int r = *slot;
    __syncthreads();
    return r;
}
__global__ void __launch_bounds__(512, 2) hymba_fwd(Args args) {
    extern __shared__ __attribute__((aligned(16))) unsigned char lds_raw[];
    Ctx C; C.in = args.in; C.out = args.out; C.ws = args.ws; C.lds = (LAS unsigned char*)lds_raw;
    C.tid = threadIdx.x; C.lane = C.tid & 63; C.wave = __builtin_amdgcn_readfirstlane(C.tid >> 6); C.G = gridDim.x; C.bid = blockIdx.x;
    C.HY = (bf16*)(args.ws + WS_HY); C.HB = (bf16*)(args.ws + WS_HB); C.PROJ = (bf16*)(args.ws + WS_PROJ); C.KC = (bf16*)(args.ws + WS_KC); C.VC = (bf16*)(args.ws + WS_VC);
    C.WIN = (bf16*)(args.ws + WS_WIN); C.WOUT = (bf16*)(args.ws + WS_WOUT); C.MOD = (float*)(args.ws + WS_MOD); C.SSQ = (float*)(args.ws + WS_SSQ); C.SB = (float*)(args.ws + WS_SB); C.GS = (float*)(args.ws + WS_GS); C.ctl = (unsigned*)(args.ws + WS_CTL);
    if (C.tid < 16) ((LAS unsigned*)(C.lds + MISC_OFF))[C.tid] = 0u;
    __syncthreads();
    const int lo = args.ph_lo, hi = args.ph_hi;
    const bool multi = (hi - lo) > 1;
    XcdBarrier bar; bar.bar = C.ctl + CW_BAR; bar.x = 0; bar.st = nullptr;
    if (multi) bar = xcd_barrier_post(C.ctl + CW_BAR, (volatile LAS unsigned*)(C.lds + MISC_OFF));
#define IN(k) (lo <= (k) && (k) < hi)
#define SEAM(k) do { if (IN(k) && IN((k) + 1)) xcd_barrier(bar); } while (0)
    int ph = 0;
#define TP_B(k) do { if (TPROBE == (k) && blockIdx.x == 0 && threadIdx.x == 0) *(LAS volatile unsigned long long*)(C.lds + MISC_OFF + 40) = __builtin_amdgcn_s_memrealtime(); } while (0)
#define TP_E(k) do { if (TPROBE == (k) && blockIdx.x == 0 && threadIdx.x == 0) *(LAS volatile unsigned long long*)(C.lds + MISC_OFF + 48) += __builtin_amdgcn_s_memrealtime() - *(LAS volatile unsigned long long*)(C.lds + MISC_OFF + 40); } while (0)
#ifndef PHM
#define PHM 0xff
#endif
    TP_B(1); if ((PHM & 1) && IN(ph)) { p0_prologue(C, true); if (REP & 16) p0_prologue(C, false); }
    SEAM(ph); ++ph; TP_E(1);
    TP_B(2); if ((PHM & 2) && IN(ph)) p0b_phase(C);
    SEAM(ph); ++ph; TP_E(2);
    for (int l = 0; l < DEPTH; ++l) {
        TP_B(3); if ((PHM & 4) && IN(ph)) {
            pg8::Gemm g{C.HB, C.WIN + (size_t)l * NIN * DM, MT, NIN, DM}; pg8::G1Order S; S.init(MT, NIN, C.G, C.bid, (l > 0 && C.G == 256) ? 1 : 0, nullptr);
            pg8::EpiProj E{C.PROJ, C.out + O_KP + (size_t)l * NBP * 512 * 1024, C.out + O_VP + (size_t)l * NBP * 512 * 1024, C.out + O_KS + (size_t)l * NBS * 64 * 1024, C.out + O_VS + (size_t)l * NBS * 64 * 1024,
                           C.SSQ + (size_t)l * MT, C.SB + (size_t)l * 40 * NIN};
            pg8::gemm_phase<pg8::EpiProj, pg8::G1Order, true, true>(C.lds, g, S, E);
        }
        SEAM(ph); ++ph; TP_E(3); TP_B(4);
        if ((PHM & 8) && IN(ph)) { for (int u = C.bid; u < 512; u += C.G) ssm_local_unit(C, l, u); }
        SEAM(ph); ++ph;
        if ((PHM & 8) && IN(ph)) ssm_carry_phase(C, l);
        SEAM(ph); ++ph; TP_E(4); TP_B(5);
        if ((PHM & 0x70) && IN(ph)) {
            unsigned* ctr = C.ctl + CW_Q + 64 * 16 * l;
            TP_B(8); if (PHM & 0x10) { int tk = q_issue_attn(C, ctr); for (;;) { const int u = q_bcast_attn(C, ctr, tk); if (u < 0) break; tk = q_issue_attn(C, ctr); attn_unit(C, l, u); } } TP_E(8);
            TP_B(9); if (PHM & 0x20) { int tk = q_issue(C, ctr + 64 * 8); for (;;) { const int u = q_bcast(C, tk); if (u >= 544) break; tk = q_issue(C, ctr + 64 * 8); ssm_main_unit(C, l, u); } } TP_E(9);
            TP_B(10); if (PHM & 0x40) { int tk = q_issue(C, ctr + 64 * 9); for (;;) { const int u = q_bcast(C, tk); if (u >= 544) break; tk = q_issue(C, ctr + 64 * 9); pool_unit(C, l, u); } } TP_E(10);
        }
        SEAM(ph); ++ph; TP_E(5); TP_B(6);
        if ((PHM & 0x80) && IN(ph)) {
            unsigned* rbsig = C.ctl + CW_RB + 64 * l;
            pg8::Gemm g{C.HY, C.WOUT + (size_t)l * DM * DM, MT, DM, DM}; pg8::G2Order S; S.init(MT, DM, C.G, C.bid); S.sig = (l + 1 < DEPTH && C.G == 256) ? rbsig : nullptr; S.late = (C.bid >= 64); S.hits = 0;
            pg8::EpiRes E{l == 0 ? C.in[I_XP] : C.out, l == 0 ? C.in[I_XS] : C.out + (size_t)MP * DM, C.out, C.MOD + (size_t)l * 40 * NIN + 2 * DM,
                          (l + 1 < DEPTH) ? C.GS + (size_t)(l + 1) * 40 * DM : nullptr, C.HB, C.SSQ + (size_t)(l + 1) * MT};
            pg8::gemm_phase<pg8::EpiRes, pg8::G2Order, true, true>(C.lds, g, S, E);
            S.flush();
            if (l + 1 < DEPTH && C.bid >= 64) {
                __syncthreads();
                if (C.G == 256) { pg8::Gemm g1{C.HB, C.WIN + (size_t)(l + 1) * NIN * DM, MT, NIN, DM}; pg8::G1Order S1; S1.init(MT, NIN, C.G, C.bid, 2, rbsig);
                  pg8::EpiProj E1{C.PROJ, C.out + O_KP + (size_t)(l + 1) * NBP * 512 * 1024, C.out + O_VP + (size_t)(l + 1) * NBP * 512 * 1024, C.out + O_KS + (size_t)(l + 1) * NBS * 64 * 1024, C.out + O_VS + (size_t)(l + 1) * NBS * 64 * 1024,
                                  C.SSQ + (size_t)(l + 1) * MT, C.SB + (size_t)(l + 1) * 40 * NIN};
                  pg8::gemm_phase<pg8::EpiProj, pg8::G1Order, true, true>(C.lds, g1, S1, E1); }
                __syncthreads();
                cache_span(C, l + 1, C.bid - 64, C.G - 64); }
        }
        SEAM(ph); ++ph; TP_E(6);
    }
    TP_B(7); TP_B(11); if ((PHM & 2) && IN(ph)) final_norm_phase(C); TP_E(7);
    if (TPROBE == 11) { xcd_barrier(bar); TP_E(11); }
    if (TPROBE && blockIdx.x == 0 && threadIdx.x == 0) { const unsigned long long d = *(LAS volatile unsigned long long*)(C.lds + MISC_OFF + 48), t0 = __builtin_amdgcn_s_memrealtime();
        while (__builtin_amdgcn_s_memrealtime() - t0 < d) __builtin_amdgcn_s_sleep(8); }
#undef IN
#undef SEAM
}

#ifndef N_LAUNCH_MODE
#define N_LAUNCH_MODE 1
#endif
extern "C" void kernel_launch(void* const* d_in, const int* in_sizes, int n_in, void* d_out, int out_size, void* d_ws, size_t ws_size, hipStream_t stream) {
    static int grid = 0;
    if (grid == 0) {
        if (n_in != N_IN || (size_t)out_size != O_END || ws_size < WS_END) { fprintf(stderr, "kernel_launch: unexpected sizes n_in %d out %d ws %zu (need %zu)\n", n_in, out_size, ws_size, (size_t)WS_END); grid = -1; return; }
        int dev = 0, cus = 0, per_cu = 0;
        if (hipGetDevice(&dev) != hipSuccess || hipDeviceGetAttribute(&cus, hipDeviceAttributeMultiprocessorCount, dev) != hipSuccess) { grid = -1; return; }
        if (hipFuncSetAttribute((const void*)hymba_fwd, hipFuncAttributeMaxDynamicSharedMemorySize, LDS_BYTES) != hipSuccess) { fprintf(stderr, "kernel_launch: hipFuncSetAttribute failed\n"); grid = -1; return; }
        if (hipOccupancyMaxActiveBlocksPerMultiprocessor(&per_cu, (const void*)hymba_fwd, 512, LDS_BYTES) != hipSuccess || per_cu < 1) fprintf(stderr, "kernel_launch: occupancy query says %d\n", per_cu);
        (void)hipGetLastError();
        grid = cus;
    }
    if (grid < 0) return;
    (void)in_sizes;
    if (hipMemsetAsync((char*)d_ws + WS_CTL, 0, ZERO_BYTES, stream) != hipSuccess) return;
    Args a{};
    for (int i = 0; i < N_IN; ++i) a.in[i] = (const float*)d_in[i];
    a.out = (float*)d_out; a.ws = (unsigned char*)d_ws;
#if N_LAUNCH_MODE == 1
    a.ph_lo = 0; a.ph_hi = NPH;
    hipLaunchKernelGGL(hymba_fwd, dim3(grid), dim3(512), LDS_BYTES, stream, a);
#else
    for (int p = 0; p < NPH; ++p) { a.ph_lo = p; a.ph_hi = p + 1; hipLaunchKernelGGL(hymba_fwd, dim3(grid), dim3(512), LDS_BYTES, stream, a); }
#endif
}
```
